# Optimizing an MI355X kernel written in HIP

```python
import math
import jax
import jax.numpy as jnp
from jax import lax
import numpy as np

D_MODEL = 1024
BATCH = 8
SEQ = 4096
DEPTH = 2

M_HEADS = 4
M_HEAD_DIM = 128
M_WIDTH = M_HEADS * M_HEAD_DIM
M_CHUNK = 128
CONV_WIDTH = 4
A_HEADS = 8
A_HEAD_DIM = 64
A_WIDTH = A_HEADS * A_HEAD_DIM
MOBA_BLOCK = 256
MOBA_TOPK = 3
Q_CHUNK = 16
REL_BUCKETS = 32
REL_MAX_DIST = 1024
D_FF_DENSE = 2816
N_EXPERTS = 8
TOP_K = 2
D_FF_EXPERT = 3584
N_DENSE = (DEPTH + 1) // 2
N_MOE = DEPTH // 2
EPS = 1e-6

IN_SIZES = (M_WIDTH, M_WIDTH, M_WIDTH, M_WIDTH, M_HEADS, M_HEADS, A_WIDTH, A_WIDTH, A_WIDTH, D_MODEL, D_MODEL)
IN_WIDTH = sum(IN_SIZES)

kernel_name = 'hybrid_mlstm_moba_moe_block'


def rms_norm(x, g):
    x32 = x.astype(jnp.float32)
    y = x32 * lax.rsqrt(jnp.mean(x32 * x32, axis=-1, keepdims=True) + EPS)
    return (y * g.astype(jnp.float32)).astype(x.dtype)


def split_columns(z):
    cuts = []
    acc = 0
    for s in IN_SIZES[:-1]:
        acc += s
        cuts.append(acc)
    return jnp.split(z, cuts, axis=-1)


def causal_depthwise_conv(x, w, b):
    c = x.shape[-1]
    y = lax.conv_general_dilated(x, w[:, None, :].astype(x.dtype), window_strides=(1,),
                                 padding=[(CONV_WIDTH - 1, 0)],
                                 dimension_numbers=('NWC', 'WIO', 'NWC'),
                                 feature_group_count=c)
    return y + b.astype(x.dtype)


def t5_bucket(dist):
    n = jnp.maximum(dist, 0)
    max_exact = REL_BUCKETS // 2
    log_ratio = jnp.log(jnp.maximum(n, max_exact).astype(jnp.float32) / max_exact) / math.log(REL_MAX_DIST / max_exact)
    large = max_exact + (log_ratio * (REL_BUCKETS - max_exact)).astype(jnp.int32)
    large = jnp.minimum(large, REL_BUCKETS - 1)
    return jnp.where(n < max_exact, n, large)


def gather_blocks(blocks, idx):
    return jax.vmap(jax.vmap(lambda bl, ix: bl[ix]))(blocks, idx)


def mlstm_chunkwise(q, k, v, i_pre, f_pre):
    B, S, H, DH = q.shape
    L = M_CHUNK
    NC = S // L
    f32 = jnp.float32

    def chunk(a):
        a = a.astype(f32).reshape((B, NC, L, H) + a.shape[3:])
        return jnp.moveaxis(a, (1, 3), (0, 2))

    qc = chunk(q)
    kc = chunk(k) * (DH ** -0.5)
    vc = chunk(v)
    log_f = chunk(jax.nn.log_sigmoid(f_pre.astype(f32)))
    log_i = chunk(i_pre)
    bcum = jnp.cumsum(log_f, axis=-1)
    causal = jnp.tril(jnp.ones((L, L), dtype=bool))

    def step(carry, xs):
        C, n, m = carry
        qq, kk, vv, bb, ii = xs
        dlog = jnp.where(causal, bb[..., :, None] - bb[..., None, :] + ii[..., None, :], -jnp.inf)
        a = bb + m[..., None]
        mt = jnp.maximum(a, jnp.max(dlog, axis=-1))
        w_intra = jnp.exp(dlog - mt[..., None])
        w_state = jnp.exp(a - mt)
        s = jnp.einsum('bhtd,bhsd->bhts', qq, kk) * w_intra
        num = jnp.einsum('bhts,bhse->bhte', s, vv) + w_state[..., None] * jnp.einsum('bhtd,bhde->bhte', qq, C)
        den = jnp.sum(s, axis=-1) + w_state * jnp.einsum('bhtd,bhd->bht', qq, n)
        h = num / jnp.maximum(jnp.abs(den), jnp.exp(-mt))[..., None]
        b_last = bb[..., -1]
        g = b_last[..., None] - bb + ii
        m_new = jnp.maximum(b_last + m, jnp.max(g, axis=-1))
        decay = jnp.exp(b_last + m - m_new)
        ws = jnp.exp(g - m_new[..., None])
        C = decay[..., None, None] * C + jnp.einsum('bhs,bhsd,bhse->bhde', ws, kk, vv)
        n = decay[..., None] * n + jnp.einsum('bhs,bhsd->bhd', ws, kk)
        return (C, n, m_new), h

    init = (jnp.zeros((B, H, DH, DH), f32), jnp.zeros((B, H, DH), f32), jnp.zeros((B, H), f32))
    _, h = lax.scan(step, init, (qc, kc, vc, bcum, log_i))
    return jnp.moveaxis(h, (0, 2), (1, 3)).reshape(B, S, H, DH)


def moba_attention(q, k, v, rel_bias):
    B, H, S, DA = q.shape
    BS = MOBA_BLOCK
    NB = -(-S // BS)
    SP = NB * BS
    f32 = jnp.float32
    pad = [(0, 0), (0, 0), (0, SP - S), (0, 0)]
    q = jnp.pad(q, pad)
    k = jnp.pad(k, pad)
    v = jnp.pad(v, pad)
    kb = k.reshape(B, H, NB, BS, DA)
    vb = v.reshape(B, H, NB, BS, DA)
    k_mean = jnp.mean(kb.astype(f32), axis=3)
    gate = jnp.einsum('bhsd,bhnd->bhsn', q.astype(f32), k_mean)
    q_blk = jnp.arange(SP) // BS
    past = jnp.arange(NB)[None, :] < q_blk[:, None]
    gate = jnp.where(past, gate, -jnp.inf)
    n_sel = min(MOBA_TOPK, NB)
    _, sel = lax.top_k(gate, n_sel)
    sel_ok = sel < q_blk[:, None]
    nqc = SP // Q_CHUNK

    def by_chunk(a):
        return jnp.moveaxis(a.reshape((B, H, nqc, Q_CHUNK) + a.shape[3:]), 2, 0)

    bias_hb = rel_bias.T
    head_ix = jnp.arange(H)[None, :, None, None, None]
    scale = DA ** -0.5

    def attend(args):
        qq, ss, ok, start = args
        qpos = start + jnp.arange(Q_CHUNK)
        blk = start // BS
        own_k = lax.dynamic_index_in_dim(kb, blk, axis=2, keepdims=False)
        own_v = lax.dynamic_index_in_dim(vb, blk, axis=2, keepdims=False)
        own_pos = blk * BS + jnp.arange(BS)
        sel_k = gather_blocks(kb, ss)
        sel_v = gather_blocks(vb, ss)
        sel_pos = ss[..., None] * BS + jnp.arange(BS)
        l_own = jnp.einsum('bhqd,bhkd->bhqk', qq, own_k).astype(f32) * scale \
            + bias_hb[:, t5_bucket(qpos[:, None] - own_pos[None, :])]
        l_own = jnp.where(own_pos[None, :] <= qpos[:, None], l_own, -jnp.inf)
        l_sel = jnp.einsum('bhqd,bhqnkd->bhqnk', qq, sel_k).astype(f32) * scale \
            + bias_hb[head_ix, t5_bucket(qpos[None, None, :, None, None] - sel_pos)]
        l_sel = jnp.where(ok[..., None], l_sel, -jnp.inf)
        logits = jnp.concatenate([l_own, l_sel.reshape(B, H, Q_CHUNK, n_sel * BS)], axis=-1)
        p = jax.nn.softmax(logits, axis=-1).astype(v.dtype)
        p_own = p[..., :BS]
        p_sel = p[..., BS:].reshape(B, H, Q_CHUNK, n_sel, BS)
        return jnp.einsum('bhqk,bhkd->bhqd', p_own, own_v) + jnp.einsum('bhqnk,bhqnkd->bhqd', p_sel, sel_v)

    starts = jnp.arange(nqc, dtype=jnp.int32) * Q_CHUNK
    out = lax.map(attend, (by_chunk(q), by_chunk(sel), by_chunk(sel_ok), starts))
    out = jnp.moveaxis(out, 0, 2).reshape(B, H, SP, DA)
    return out[:, :, :S]


def hybrid_mixer(h, rel_bias, w_in, conv_w, conv_b, igate_b, fgate_b, mlstm_norm_g,
                 q_norm_g, k_norm_g, w_branch_a, w_branch_b, w_out):
    B, S, _ = h.shape
    z = jnp.einsum('bsd,dp->bsp', h, w_in)
    mq, mk, mv, mo, mi, mf, aq, ak, av, ga, gb = split_columns(z)
    qk = jax.nn.silu(causal_depthwise_conv(jnp.concatenate([mq, mk], axis=-1), conv_w, conv_b))
    mq, mk = jnp.split(qk, 2, axis=-1)

    def heads_m(t):
        return t.reshape(B, S, M_HEADS, M_HEAD_DIM)

    h_cell = mlstm_chunkwise(heads_m(mq), heads_m(mk), heads_m(mv),
                             mi.astype(jnp.float32) + igate_b, mf.astype(jnp.float32) + fgate_b)
    h_cell = jax.nn.sigmoid(heads_m(mo).astype(jnp.float32)) * h_cell
    h_a = rms_norm(h_cell, mlstm_norm_g.reshape(M_HEADS, M_HEAD_DIM)).astype(h.dtype).reshape(B, S, M_WIDTH)
    y_a = h_a @ w_branch_a
    def heads_a(t):
        return t.reshape(B, S, A_HEADS, A_HEAD_DIM).transpose(0, 2, 1, 3)

    qa = rms_norm(heads_a(aq), q_norm_g)
    ka = rms_norm(heads_a(ak), k_norm_g)
    o_b = moba_attention(qa, ka, heads_a(av), rel_bias)
    y_b = o_b.transpose(0, 2, 1, 3).reshape(B, S, A_WIDTH) @ w_branch_b
    y = jax.nn.sigmoid(ga) * y_a + jax.nn.sigmoid(gb) * y_b
    return y @ w_out


def swiglu(h, wg, wu, wd):
    return (jax.nn.silu(h @ wg) * (h @ wu)) @ wd


def moe_swiglu(h, router_w, wg, wu, wd):
    logits = (h @ router_w).astype(jnp.float32)
    top_val, top_idx = lax.top_k(logits, TOP_K)
    top_w = jax.nn.softmax(top_val, axis=-1)
    gates = jnp.sum(jax.nn.one_hot(top_idx, N_EXPERTS, dtype=jnp.float32) * top_w[..., None], axis=-2).astype(h.dtype)
    y = jnp.zeros_like(h)
    for e in range(N_EXPERTS):
        y = y + gates[..., e:e + 1] * swiglu(h, wg[e], wu[e], wd[e])
    return y


def setup_inputs(seed: int = 0) -> dict:
    key = jax.random.key(seed)
    ks = jax.random.split(key, 24)
    f32 = jnp.float32

    def w(k, shape, fan_in):
        return jax.random.normal(k, shape, f32) * (fan_in ** -0.5)

    def gain(k, shape):
        return 1.0 + 0.05 * jax.random.normal(k, shape, f32)

    return {
        'x': jax.random.normal(ks[0], (BATCH, SEQ, D_MODEL), f32),
        'rel_bias': 0.1 * jax.random.normal(ks[1], (REL_BUCKETS, A_HEADS), f32),
        'mix_norm_g': gain(ks[2], (DEPTH, D_MODEL)),
        'w_in': w(ks[3], (DEPTH, D_MODEL, IN_WIDTH), D_MODEL),
        'conv_w': w(ks[4], (DEPTH, CONV_WIDTH, 2 * M_WIDTH), CONV_WIDTH),
        'conv_b': 0.02 * jax.random.normal(ks[5], (DEPTH, 2 * M_WIDTH), f32),
        'igate_b': 0.1 * jax.random.normal(ks[6], (DEPTH, M_HEADS), f32),
        'fgate_b': 3.0 + 3.0 * jax.random.uniform(ks[7], (DEPTH, M_HEADS), f32),
        'mlstm_norm_g': gain(ks[8], (DEPTH, M_WIDTH)),
        'q_norm_g': gain(ks[9], (DEPTH, A_HEAD_DIM)),
        'k_norm_g': gain(ks[10], (DEPTH, A_HEAD_DIM)),
        'w_branch_a': w(ks[11], (DEPTH, M_WIDTH, D_MODEL), M_WIDTH),
        'w_branch_b': w(ks[12], (DEPTH, A_WIDTH, D_MODEL), A_WIDTH),
        'w_out': w(ks[13], (DEPTH, D_MODEL, D_MODEL), D_MODEL),
        'ffn_norm_g': gain(ks[14], (DEPTH, D_MODEL)),
        'dense_w_gate': w(ks[15], (N_DENSE, D_MODEL, D_FF_DENSE), D_MODEL),
        'dense_w_up': w(ks[16], (N_DENSE, D_MODEL, D_FF_DENSE), D_MODEL),
        'dense_w_down': w(ks[17], (N_DENSE, D_FF_DENSE, D_MODEL), D_FF_DENSE),
        'router_w': w(ks[18], (N_MOE, D_MODEL, N_EXPERTS), D_MODEL),
        'expert_w_gate': w(ks[19], (N_MOE, N_EXPERTS, D_MODEL, D_FF_EXPERT), D_MODEL),
        'expert_w_up': w(ks[20], (N_MOE, N_EXPERTS, D_MODEL, D_FF_EXPERT), D_MODEL),
        'expert_w_down': w(ks[21], (N_MOE, N_EXPERTS, D_FF_EXPERT, D_MODEL), D_FF_EXPERT),
    }


def reference(x, rel_bias, mix_norm_g, w_in, conv_w, conv_b, igate_b, fgate_b, mlstm_norm_g,
              q_norm_g, k_norm_g, w_branch_a, w_branch_b, w_out, ffn_norm_g,
              dense_w_gate, dense_w_up, dense_w_down, router_w,
              expert_w_gate, expert_w_up, expert_w_down):
    for layer in range(DEPTH):
        h = rms_norm(x, mix_norm_g[layer])
        x = x + hybrid_mixer(h, rel_bias, w_in[layer], conv_w[layer], conv_b[layer], igate_b[layer],
                             fgate_b[layer], mlstm_norm_g[layer], q_norm_g[layer], k_norm_g[layer],
                             w_branch_a[layer], w_branch_b[layer], w_out[layer])
        h = rms_norm(x, ffn_norm_g[layer])
        j = layer // 2
        if layer % 2 == 0:
            x = x + swiglu(h, dense_w_gate[j], dense_w_up[j], dense_w_down[j])
        else:
            x = x + moe_swiglu(h, router_w[j], expert_w_gate[j], expert_w_up[j], expert_w_down[j])
    return x
```

```cpp
#include <hip/hip_runtime.h>
#include <cstdio>
#include <cstdint>

#define LAS __attribute__((address_space(3)))
#define GAS __attribute__((address_space(1)))
typedef unsigned short bf16_t;
typedef short bf16x8 __attribute__((ext_vector_type(8)));
typedef short s16x4 __attribute__((ext_vector_type(4)));
typedef float f32x2 __attribute__((ext_vector_type(2)));
typedef float f32x4 __attribute__((ext_vector_type(4)));
typedef float f32x16 __attribute__((ext_vector_type(16)));
typedef unsigned u32x4 __attribute__((ext_vector_type(4)));
typedef unsigned u32x2 __attribute__((ext_vector_type(2)));
typedef GAS unsigned gu32;

constexpr int NBATCH = 8, SEQ = 4096, DM = 1024, MTOK = NBATCH * SEQ;
constexpr int INW = 5640, NIN = 5632;
constexpr int MH = 4, MDH = 128, MCH = 128, NCH = SEQ / MCH;
constexpr int AH = 8, ADH = 64, ABLK = 256, NAB = SEQ / ABLK;
constexpr int DFF = 2816, NEXP = 8, EFF = 3584;
constexpr float EPS = 1e-6f;
constexpr float LOG2E = 1.4426950408889634f;
constexpr float QSCALE = 0.125f * LOG2E;

constexpr size_t MiB = 1u << 20;
constexpr size_t WS_CTL = 0, CTL_ZERO_BYTES = 1 * MiB;
constexpr size_t WS_GATES = 1 * MiB;
constexpr size_t WS_KMEAN = 2 * MiB;
constexpr size_t WS_MSC = 2 * MiB + 512 * 1024;
constexpr size_t WS_UN = 3 * MiB;
constexpr size_t WS_NST = 3 * MiB + 512 * 1024;
constexpr size_t WS_MIDX = 4 * MiB;
constexpr size_t WS_MWGT = 6 * MiB;
constexpr size_t WS_WIN = 12 * MiB;
constexpr size_t WS_WA = 34 * MiB;
constexpr size_t WS_WB = 36 * MiB;
constexpr size_t WS_WOUT = 38 * MiB;
constexpr size_t WS_WGU = 42 * MiB;
constexpr size_t WS_WD = 53 * MiB;
constexpr size_t WS_XN = 60 * MiB;
constexpr size_t WS_MQK = 124 * MiB;
constexpr size_t WS_MV = 188 * MiB;
constexpr size_t WS_MO = 220 * MiB, WS_AQ = 252 * MiB, WS_AK = 284 * MiB, WS_AV = 316 * MiB;
constexpr size_t WS_GAB = 348 * MiB;
constexpr size_t WS_CST = 476 * MiB;
constexpr size_t WS_Y = 476 * MiB;
constexpr size_t WS_ACT = 124 * MiB;
constexpr size_t WS_WGUE = 124 * MiB;
constexpr size_t WS_WDE = 236 * MiB;
constexpr size_t WS_EACT = 292 * MiB;
constexpr size_t WS_END = 540 * MiB;
constexpr int CW_BAR = 4096;
constexpr int CW_MOE = 8192;

constexpr int LDS_BYTES = 147456;
constexpr int MISC_OFF = LDS_BYTES - 256;

__device__ __forceinline__ unsigned cvt_pk_bf16(float lo, float hi) { unsigned r; asm volatile("v_cvt_pk_bf16_f32 %0, %1, %2" : "=v"(r) : "v"(lo), "v"(hi)); return r; }
__device__ __forceinline__ float bf_lo(unsigned w) { return __uint_as_float(w << 16); }
__device__ __forceinline__ float bf_hi(unsigned w) { return __uint_as_float(w & 0xffff0000u); }
__device__ __forceinline__ float bf2f(bf16_t b) { return __uint_as_float((unsigned)b << 16); }
__device__ __forceinline__ float sigmoidf_(float x) { return __builtin_amdgcn_rcpf(1.0f + __builtin_amdgcn_exp2f(-x * LOG2E)); }
__device__ __forceinline__ int fresh_lane() { unsigned m = ~0u; asm volatile("" : "+s"(m)); return (int)__builtin_amdgcn_mbcnt_hi(m, __builtin_amdgcn_mbcnt_lo(m, 0u)); }
__device__ __forceinline__ int crow(int r, int hi) { return (r & 3) + 8 * (r >> 2) + 4 * hi; }
#define LDS_WAIT() asm volatile("s_waitcnt lgkmcnt(0)" ::: "memory")
#define VM_WAIT() asm volatile("s_waitcnt vmcnt(0)" ::: "memory")

namespace pg8 {
constexpr int BM = 256, BK = 64, HALF = 128, HTB = HALF * BK * 2, STAGE_BYTES = 8 * HTB, NXCD = 8, WGM = 8;
__host__ __device__ __forceinline__ int lds_byte(int r, int c) { const int st = (r >> 4) * 2 + (c >> 5), rr = r & 15, cc = c & 31, ob = rr * 64 + cc * 2; return st * 1024 + (ob ^ (((ob >> 9) & 1) << 5)); }
__host__ __device__ __forceinline__ void stage_rc(int b, int& R, int& C) { const int st = b / 1024, sb = b % 1024, swz = sb ^ (((sb >> 9) & 1) << 5); R = (st >> 1) * 16 + swz / 64; C = (st & 1) * 32 + (swz % 64) / 2; }
__host__ __device__ __forceinline__ int perm32(int rho) { const int n = rho >> 4, i = rho & 15; return 8 * (i >> 2) + 4 * n + (i & 3); }

struct Unit { int pm, pn, e, lp; };

struct StaticOrder {
    static constexpr bool GATHER = false;
    const char* A; const char* Bt; size_t tstep;
    int nM, nN, nwg, G, c;
    __device__ __forceinline__ void init(const void* A_, const void* Bt_, int M, int N, int K, int G_, int c_) { A = (const char*)A_; Bt = (const char*)Bt_; tstep = (size_t)BM * K * 2; nM = M / BM; nN = N / BM; nwg = nM * nN; G = G_; c = c_; }
    __device__ __forceinline__ bool next(int i, Unit& u) const {
        const long L = (long)i * G + c; if (L >= nwg) return false;
        int wgid = (int)L; { const int q = nwg / NXCD, r = nwg % NXCD, xcd = wgid % NXCD, off = wgid / NXCD; wgid = (xcd < r ? xcd * (q + 1) : r * (q + 1) + (xcd - r) * q) + off; }
        const int nig = WGM * nN, gid = wgid / nig, fm = gid * WGM, gsz = (nM - fm) < WGM ? (nM - fm) : WGM;
        u.pm = fm + ((wgid % nig) % gsz); u.pn = (wgid % nig) / gsz; u.e = 0; u.lp = 0; return true;
    }
    __device__ __forceinline__ const char* abase(const Unit& u) const { return A + (size_t)u.pm * tstep; }
    __device__ __forceinline__ const char* bbase(const Unit& u) const { return Bt + (size_t)u.pn * tstep; }
    __device__ __forceinline__ unsigned tok(const Unit&, int) const { return 0u; }
};

template <class Epi, class Sched, bool ALIGN_EPI>
__device__ __forceinline__ void gemm_phase(LAS unsigned char* lds, const int K, const Sched& S, const Epi& E, const int wave_id) {
    const int lane_ = fresh_lane();
    const int wid = __builtin_amdgcn_readfirstlane(wave_id), lane = lane_, tid = wid * 64 + lane, wr = wid >> 2, wc = wid & 3, fr = lane & 15, fq = lane >> 4;
    const int nt = K / BK;
    unsigned voffB[2]; int RA[2], CA[2];
#pragma unroll
    for (int i = 0; i < 2; ++i) { int R, C; stage_rc(tid * 16 + i * 8192, R, C); RA[i] = R; CA[i] = C; const int Rb = Epi::PERM ? ((R & ~31) + perm32(R & 31)) : R; voffB[i] = (unsigned)(Rb * K + C) * 2u; }
    const size_t kstep = (size_t)(BK * 2);
    const size_t hstep = (size_t)HALF * K * 2;
    const size_t hstepA = Sched::GATHER ? (size_t)0 : hstep;
    const unsigned ldsw = (unsigned)wid * 1024u;
    const int aoff = lds_byte(wr * 64 + fr, fq * 8), boff = lds_byte(wc * 32 + fr, fq * 8);
#define PG8_SA(b, h) (((b) * 2 + (h)) * HTB)
#define PG8_SB(b, h) ((4 + (b) * 2 + (h)) * HTB)
#define PG8_STAGE(bufoff, gbase, voff) do { _Pragma("unroll") for (int _i = 0; _i < 2; ++_i) \
        __builtin_amdgcn_global_load_lds((const unsigned*)((const char*)(gbase) + (voff)[_i]), (LAS unsigned*)(lds + (bufoff) + ldsw + _i * 8192), 16, 0, 0); } while (0)
#define PG8_LDA(dst, b, h) do { _Pragma("unroll") for (int m = 0; m < 4; ++m) _Pragma("unroll") for (int k = 0; k < 2; ++k) dst[m][k] = *(const LAS bf16x8*)(lds + PG8_SA(b, h) + aoff + m * 2048 + k * 1024); } while (0)
#define PG8_LDB(dst, b, h) do { _Pragma("unroll") for (int n = 0; n < 2; ++n) _Pragma("unroll") for (int k = 0; k < 2; ++k) dst[n][k] = *(const LAS bf16x8*)(lds + PG8_SB(b, h) + boff + n * 2048 + k * 1024); } while (0)
#define PG8_MMA(ai, bj, At, Bt) do { __builtin_amdgcn_s_setprio(1); _Pragma("unroll") for (int m = 0; m < 4; ++m) _Pragma("unroll") for (int n = 0; n < 2; ++n) _Pragma("unroll") for (int k = 0; k < 2; ++k) \
        acc[ai][bj][m][n] = __builtin_amdgcn_mfma_f32_16x16x32_bf16(Bt[n][k], At[m][k], acc[ai][bj][m][n], 0, 0, 0); __builtin_amdgcn_s_setprio(0); } while (0)
#define PG8_WAIT_V(n) asm volatile("s_waitcnt vmcnt(" #n ")" ::: "memory")
#define PG8_WAIT_L(n) asm volatile("s_waitcnt lgkmcnt(" #n ")" ::: "memory")
#define PG8_BAR __builtin_amdgcn_s_barrier()
#define PG8_SCHED __builtin_amdgcn_sched_barrier(0)
#define PG8_SETV(v, u) do { _Pragma("unroll") for (int _h = 0; _h < 2; ++_h) _Pragma("unroll") for (int _i = 0; _i < 2; ++_i) \
        v[_h][_i] = Sched::GATHER ? (S.tok(u, _h * HALF + RA[_i]) * (unsigned)K + (unsigned)CA[_i]) * 2u : (unsigned)(RA[_i] * K + CA[_i]) * 2u; } while (0)
    Unit cur, nxt; int ui = 0;
    if (!S.next(0, cur)) return;
    f32x4 acc[2][2][4][2];
#pragma unroll
    for (int a = 0; a < 2; ++a)
#pragma unroll
        for (int b = 0; b < 2; ++b)
#pragma unroll
            for (int m = 0; m < 4; ++m)
#pragma unroll
                for (int n = 0; n < 2; ++n) acc[a][b][m][n] = (f32x4){0.f, 0.f, 0.f, 0.f};
    bf16x8 At[4][2], B0[2][2], B1[2][2];
    unsigned cvA[2][2], nvA[2][2];
    PG8_SETV(cvA, cur);
    const char* cA = S.abase(cur); const char* cB = S.bbase(cur);
    PG8_STAGE(PG8_SB(0, 0), cB, voffB); PG8_STAGE(PG8_SB(0, 1), cB + hstep, voffB); PG8_STAGE(PG8_SA(0, 0), cA, cvA[0]); PG8_STAGE(PG8_SA(0, 1), cA + hstepA, cvA[1]);
    if (wr == 1) PG8_BAR;
    PG8_WAIT_V(2); PG8_BAR;
    PG8_STAGE(PG8_SB(1, 0), cB + kstep, voffB); PG8_STAGE(PG8_SA(1, 0), cA + kstep, cvA[0]); PG8_STAGE(PG8_SB(1, 1), cB + hstep + kstep, voffB);
    PG8_WAIT_V(6); PG8_BAR;
    for (;;) {
        const bool has_next = S.next(ui + 1, nxt);
        const char* nA = has_next ? S.abase(nxt) : cA; const char* nB = has_next ? S.bbase(nxt) : cB;
        if constexpr (Sched::GATHER) {
            if (has_next) { PG8_SETV(nvA, nxt); }
            else {
#pragma unroll
                for (int h = 0; h < 2; ++h)
#pragma unroll
                    for (int i = 0; i < 2; ++i) nvA[h][i] = cvA[h][i];
            }
            asm volatile("" : "+v"(nvA[0][0]), "+v"(nvA[0][1]), "+v"(nvA[1][0]), "+v"(nvA[1][1]));
        }
        for (int t = 0; t < nt; t += 2) {
            const bool last = (t == nt - 2);
            const char* a1 = cA + (size_t)(t + 1) * kstep;
            const char* a2 = last ? nA : cA + (size_t)(t + 2) * kstep; const char* b2 = last ? nB : cB + (size_t)(t + 2) * kstep;
            const char* a3 = a2 + kstep; const char* b3 = b2 + kstep;
            unsigned v0[2], v1[2];
#pragma unroll
            for (int i = 0; i < 2; ++i) { if constexpr (Sched::GATHER) { v0[i] = last ? nvA[0][i] : cvA[0][i]; v1[i] = last ? nvA[1][i] : cvA[1][i]; } else { v0[i] = cvA[0][i]; v1[i] = cvA[1][i]; } }
            PG8_LDB(B0, 0, 0); PG8_LDB(B1, 0, 1); PG8_SCHED; PG8_LDA(At, 0, 0); PG8_STAGE(PG8_SA(1, 1), a1 + hstepA, cvA[1]);
            PG8_WAIT_V(8); PG8_WAIT_L(0); PG8_BAR; PG8_MMA(0, 0, At, B0); PG8_MMA(0, 1, At, B1); PG8_BAR; PG8_SCHED;
            PG8_LDA(At, 0, 1); PG8_STAGE(PG8_SB(0, 0), b2, voffB); PG8_STAGE(PG8_SB(0, 1), b2 + hstep, voffB); PG8_STAGE(PG8_SA(0, 0), a2, v0);
            PG8_WAIT_V(8); PG8_WAIT_L(0); PG8_BAR; PG8_MMA(1, 0, At, B0); PG8_MMA(1, 1, At, B1); PG8_BAR; PG8_SCHED;
            PG8_LDB(B0, 1, 0); PG8_LDB(B1, 1, 1); PG8_SCHED; PG8_LDA(At, 1, 0); PG8_STAGE(PG8_SA(0, 1), a2 + hstepA, v1);
            PG8_WAIT_V(8); PG8_WAIT_L(0); PG8_BAR; PG8_MMA(0, 0, At, B0); PG8_MMA(0, 1, At, B1); PG8_BAR; PG8_SCHED;
            PG8_LDA(At, 1, 1); PG8_STAGE(PG8_SB(1, 0), b3, voffB); PG8_STAGE(PG8_SB(1, 1), b3 + hstep, voffB); PG8_STAGE(PG8_SA(1, 0), a3, v0);
            PG8_WAIT_V(8); PG8_WAIT_L(0); PG8_BAR; PG8_MMA(1, 0, At, B0); PG8_MMA(1, 1, At, B1); PG8_BAR; PG8_SCHED;
        }
        if constexpr (ALIGN_EPI) { if (wr == 0) PG8_BAR; }
        E(acc, cur, wr, wc, fr, fq);
        if (!has_next) break;
#pragma unroll
        for (int a = 0; a < 2; ++a)
#pragma unroll
            for (int b = 0; b < 2; ++b)
#pragma unroll
                for (int m = 0; m < 4; ++m)
#pragma unroll
                    for (int n = 0; n < 2; ++n) acc[a][b][m][n] = (f32x4){0.f, 0.f, 0.f, 0.f};
        cur = nxt; cA = nA; cB = nB; ++ui;
#pragma unroll
        for (int h = 0; h < 2; ++h)
#pragma unroll
            for (int i = 0; i < 2; ++i) cvA[h][i] = nvA[h][i];
        if constexpr (ALIGN_EPI) { if (wr == 1) PG8_BAR; }
    }
    PG8_WAIT_V(0);
    if constexpr (!ALIGN_EPI) { if (wr == 0) PG8_BAR; }
    PG8_BAR;
#undef PG8_SA
#undef PG8_SB
#undef PG8_STAGE
#undef PG8_LDA
#undef PG8_LDB
#undef PG8_MMA
#undef PG8_WAIT_V
#undef PG8_WAIT_L
#undef PG8_BAR
#undef PG8_SCHED
#undef PG8_SETV
}

struct EpiIn {
    static constexpr bool PERM = true;
    unsigned char* ws;
    __device__ __forceinline__ void operator()(const f32x4 (&acc)[2][2][4][2], const Unit& u, int wr, int wc, int fr, int fq) const {
        const int pn = u.pn; bf16_t* base; int ld, colt; bool sg;
        if (pn < 4) { base = (bf16_t*)(ws + WS_MQK); ld = 1024; colt = 256 * pn; sg = false; }
        else if (pn < 14) { const int q = (pn - 4) >> 1; base = (bf16_t*)(ws + WS_MV + (size_t)q * (32 * MiB)); ld = 512; colt = 256 * ((pn - 4) & 1); sg = (q == 1); }
        else { base = (bf16_t*)(ws + WS_GAB); ld = 2048; colt = 256 * (pn - 14); sg = true; }
        const int row0 = u.pm * BM + wr * 64 + fr, col0 = colt + wc * 32 + 8 * fq;
#pragma unroll
        for (int ai = 0; ai < 2; ++ai)
#pragma unroll
            for (int m = 0; m < 4; ++m) { bf16_t* rowp = base + (size_t)(row0 + ai * HALF + m * 16) * ld + col0;
#pragma unroll
                for (int bj = 0; bj < 2; ++bj) { f32x4 v0 = acc[ai][bj][m][0], v1 = acc[ai][bj][m][1];
                    if (sg) {
#pragma unroll
                        for (int j = 0; j < 4; ++j) { v0[j] = sigmoidf_(v0[j]); v1[j] = sigmoidf_(v1[j]); } }
                    u32x4 w; w.x = cvt_pk_bf16(v0[0], v0[1]); w.y = cvt_pk_bf16(v0[2], v0[3]); w.z = cvt_pk_bf16(v1[0], v1[1]); w.w = cvt_pk_bf16(v1[2], v1[3]);
                    *(u32x4*)(rowp + bj * HALF) = w; } }
    }
};
template <int BR> struct EpiBranch {
    static constexpr bool PERM = true;
    bf16_t* Y; const bf16_t* G;
    __device__ __forceinline__ void operator()(const f32x4 (&acc)[2][2][4][2], const Unit& u, int wr, int wc, int fr, int fq) const {
        const int row0 = u.pm * BM + wr * 64 + fr, col0 = u.pn * BM + wc * 32 + 8 * fq;
#pragma unroll
        for (int ai = 0; ai < 2; ++ai)
#pragma unroll
            for (int m = 0; m < 4; ++m) { const size_t r = (size_t)(row0 + ai * HALF + m * 16);
#pragma unroll
                for (int bj = 0; bj < 2; ++bj) { const int c = col0 + bj * HALF;
                    const u32x4 g = *(const u32x4*)(G + r * 2048 + BR * 1024 + c);
                    f32x4 v0 = acc[ai][bj][m][0], v1 = acc[ai][bj][m][1];
                    v0[0] *= bf_lo(g.x); v0[1] *= bf_hi(g.x); v0[2] *= bf_lo(g.y); v0[3] *= bf_hi(g.y); v1[0] *= bf_lo(g.z); v1[1] *= bf_hi(g.z); v1[2] *= bf_lo(g.w); v1[3] *= bf_hi(g.w);
                    if (BR == 1) { const u32x4 y = *(const u32x4*)(Y + r * 1024 + c);
                        v0[0] += bf_lo(y.x); v0[1] += bf_hi(y.x); v0[2] += bf_lo(y.y); v0[3] += bf_hi(y.y); v1[0] += bf_lo(y.z); v1[1] += bf_hi(y.z); v1[2] += bf_lo(y.w); v1[3] += bf_hi(y.w); }
                    u32x4 w; w.x = cvt_pk_bf16(v0[0], v0[1]); w.y = cvt_pk_bf16(v0[2], v0[3]); w.z = cvt_pk_bf16(v1[0], v1[1]); w.w = cvt_pk_bf16(v1[2], v1[3]);
                    *(u32x4*)(Y + r * 1024 + c) = w; } }
    }
};
struct EpiResid {
    static constexpr bool PERM = false;
    const float* base; float* out;
    __device__ __forceinline__ void operator()(const f32x4 (&acc)[2][2][4][2], const Unit& u, int wr, int wc, int fr, int fq) const {
        const int row0 = u.pm * BM + wr * 64 + fr, col0 = u.pn * BM + wc * 32 + 4 * fq;
#pragma unroll
        for (int ai = 0; ai < 2; ++ai)
#pragma unroll
            for (int m = 0; m < 4; ++m) { const size_t off = (size_t)(row0 + ai * HALF + m * 16) * 1024 + col0;
#pragma unroll
                for (int bj = 0; bj < 2; ++bj)
#pragma unroll
                    for (int n = 0; n < 2; ++n) { const f32x4 b = *(const f32x4*)(base + off + bj * HALF + n * 16); *(f32x4*)(out + off + bj * HALF + n * 16) = b + acc[ai][bj][m][n]; } }
    }
};
template <bool MOE> struct EpiSwiGLU {
    static constexpr bool PERM = true;
    bf16_t* O; int ld;
    __device__ __forceinline__ void operator()(const f32x4 (&acc)[2][2][4][2], const Unit& u, int wr, int wc, int fr, int fq) const {
        const int row0 = u.pm * BM + wr * 64 + fr, col0 = (MOE ? u.lp : u.pn) * HALF + wc * 32 + 8 * fq;
#pragma unroll
        for (int ai = 0; ai < 2; ++ai)
#pragma unroll
            for (int m = 0; m < 4; ++m) { bf16_t* rowp = O + (size_t)(row0 + ai * HALF + m * 16) * ld + col0;
                f32x4 v0, v1;
#pragma unroll
                for (int j = 0; j < 4; ++j) { const float g0 = acc[ai][0][m][0][j], g1 = acc[ai][0][m][1][j];
                    v0[j] = g0 * sigmoidf_(g0) * acc[ai][1][m][0][j]; v1[j] = g1 * sigmoidf_(g1) * acc[ai][1][m][1][j]; }
                u32x4 w; w.x = cvt_pk_bf16(v0[0], v0[1]); w.y = cvt_pk_bf16(v0[2], v0[3]); w.z = cvt_pk_bf16(v1[0], v1[1]); w.w = cvt_pk_bf16(v1[2], v1[3]);
                *(u32x4*)rowp = w; }
    }
};
struct EpiMoeDown {
    static constexpr bool PERM = false;
    float* X; const int* idx; const float* wgt; const unsigned* cnt;
    __device__ __forceinline__ void operator()(const f32x4 (&acc)[2][2][4][2], const Unit& u, int wr, int wc, int fr, int fq) const {
        const int n = (int)cnt[64 * u.e]; const int col0 = (u.pn & 3) * BM + wc * 32 + 4 * fq;
#pragma unroll
        for (int ai = 0; ai < 2; ++ai)
#pragma unroll
            for (int m = 0; m < 4; ++m) { const int j = u.lp * 256 + ai * HALF + wr * 64 + m * 16 + fr;
                if (j < n) { const int tk = idx[u.e * 32768 + j]; const float w = wgt[u.e * 32768 + j]; float* p = X + (size_t)tk * 1024 + col0;
#pragma unroll
                    for (int bj = 0; bj < 2; ++bj)
#pragma unroll
                        for (int nn = 0; nn < 2; ++nn) { const f32x4 b = *(const f32x4*)(p + bj * HALF + nn * 16); *(f32x4*)(p + bj * HALF + nn * 16) = b + w * acc[ai][bj][m][nn]; } } }
    }
};
template <bool UP> struct MoeOrder {
    static constexpr bool GATHER = UP;
    const char* A; const char* Bt; size_t tstep; const int* idx; const unsigned* cnt; int ps[9]; int NT, G, c;
    __device__ __forceinline__ void init(const void* A_, const void* Bt_, int K, const int* idx_, const unsigned* cnt_, int NT_, int G_, int c_) {
        A = (const char*)A_; Bt = (const char*)Bt_; tstep = (size_t)BM * K * 2; idx = idx_; cnt = cnt_; NT = NT_; G = G_; c = c_; ps[0] = 0;
#pragma unroll
        for (int e = 0; e < 8; ++e) ps[e + 1] = ps[e] + (((int)cnt[64 * e] + 255) >> 8);
    }
    __device__ __forceinline__ bool next(int i, Unit& u) const {
        const int L = i * G + c; if (L >= ps[8] * NT) return false;
        const int p = L / NT, pl = L - p * NT; int e = 0, st = 0;
#pragma unroll
        for (int k = 1; k < 8; ++k) if (p >= ps[k]) { e = k; st = ps[k]; }
        u.pm = p; u.pn = e * NT + pl; u.e = e; u.lp = UP ? pl : (p - st);
        if (UP) u.e = e | ((p - st) << 8);
        return true;
    }
    __device__ __forceinline__ const char* abase(const Unit& u) const { return UP ? A : A + (size_t)u.pm * tstep; }
    __device__ __forceinline__ const char* bbase(const Unit& u) const { return Bt + (size_t)u.pn * tstep; }
    __device__ __forceinline__ unsigned tok(const Unit& u, int r) const { const int e = u.e & 255, lp = u.e >> 8; const int n = (int)cnt[64 * e]; int j = lp * 256 + r; j = j < n ? j : n - 1; return (unsigned)idx[e * 32768 + j]; }
};
}

#define XB_TMO      128
#define XB_XCNT(j)  (256  + 64 * (j))
#define XB_XSUB(j)  (1280 + 64 * (j))
#define XB_XGEN(j)  (2304 + 64 * (j))
#define XB_TOP      3328
#define XB_TOPGEN   3392
#define XCD_BAR_WORDS 3456
#define XB_SPIN_CAP (1u << 18)

__device__ __forceinline__ unsigned xb_ld(unsigned* p)              { return __hip_atomic_load(p, __ATOMIC_RELAXED, __HIP_MEMORY_SCOPE_AGENT); }
__device__ __forceinline__ unsigned xb_add(unsigned* p, unsigned v) { return __hip_atomic_fetch_add(p, v, __ATOMIC_RELAXED, __HIP_MEMORY_SCOPE_AGENT); }
__device__ __forceinline__ unsigned xb_xcc_id() { return (unsigned)__builtin_amdgcn_s_getreg((3 << 11) | 20) & 0xFu; }
#define XB_SPIN(cond, bar) do { unsigned _sp = 0; while (cond) { __builtin_amdgcn_s_sleep(1); \
    if ((++_sp & 255u) == 0u) { if (xb_ld(&(bar)[XB_TMO])) break; if (_sp > XB_SPIN_CAP) { atomicAdd(&(bar)[XB_TMO], 1u); break; } } } } while (0)

struct XcdBarrier { unsigned* bar; unsigned x; volatile LAS unsigned* st; };
__device__ __forceinline__ XcdBarrier xcd_barrier_post(unsigned* bar, volatile LAS unsigned* st, int tid) {
    XcdBarrier b; b.bar = bar; b.x = xb_xcc_id(); b.st = st;
    if (tid == 0) (void)xb_add(&bar[XB_XCNT(b.x)], 1u);
    return b;
}
__device__ __forceinline__ void xcd_barrier_complete(unsigned* bar, unsigned x, unsigned& nloc, unsigned& nx) {
    const unsigned G = gridDim.x * gridDim.y * gridDim.z;
    unsigned sum, cnt, mine, sp = 0u;
    for (;;) {
        sum = 0u; cnt = 0u; mine = 0u;
#pragma unroll
        for (unsigned j = 0; j < 16; ++j) { const unsigned c = xb_ld(&bar[XB_XCNT(j)]); sum += c; cnt += (c > 0u) ? 1u : 0u; mine = (j == x) ? c : mine; }
        if (sum == G) break;
        __builtin_amdgcn_s_sleep(1);
        if ((++sp & 255u) == 0u) { if (xb_ld(&bar[XB_TMO])) break; if (sp > XB_SPIN_CAP) { atomicAdd(&bar[XB_TMO], 1u); break; } }
    }
    nloc = mine > 0u ? mine : 1u; nx = cnt > 0u ? cnt : 1u;
}
__device__ __forceinline__ void xcd_barrier(const XcdBarrier& b, int tid) {
    asm volatile("s_waitcnt vmcnt(0)" ::: "memory");
    __syncthreads();
    if (tid == 0) {
        unsigned* bar = b.bar; asm volatile("" : "+s"(bar));
        __builtin_amdgcn_s_waitcnt(0);
        unsigned nloc = b.st[0], nx = b.st[1];
        if (nloc == 0u) { xcd_barrier_complete(bar, b.x, nloc, nx); b.st[0] = nloc; b.st[1] = nx; }
        const unsigned old = xb_add(&bar[XB_XSUB(b.x)], 1u);
        const unsigned gen = old / nloc;
        if (old + 1u == (gen + 1u) * nloc) {
            __builtin_amdgcn_fence(__ATOMIC_RELEASE, "agent");
            asm volatile("s_waitcnt vmcnt(0)" ::: "memory");
            const unsigned og = xb_add(&bar[XB_TOP], 1u);
            const unsigned tg = og / nx;
            if (og + 1u == (tg + 1u) * nx) xb_add(&bar[XB_TOPGEN], 1u);
            else XB_SPIN(xb_ld(&bar[XB_TOPGEN]) == tg, bar);
            __builtin_amdgcn_fence(__ATOMIC_ACQUIRE, "agent");
            xb_add(&bar[XB_XGEN(b.x)], 1u);
            asm volatile("s_waitcnt vmcnt(0)" ::: "memory");
        } else {
            XB_SPIN(xb_ld(&bar[XB_XGEN(b.x)]) == gen, bar);
            __builtin_amdgcn_fence(__ATOMIC_ACQUIRE, "agent");
            asm volatile("s_waitcnt vmcnt(0)" ::: "memory");
        }
    }
    __syncthreads();
}

struct Args { const float* in[22]; float* out; unsigned char* ws; };
typedef __attribute__((address_space(4))) const unsigned char* karg_t;
__device__ __forceinline__ karg_t kargs() { karg_t p = (karg_t)__builtin_amdgcn_kernarg_segment_ptr(); asm volatile("" : "+s"(p)); return p; }
#define AIN(i) (((const float* const __attribute__((address_space(4)))*)kargs())[i])
#define AOUT() (((float* const __attribute__((address_space(4)))*)kargs())[22])
#define AWS() (((unsigned char* const __attribute__((address_space(4)))*)kargs())[23])
struct Frame {
    LAS unsigned char* lds; unsigned char* ws;
    int tid, lane, wave, vcu, G;
};


template <int O> __device__ __forceinline__ float shx(float v) {
    if constexpr (O < 32) return __int_as_float(__builtin_amdgcn_ds_swizzle(__float_as_int(v), 0x1f | (O << 10)));
    else { auto rr = __builtin_amdgcn_permlane32_swap(__float_as_uint(v), __float_as_uint(v), false, false); const float lo = __uint_as_float(rr[0]), hi = __uint_as_float(rr[1]); return (lo + hi) - v; }
}
template <int O> __device__ __forceinline__ float shx_sum(float v) {
    if constexpr (O < 32) return v + shx<O>(v);
    else { auto rr = __builtin_amdgcn_permlane32_swap(__float_as_uint(v), __float_as_uint(v), false, false); return __uint_as_float(rr[0]) + __uint_as_float(rr[1]); }
}
template <int O> __device__ __forceinline__ float shx_max(float v) {
    if constexpr (O < 32) return fmaxf(v, shx<O>(v));
    else { auto rr = __builtin_amdgcn_permlane32_swap(__float_as_uint(v), __float_as_uint(v), false, false); return fmaxf(__uint_as_float(rr[0]), __uint_as_float(rr[1])); }
}
__device__ __forceinline__ float bperm(int src_lane, float v) { return __int_as_float(__builtin_amdgcn_ds_bpermute(src_lane << 2, __float_as_int(v))); }
__device__ __forceinline__ Frame unit_frame(const Frame& F) { Frame f = F; LAS unsigned char* L = F.lds; asm volatile("" : "+s"(L)); int l = F.lane; asm volatile("" : "+v"(l)); f.lds = L; f.lane = l; f.tid = f.wave * 64 + l; return f; }
__device__ __forceinline__ float wave_sum(float v) { v = shx_sum<1>(v); v = shx_sum<2>(v); v = shx_sum<4>(v); v = shx_sum<8>(v); v = shx_sum<16>(v); v = shx_sum<32>(v); return v; }
__device__ __forceinline__ float wave_max(float v) { v = shx_max<1>(v); v = shx_max<2>(v); v = shx_max<4>(v); v = shx_max<8>(v); v = shx_max<16>(v); v = shx_max<32>(v); return v; }

__device__ __forceinline__ void tr_item(const float* W, int ldw, int k0, int n0, bf16_t* WT, int Kd, int dst_row0, LAS float* scr, int lane) {
#pragma unroll 8
    for (int i = 0; i < 32; ++i) { const int kk = 2 * i + (lane >> 5); scr[kk * 33 + (lane & 31)] = W[(size_t)(k0 + kk) * ldw + n0 + (lane & 31)]; }
    LDS_WAIT(); asm volatile("" ::: "memory");
    const int c = lane & 7;
#pragma unroll
    for (int j = 0; j < 4; ++j) { const int n = (lane >> 3) + 8 * j; const LAS float* s = scr + (8 * c) * 33 + n;
        u32x4 o; o.x = cvt_pk_bf16(s[0 * 33], s[1 * 33]); o.y = cvt_pk_bf16(s[2 * 33], s[3 * 33]); o.z = cvt_pk_bf16(s[4 * 33], s[5 * 33]); o.w = cvt_pk_bf16(s[6 * 33], s[7 * 33]);
        *(GAS u32x4*)(WT + (size_t)(dst_row0 + n) * Kd + k0 + 8 * c) = o; }
    LDS_WAIT(); asm volatile("" ::: "memory");
}
__device__ __forceinline__ void tr_matrix_item(const float* W, int K, int N, int ldw, bf16_t* WT, int Kd, int mode, int bj, int item, LAS float* scr, int lane) {
    const int nblk = N / 32, kb = item / nblk, nb = item % nblk; const int c0 = 32 * nb;
    int n0 = c0, dr = c0;
    if (mode == 1) { n0 = c0 + (c0 >= 2048 ? 8 : 0); }
    if (mode == 2) { dr = 256 * (c0 >> 7) + 128 * bj + (c0 & 127); }
    tr_item(W, ldw, 64 * kb, n0, WT, Kd, dr, scr, lane);
}

__device__ __forceinline__ void p0_convert(Frame& F) {
    LAS float* scr = (LAS float*)(F.lds + F.wave * 8704);
    const int gw = F.vcu * 8 + F.wave, NGW = F.G * 8;
    constexpr int I_IN = 16 * (NIN / 32), I_BR = 8 * 32, I_OUT = 16 * 32, I_GU = 16 * (DFF / 32), I_D = (DFF / 64) * 32;
    constexpr int NITEMS = 2 * I_IN + 4 * I_BR + 2 * I_OUT + 2 * I_GU + I_D;
    for (int it = gw; it < NITEMS; it += NGW) {
        int r = it;
        if (r < 2 * I_IN) { const int l = r / I_IN; tr_matrix_item(AIN(3) + (size_t)l * DM * INW, DM, NIN, INW, (bf16_t*)(F.ws + WS_WIN) + (size_t)l * NIN * DM, DM, 1, 0, r % I_IN, scr, F.lane); continue; } r -= 2 * I_IN;
        if (r < 2 * I_BR) { const int l = r / I_BR; tr_matrix_item(AIN(11) + (size_t)l * 512 * DM, 512, DM, DM, (bf16_t*)(F.ws + WS_WA) + (size_t)l * DM * 512, 512, 0, 0, r % I_BR, scr, F.lane); continue; } r -= 2 * I_BR;
        if (r < 2 * I_BR) { const int l = r / I_BR; tr_matrix_item(AIN(12) + (size_t)l * 512 * DM, 512, DM, DM, (bf16_t*)(F.ws + WS_WB) + (size_t)l * DM * 512, 512, 0, 0, r % I_BR, scr, F.lane); continue; } r -= 2 * I_BR;
        if (r < 2 * I_OUT) { const int l = r / I_OUT; tr_matrix_item(AIN(13) + (size_t)l * DM * DM, DM, DM, DM, (bf16_t*)(F.ws + WS_WOUT) + (size_t)l * DM * DM, DM, 0, 0, r % I_OUT, scr, F.lane); continue; } r -= 2 * I_OUT;
        if (r < I_GU) { tr_matrix_item(AIN(15), DM, DFF, DFF, (bf16_t*)(F.ws + WS_WGU), DM, 2, 0, r, scr, F.lane); continue; } r -= I_GU;
        if (r < I_GU) { tr_matrix_item(AIN(16), DM, DFF, DFF, (bf16_t*)(F.ws + WS_WGU), DM, 2, 1, r, scr, F.lane); continue; } r -= I_GU;
        tr_matrix_item(AIN(17), DFF, DM, DM, (bf16_t*)(F.ws + WS_WD), DFF, 0, 0, r, scr, F.lane);
    }
}
__device__ __forceinline__ void p_convert_experts(Frame& F) {
    LAS float* scr = (LAS float*)(F.lds + F.wave * 8704);
    const int gw = F.vcu * 8 + F.wave, NGW = F.G * 8;
    constexpr int I_GU = 16 * (EFF / 32), I_D = (EFF / 64) * 32, I_E = 2 * I_GU + I_D;
    for (int it = gw; it < 8 * I_E; it += NGW) {
        const int e = it / I_E; int r = it % I_E;
        bf16_t* gu = (bf16_t*)(F.ws + WS_WGUE) + (size_t)e * 2 * EFF * DM; bf16_t* wd = (bf16_t*)(F.ws + WS_WDE) + (size_t)e * DM * EFF;
        if (r < I_GU) { tr_matrix_item(AIN(19) + (size_t)e * DM * EFF, DM, EFF, EFF, gu, DM, 2, 0, r, scr, F.lane); continue; } r -= I_GU;
        if (r < I_GU) { tr_matrix_item(AIN(20) + (size_t)e * DM * EFF, DM, EFF, EFF, gu, DM, 2, 1, r, scr, F.lane); continue; } r -= I_GU;
        tr_matrix_item(AIN(21) + (size_t)e * EFF * DM, EFF, DM, DM, wd, EFF, 0, 0, r, scr, F.lane);
    }
}

template <int MODE>
__device__ __forceinline__ void norm_pass(Frame& F, const float* X, const float* gain, const float* W8, int ldw8, const float* bi, const float* bf) {
    LAS float* w8 = (LAS float*)F.lds;
    if (MODE != 1) {
        for (int i = F.tid; i < 1024 * 8; i += 512) w8[i] = W8[(size_t)(i >> 3) * ldw8 + (i & 7)];
        __syncthreads();
    }
    bf16_t* XN = (bf16_t*)(F.ws + WS_XN);
    const int gw = F.vcu * 8 + F.wave, NGW = F.G * 8;
    f32x4 gv[4];
#pragma unroll
    for (int j = 0; j < 4; ++j) gv[j] = *(const f32x4*)(gain + 4 * F.lane + 256 * j);
    for (int m = gw; m < MTOK; m += NGW) {
        const f32x4* xr = (const f32x4*)(X + (size_t)m * DM) + F.lane;
        f32x4 v[4]; float s = 0.f;
#pragma unroll
        for (int j = 0; j < 4; ++j) { v[j] = xr[64 * j]; s += (v[j].x * v[j].x + v[j].y * v[j].y) + (v[j].z * v[j].z + v[j].w * v[j].w); }
        const float r = 1.0f / sqrtf(wave_sum(s) * (1.f / DM) + EPS);
#pragma unroll
        for (int j = 0; j < 4; ++j) v[j] = v[j] * r * gv[j];
        unsigned long long* o8 = (unsigned long long*)(XN + (size_t)m * DM) + F.lane;
#pragma unroll
        for (int j = 0; j < 4; ++j) o8[64 * j] = (unsigned long long)cvt_pk_bf16(v[j].x, v[j].y) | ((unsigned long long)cvt_pk_bf16(v[j].z, v[j].w) << 32);
        if (MODE != 1) {
            float d[8];
#pragma unroll
            for (int c = 0; c < 8; ++c) d[c] = 0.f;
#pragma unroll
            for (int j = 0; j < 4; ++j)
#pragma unroll
                for (int q = 0; q < 4; ++q) { const LAS float* wp = w8 + (4 * F.lane + 256 * j + q) * 8; const f32x4 wa = *(const LAS f32x4*)wp, wb = *(const LAS f32x4*)(wp + 4); const float y = v[j][q];
                    d[0] += y * wa.x; d[1] += y * wa.y; d[2] += y * wa.z; d[3] += y * wa.w; d[4] += y * wb.x; d[5] += y * wb.y; d[6] += y * wb.z; d[7] += y * wb.w; }
#pragma unroll
            for (int c = 0; c < 8; ++c) d[c] = wave_sum(d[c]);
            if (MODE == 0) {
                if (F.lane < 8) { float val = 0.f;
#pragma unroll
                    for (int c = 0; c < 8; ++c) val = (F.lane == c) ? d[c] : val;
                    float o;
                    if (F.lane < 4) o = val + bi[F.lane];
                    else { const float fp = val + bf[F.lane - 4]; o = fminf(fp, 0.f) - log1pf(__expf(-fabsf(fp))); }
                    ((float*)(F.ws + WS_GATES))[(size_t)m * 8 + F.lane] = o; }
            } else {
                int e1 = 0; float v1 = d[0];
#pragma unroll
                for (int c = 1; c < 8; ++c) if (d[c] > v1) { v1 = d[c]; e1 = c; }
                int e2 = -1; float v2 = -INFINITY;
#pragma unroll
                for (int c = 0; c < 8; ++c) if (c != e1 && d[c] > v2) { v2 = d[c]; e2 = c; }
                const float ex = __expf(v2 - v1), w1 = 1.0f / (1.0f + ex), w2 = ex * w1;
                if (F.lane < 2) { const int e = F.lane == 0 ? e1 : e2; const float w = F.lane == 0 ? w1 : w2;
                    const unsigned pos = __hip_atomic_fetch_add(((unsigned*)F.ws + CW_MOE + 64 * (F.lane * 8 + e)), 1u, __ATOMIC_RELAXED, __HIP_MEMORY_SCOPE_AGENT);
                    ((int*)(F.ws + WS_MIDX))[(size_t)(F.lane * 8 + e) * 32768 + pos] = m; ((float*)(F.ws + WS_MWGT))[(size_t)(F.lane * 8 + e) * 32768 + pos] = w; }
            }
        }
    }
    __syncthreads();
}

__device__ __forceinline__ void moba_prep_item(const Frame& F0, int it, const float* qg, const float* kg) {
    Frame F = unit_frame(F0);
    const int h = it & 7, blk = (it >> 3) & 15, b = it >> 7;
    const size_t r0 = (size_t)b * SEQ + blk * ABLK;
    const int row = F.tid >> 1, half = F.tid & 1;
    LAS float* part = (LAS float*)F.lds;
    bf16_t* qp = (bf16_t*)(F.ws + WS_AQ) + (r0 + row) * 512 + h * 64 + half * 32;
    bf16_t* kp = (bf16_t*)(F.ws + WS_AK) + (r0 + row) * 512 + h * 64 + half * 32;
    float gq[32], gk[32];
#pragma unroll
    for (int i = 0; i < 32; ++i) { gq[i] = qg[half * 32 + i] * QSCALE; gk[i] = kg[half * 32 + i]; }
    {
        u32x4 w[4]; float x[32]; float ss = 0.f;
#pragma unroll
        for (int i = 0; i < 4; ++i) w[i] = ((const u32x4*)qp)[i];
#pragma unroll
        for (int i = 0; i < 4; ++i) { x[8 * i + 0] = bf_lo(w[i].x); x[8 * i + 1] = bf_hi(w[i].x); x[8 * i + 2] = bf_lo(w[i].y); x[8 * i + 3] = bf_hi(w[i].y); x[8 * i + 4] = bf_lo(w[i].z); x[8 * i + 5] = bf_hi(w[i].z); x[8 * i + 6] = bf_lo(w[i].w); x[8 * i + 7] = bf_hi(w[i].w); }
#pragma unroll
        for (int i = 0; i < 32; ++i) ss += x[i] * x[i];
        ss = shx_sum<1>(ss);
        const float r = 1.0f / sqrtf(ss * (1.f / 64.f) + EPS);
#pragma unroll
        for (int i = 0; i < 4; ++i) { u32x4 o; o.x = cvt_pk_bf16(x[8 * i] * r * gq[8 * i], x[8 * i + 1] * r * gq[8 * i + 1]); o.y = cvt_pk_bf16(x[8 * i + 2] * r * gq[8 * i + 2], x[8 * i + 3] * r * gq[8 * i + 3]);
            o.z = cvt_pk_bf16(x[8 * i + 4] * r * gq[8 * i + 4], x[8 * i + 5] * r * gq[8 * i + 5]); o.w = cvt_pk_bf16(x[8 * i + 6] * r * gq[8 * i + 6], x[8 * i + 7] * r * gq[8 * i + 7]); ((u32x4*)qp)[i] = o; }
    }
    {
        u32x4 w[4]; float x[32]; float ss = 0.f;
#pragma unroll
        for (int i = 0; i < 4; ++i) w[i] = ((const u32x4*)kp)[i];
#pragma unroll
        for (int i = 0; i < 4; ++i) { x[8 * i + 0] = bf_lo(w[i].x); x[8 * i + 1] = bf_hi(w[i].x); x[8 * i + 2] = bf_lo(w[i].y); x[8 * i + 3] = bf_hi(w[i].y); x[8 * i + 4] = bf_lo(w[i].z); x[8 * i + 5] = bf_hi(w[i].z); x[8 * i + 6] = bf_lo(w[i].w); x[8 * i + 7] = bf_hi(w[i].w); }
#pragma unroll
        for (int i = 0; i < 32; ++i) ss += x[i] * x[i];
        ss = shx_sum<1>(ss);
        const float r = 1.0f / sqrtf(ss * (1.f / 64.f) + EPS);
#pragma unroll
        for (int i = 0; i < 32; ++i) x[i] = x[i] * r * gk[i];
#pragma unroll
        for (int i = 0; i < 4; ++i) { u32x4 o; o.x = cvt_pk_bf16(x[8 * i], x[8 * i + 1]); o.y = cvt_pk_bf16(x[8 * i + 2], x[8 * i + 3]); o.z = cvt_pk_bf16(x[8 * i + 4], x[8 * i + 5]); o.w = cvt_pk_bf16(x[8 * i + 6], x[8 * i + 7]); ((u32x4*)kp)[i] = o; }
#pragma unroll
        for (int i = 0; i < 32; ++i) { float s = x[i]; s = shx_sum<2>(s); s = shx_sum<4>(s); s = shx_sum<8>(s); s = shx_sum<16>(s); s = shx_sum<32>(s); x[i] = s; }
        if (F.lane < 2) {
#pragma unroll
            for (int i = 0; i < 32; ++i) part[F.wave * 64 + half * 32 + i] = x[i]; }
    }
    __syncthreads();
    if (F.tid < 64) { float s = 0.f;
#pragma unroll
        for (int w = 0; w < 8; ++w) s += part[w * 64 + F.tid];
        ((float*)(F.ws + WS_KMEAN))[((size_t)(b * 8 + h) * 16 + blk) * 64 + F.tid] = s * (1.f / 256.f); }
    __syncthreads();
}

constexpr int ML_TILE = 128 * 272;
constexpr int ML_Q = 0, ML_K = ML_TILE, ML_VT = 2 * ML_TILE, ML_CT = 3 * ML_TILE, ML_TAB = 4 * ML_TILE;
constexpr int MT_BB = 0, MT_U = 1, MT_M = 2, MT_WST = 3, MT_LIM = 4, MT_N = 5, MT_QN = 6, MT_INV = 7, MT_WS = 8, MT_SC = 9;
static_assert(ML_TAB + 10 * 512 <= MISC_OFF, "mLSTM LDS map");

__device__ __forceinline__ void ml_scalars(Frame& F, size_t r0, int h, LAS float* tab, float& umax_out, float& blast_out) {
    const float* G = (const float*)(F.ws + WS_GATES);
    const int l = F.lane;
    const float i0 = G[(r0 + 2 * l) * 8 + h], i1 = G[(r0 + 2 * l + 1) * 8 + h];
    const float f0 = G[(r0 + 2 * l) * 8 + 4 + h], f1 = G[(r0 + 2 * l + 1) * 8 + 4 + h];
    float ps = f0 + f1, sc = ps;
#pragma unroll
    for (int o = 1; o < 64; o <<= 1) { const float t = bperm(l >= o ? l - o : l, sc); if (l >= o) sc += t; }
    const float ex = sc - ps;
    const float b0 = ex + f0, b1 = ex + ps;
    const float u0 = i0 - b0, u1 = i1 - b1;
    float pm = fmaxf(u0, u1), sm = pm;
#pragma unroll
    for (int o = 1; o < 64; o <<= 1) { const float t = bperm(l >= o ? l - o : l, sm); if (l >= o) sm = fmaxf(sm, t); }
    const float pe = bperm(l >= 1 ? l - 1 : l, sm);
    const float p0 = (l == 0) ? u0 : fmaxf(pe, u0), p1 = fmaxf(p0, u1);
    tab[MT_BB * 128 + 2 * l] = b0; tab[MT_BB * 128 + 2 * l + 1] = b1;
    tab[MT_U * 128 + 2 * l] = u0; tab[MT_U * 128 + 2 * l + 1] = u1;
    tab[MT_M * 128 + 2 * l] = p0; tab[MT_M * 128 + 2 * l + 1] = p1;
    umax_out = __int_as_float(__builtin_amdgcn_readlane(__float_as_int(sm), 63)); blast_out = __int_as_float(__builtin_amdgcn_readlane(__float_as_int(sc), 63));
}
template <bool TR>
__device__ __forceinline__ void ml_stage_conv(Frame& F, LAS unsigned char* tile, size_t r0, int tpos0, int col0, const float* cw, const float* cb, float scale) {
    const bf16_t* src = (const bf16_t*)(F.ws + WS_MQK);
    const int cg = F.tid & 15, rg = F.tid >> 4;
    float w[4][8], bias[8];
#pragma unroll
    for (int j = 0; j < 4; ++j)
#pragma unroll
        for (int i = 0; i < 8; ++i) w[j][i] = cw[j * 1024 + col0 + cg * 8 + i];
#pragma unroll
    for (int i = 0; i < 8; ++i) bias[i] = cb[col0 + cg * 8 + i];
    float x[7][8];
#pragma unroll
    for (int j = 0; j < 7; ++j) { const int rr = 4 * rg - 3 + j;
        if (tpos0 + rr >= 0) { const u32x4 v = *(const u32x4*)(src + (size_t)((long)r0 + rr) * 1024 + col0 + cg * 8);
            x[j][0] = bf_lo(v.x); x[j][1] = bf_hi(v.x); x[j][2] = bf_lo(v.y); x[j][3] = bf_hi(v.y); x[j][4] = bf_lo(v.z); x[j][5] = bf_hi(v.z); x[j][6] = bf_lo(v.w); x[j][7] = bf_hi(v.w); }
        else {
#pragma unroll
            for (int i = 0; i < 8; ++i) x[j][i] = 0.f; } }
#pragma unroll
    for (int rr = 0; rr < 4; ++rr) { float y[8];
#pragma unroll
        for (int i = 0; i < 8; ++i) { float a = bias[i] + w[0][i] * x[rr][i] + w[1][i] * x[rr + 1][i] + w[2][i] * x[rr + 2][i] + w[3][i] * x[rr + 3][i]; y[i] = a * sigmoidf_(a) * scale; }
        const int row = 4 * rg + rr;
        if (!TR) { u32x4 o; o.x = cvt_pk_bf16(y[0], y[1]); o.y = cvt_pk_bf16(y[2], y[3]); o.z = cvt_pk_bf16(y[4], y[5]); o.w = cvt_pk_bf16(y[6], y[7]); *(LAS u32x4*)(tile + row * 272 + cg * 16) = o; }
        else {
#pragma unroll
            for (int i = 0; i < 8; i += 2) { const unsigned pk = cvt_pk_bf16(y[i], y[i + 1]); *(LAS bf16_t*)(tile + (cg * 8 + i) * 272 + row * 2) = (bf16_t)(pk & 0xffffu); *(LAS bf16_t*)(tile + (cg * 8 + i + 1) * 272 + row * 2) = (bf16_t)(pk >> 16); } }
    }
}
__device__ __forceinline__ void ml_stage_vt(Frame& F, LAS unsigned char* tile, size_t r0, int col0, const LAS float* rs) {
    const bf16_t* src = (const bf16_t*)(F.ws + WS_MV);
    const int cg = F.tid & 15, rg = F.tid >> 4;
#pragma unroll
    for (int rr = 0; rr < 4; ++rr) { const int row = 4 * rg + rr; const u32x4 v = *(const u32x4*)(src + (r0 + row) * 512 + col0 + cg * 8);
        float y[8] = {bf_lo(v.x), bf_hi(v.x), bf_lo(v.y), bf_hi(v.y), bf_lo(v.z), bf_hi(v.z), bf_lo(v.w), bf_hi(v.w)};
        const float sc = rs ? rs[row] : 1.0f;
#pragma unroll
        for (int i = 0; i < 8; i += 2) { const unsigned pk = cvt_pk_bf16(y[i] * sc, y[i + 1] * sc); *(LAS bf16_t*)(tile + (cg * 8 + i) * 272 + row * 2) = (bf16_t)(pk & 0xffffu); *(LAS bf16_t*)(tile + (cg * 8 + i + 1) * 272 + row * 2) = (bf16_t)(pk >> 16); } }
}
#define SYNC_SB() do { __syncthreads(); __builtin_amdgcn_sched_barrier(0); } while (0)
#define MFMA32(a, b, c) __builtin_amdgcn_mfma_f32_32x32x16_bf16(a, b, c, 0, 0, 0)
__device__ __forceinline__ void ml_mma(LAS unsigned char* TA, LAS unsigned char* TB, int rb, int cb, int lane, f32x16& c0, f32x16& c1) {
    const int r32 = lane & 31, hi = lane >> 5;
#pragma unroll 2
    for (int k = 0; k < 8; ++k) {
        const bf16x8 a = *(const LAS bf16x8*)(TA + (rb + r32) * 272 + k * 32 + hi * 16);
        const bf16x8 b0 = *(const LAS bf16x8*)(TB + (cb + r32) * 272 + k * 32 + hi * 16);
        const bf16x8 b1 = *(const LAS bf16x8*)(TB + (cb + 32 + r32) * 272 + k * 32 + hi * 16);
        c0 = MFMA32(a, b0, c0); c1 = MFMA32(a, b1, c1);
    }
}


__device__ __forceinline__ float ml_dot32(const LAS unsigned char* row, const LAS float* tabv) {
    float s = 0.f;
#pragma unroll 1
    for (int q = 0; q < 4; ++q) { const u32x4 w = *(const LAS u32x4*)(row + q * 16);
        if (tabv) { const f32x4 a = *(const LAS f32x4*)(tabv + q * 8), b = *(const LAS f32x4*)(tabv + q * 8 + 4);
            s += bf_lo(w.x) * a.x + bf_hi(w.x) * a.y + bf_lo(w.y) * a.z + bf_hi(w.y) * a.w + bf_lo(w.z) * b.x + bf_hi(w.z) * b.y + bf_lo(w.w) * b.z + bf_hi(w.w) * b.w; }
        else s += (bf_lo(w.x) + bf_hi(w.x)) + (bf_lo(w.y) + bf_hi(w.y)) + (bf_lo(w.z) + bf_hi(w.z)) + (bf_lo(w.w) + bf_hi(w.w)); }
    return s;
}
__device__ __forceinline__ void mlstm_local(const Frame& F0, int unit, const float* cw, const float* cb) {
    Frame F = unit_frame(F0);
    const int c = unit & 31, h = (unit >> 5) & 3, b = unit >> 7;
    const size_t r0 = (size_t)b * SEQ + c * MCH;
    LAS float* tab = (LAS float*)(F.lds + ML_TAB);
    if (F.wave == 0) { float umax, blast; ml_scalars(F, r0, h, tab, umax, blast);
        tab[MT_WS * 128 + 2 * F.lane] = __expf(tab[MT_U * 128 + 2 * F.lane] - umax); tab[MT_WS * 128 + 2 * F.lane + 1] = __expf(tab[MT_U * 128 + 2 * F.lane + 1] - umax);
        if (F.lane == 0) { float* sc = (float*)(F.ws + WS_MSC); sc[unit] = umax; sc[1024 + unit] = blast; } }
    SYNC_SB();
    ml_stage_conv<true>(F, F.lds + ML_K, r0, c * MCH, 512 + h * 128, cw, cb, 0.08838834764831845f);
    __builtin_amdgcn_sched_barrier(0);
    ml_stage_vt(F, F.lds + ML_VT, r0, h * 128, tab + MT_WS * 128);
    SYNC_SB();
    {
        f32x16 c0 = {}, c1 = {}; const int rb = 32 * (F.wave & 3), cbk = 64 * (F.wave >> 2);
        ml_mma(F.lds + ML_VT, F.lds + ML_K, rb, cbk, F.lane, c0, c1);
        float* U = (float*)(F.ws + WS_XN) + (size_t)unit * 16384; const int r32 = F.lane & 31, hi = F.lane >> 5;
#pragma unroll
        for (int r = 0; r < 16; ++r) { const int e = rb + crow(r, hi); U[e * 128 + cbk + r32] = c0[r]; U[e * 128 + cbk + 32 + r32] = c1[r]; }
    }
    {
        const int d = F.tid >> 2, part = F.tid & 3; float s = ml_dot32(F.lds + ML_K + d * 272 + part * 64, tab + MT_WS * 128 + part * 32);
        s = shx_sum<1>(s); s = shx_sum<2>(s);
        if (part == 0) ((float*)(F.ws + WS_UN))[(size_t)unit * 128 + d] = s;
    }
    SYNC_SB();
}
__device__ __forceinline__ void mlstm_scan(const Frame& F0, int bh, int slice) {
    Frame F = unit_frame(F0);
    const float* sc = (const float*)(F.ws + WS_MSC);
    const float* U = (const float*)(F.ws + WS_XN); bf16_t* C = (bf16_t*)(F.ws + WS_CST);
    const int eoff = slice * 2048 + F.tid * 4;
    f32x4 cst = {0.f, 0.f, 0.f, 0.f}; float nst = 0.f; float m = 0.f;
    const bool don = (slice == 0) && (F.tid < 128);
    for (int c = 0; c < NCH; ++c) { const int unit = bh * 32 + c;
        *(u32x2*)(C + (size_t)unit * 16384 + eoff) = (u32x2){cvt_pk_bf16(cst.x, cst.y), cvt_pk_bf16(cst.z, cst.w)};
        if (don) ((float*)(F.ws + WS_NST))[(size_t)unit * 128 + F.tid] = nst;
        if (slice == 0 && F.tid == 0) ((float*)(F.ws + WS_MSC))[2048 + unit] = m;
        const float umax = sc[unit], blast = sc[1024 + unit];
        const float Mx = fmaxf(m, umax); const float dc = __expf(m - Mx), du = __expf(umax - Mx);
        const f32x4 u = *(const f32x4*)(U + (size_t)unit * 16384 + eoff);
        cst = cst * dc + u * du;
        if (don) nst = nst * dc + ((const float*)(F.ws + WS_UN))[(size_t)unit * 128 + F.tid] * du;
        m = blast + Mx;
    }
}
__device__ __forceinline__ void mlstm_out(const Frame& F0, int unit, const float* cw, const float* cb, const float* ng) {
    Frame F = unit_frame(F0);
    const int c = unit & 31, h = (unit >> 5) & 3, b = unit >> 7;
    const size_t r0 = (size_t)b * SEQ + c * MCH;
    LAS float* tab = (LAS float*)(F.lds + ML_TAB);
    const float m = ((const float*)(F.ws + WS_MSC))[2048 + unit];
    if (F.wave == 0) { float umax, blast; ml_scalars(F, r0, h, tab, umax, blast);
#pragma unroll
        for (int q = 0; q < 2; ++q) { const int t = 2 * F.lane + q; const float Mt = fmaxf(m, tab[MT_M * 128 + t]);
            tab[MT_M * 128 + t] = Mt; tab[MT_WST * 128 + t] = __expf(m - Mt); tab[MT_LIM * 128 + t] = __expf(-tab[MT_BB * 128 + t] - Mt); } }
    if (F.tid >= 64 && F.tid < 192) tab[MT_N * 128 + F.tid - 64] = ((const float*)(F.ws + WS_NST))[(size_t)unit * 128 + F.tid - 64];
    __builtin_amdgcn_sched_barrier(0);
    ml_stage_conv<false>(F, F.lds + ML_Q, r0, c * MCH, h * 128, cw, cb, 1.0f);
    __builtin_amdgcn_sched_barrier(0);
    ml_stage_conv<false>(F, F.lds + ML_K, r0, c * MCH, 512 + h * 128, cw, cb, 0.08838834764831845f);
    __builtin_amdgcn_sched_barrier(0);
    ml_stage_vt(F, F.lds + ML_VT, r0, h * 128, nullptr);
    __builtin_amdgcn_sched_barrier(0);
    {
        const bf16_t* C = (const bf16_t*)(F.ws + WS_CST) + (size_t)unit * 16384;
#pragma unroll
        for (int i = 0; i < 4; ++i) { const int q = F.tid + 512 * i; const int e = q >> 4, ch = q & 15; *(LAS u32x4*)(F.lds + ML_CT + e * 272 + ch * 16) = *(const u32x4*)(C + e * 128 + ch * 8); }
    }
    SYNC_SB();
    const int rb = 32 * (F.wave & 3), cbk = 64 * (F.wave >> 2), r32 = F.lane & 31, hi = F.lane >> 5;
    f32x16 s0 = {}, s1 = {};
    ml_mma(F.lds + ML_Q, F.lds + ML_K, rb, cbk, F.lane, s0, s1);
    {
        const float u0 = tab[MT_U * 128 + cbk + r32], u1 = tab[MT_U * 128 + cbk + 32 + r32];
#pragma unroll
        for (int r = 0; r < 16; ++r) { const int t = rb + crow(r, hi); const float Mt = tab[MT_M * 128 + t];
            s0[r] = (cbk + r32 <= t) ? s0[r] * __expf(u0 - Mt) : 0.f; s1[r] = (cbk + 32 + r32 <= t) ? s1[r] * __expf(u1 - Mt) : 0.f; }
    }
    {
        const int t = F.tid >> 2, part = F.tid & 3; float s = ml_dot32(F.lds + ML_Q + t * 272 + part * 64, tab + MT_N * 128 + part * 32);
        s = shx_sum<1>(s); s = shx_sum<2>(s);
        if (part == 0) tab[MT_QN * 128 + t] = s;
    }
    SYNC_SB();
#pragma unroll
    for (int r = 0; r < 16; r += 2) {
        const unsigned pa = cvt_pk_bf16(s0[r], s0[r + 1]), pb = cvt_pk_bf16(s1[r], s1[r + 1]);
        const int t0 = rb + crow(r, hi), t1 = rb + crow(r + 1, hi);
        *(LAS bf16_t*)(F.lds + ML_K + t0 * 272 + (cbk + r32) * 2) = (bf16_t)(pa & 0xffffu); *(LAS bf16_t*)(F.lds + ML_K + t1 * 272 + (cbk + r32) * 2) = (bf16_t)(pa >> 16);
        *(LAS bf16_t*)(F.lds + ML_K + t0 * 272 + (cbk + 32 + r32) * 2) = (bf16_t)(pb & 0xffffu); *(LAS bf16_t*)(F.lds + ML_K + t1 * 272 + (cbk + 32 + r32) * 2) = (bf16_t)(pb >> 16);
    }
    SYNC_SB();
    f32x16 p0 = {}, p1 = {}, q0 = {}, q1 = {};
    ml_mma(F.lds + ML_K, F.lds + ML_VT, rb, cbk, F.lane, p0, p1);
    __builtin_amdgcn_sched_barrier(0);
    ml_mma(F.lds + ML_Q, F.lds + ML_CT, rb, cbk, F.lane, q0, q1);
    {
        const int t = F.tid >> 2, part = F.tid & 3; float s = ml_dot32(F.lds + ML_K + t * 272 + part * 64, nullptr);
        s = shx_sum<1>(s); s = shx_sum<2>(s);
        if (part == 0) { const float den = s + tab[MT_WST * 128 + t] * tab[MT_QN * 128 + t]; tab[MT_INV * 128 + t] = 1.0f / fmaxf(fabsf(den), tab[MT_LIM * 128 + t]); }
    }
    SYNC_SB();
    LAS float* H = (LAS float*)(F.lds + ML_Q);
#pragma unroll
    for (int r = 0; r < 16; ++r) { const int t = rb + crow(r, hi); const float w = tab[MT_WST * 128 + t], iv = tab[MT_INV * 128 + t];
        H[t * 132 + cbk + r32] = (p0[r] + w * q0[r]) * iv; H[t * 132 + cbk + 32 + r32] = (p1[r] + w * q1[r]) * iv; }
    SYNC_SB();
    {
        const int t = F.tid >> 2, part = F.tid & 3;
        bf16_t* op = (bf16_t*)(F.ws + WS_MO) + (r0 + t) * 512 + h * 128 + part * 32;
        float x[32]; float ss = 0.f;
#pragma unroll
        for (int i = 0; i < 4; ++i) { const u32x4 g = ((const u32x4*)op)[i]; const LAS float* hp = H + t * 132 + part * 32 + 8 * i;
            x[8 * i] = hp[0] * bf_lo(g.x); x[8 * i + 1] = hp[1] * bf_hi(g.x); x[8 * i + 2] = hp[2] * bf_lo(g.y); x[8 * i + 3] = hp[3] * bf_hi(g.y);
            x[8 * i + 4] = hp[4] * bf_lo(g.z); x[8 * i + 5] = hp[5] * bf_hi(g.z); x[8 * i + 6] = hp[6] * bf_lo(g.w); x[8 * i + 7] = hp[7] * bf_hi(g.w); }
#pragma unroll
        for (int i = 0; i < 32; ++i) ss += x[i] * x[i];
        ss = shx_sum<1>(ss); ss = shx_sum<2>(ss);
        const float r = 1.0f / sqrtf(ss * (1.f / 128.f) + EPS);
        const float* gp = ng + h * 128 + part * 32;
#pragma unroll
        for (int i = 0; i < 4; ++i) { u32x4 o; o.x = cvt_pk_bf16(x[8 * i] * r * gp[8 * i], x[8 * i + 1] * r * gp[8 * i + 1]); o.y = cvt_pk_bf16(x[8 * i + 2] * r * gp[8 * i + 2], x[8 * i + 3] * r * gp[8 * i + 3]);
            o.z = cvt_pk_bf16(x[8 * i + 4] * r * gp[8 * i + 4], x[8 * i + 5] * r * gp[8 * i + 5]); o.w = cvt_pk_bf16(x[8 * i + 6] * r * gp[8 * i + 6], x[8 * i + 7] * r * gp[8 * i + 7]); ((u32x4*)op)[i] = o; }
    }
    SYNC_SB();
}

constexpr int AT_K = 0, AT_VT = 9216, AT_TB = 18432, AT_KM = 22528, AT_OST = 26624;
__device__ __forceinline__ void moba_unit(const Frame& F0, int bh, int qb, const float* rel_bias) {
    Frame F = unit_frame(F0);
    const int b = bh >> 3, h = bh & 7;
    const int r32 = F.lane & 31, hi = F.lane >> 5, w = F.wave;
    const size_t rowb = (size_t)b * SEQ;
    const bf16_t* Q = (const bf16_t*)(F.ws + WS_AQ); const bf16_t* Kg = (const bf16_t*)(F.ws + WS_AK); const bf16_t* Vg = (const bf16_t*)(F.ws + WS_AV);
    LAS float* TB = (LAS float*)(F.lds + AT_TB); LAS float* KM = (LAS float*)(F.lds + AT_KM);
    for (int d = F.tid; d < 1024; d += 512) { int bk;
        if (d < 16) bk = d; else { bk = 16 + (d >= 21) + (d >= 27) + (d >= 35) + (d >= 46) + (d >= 59) + (d >= 77) + (d >= 99) + (d >= 128) + (d >= 166) + (d >= 216) + (d >= 280) + (d >= 363) + (d >= 470) + (d >= 609) + (d >= 790); }
        TB[d] = rel_bias[bk * 8 + h] * LOG2E; }
    for (int i = F.tid; i < 1024; i += 512) KM[i] = ((const float*)(F.ws + WS_KMEAN))[(size_t)bh * 1024 + i];
    const int q0 = qb * ABLK + w * 32;
    bf16x8 qr[4];
#pragma unroll
    for (int d0 = 0; d0 < 4; ++d0) qr[d0] = *(const bf16x8*)(Q + (rowb + q0 + r32) * 512 + h * 64 + d0 * 16 + hi * 8);
    __syncthreads();
    unsigned selmask = 0u;
    {
        float g[16];
#pragma unroll
        for (int j = 0; j < 16; ++j) { float s = 0.f;
#pragma unroll
            for (int d0 = 0; d0 < 4; ++d0)
#pragma unroll
                for (int i = 0; i < 8; ++i) s += bf2f((bf16_t)qr[d0][i]) * KM[j * 64 + d0 * 16 + hi * 8 + i];
            s = shx_sum<32>(s); g[j] = (j < qb) ? s : -INFINITY; }
#pragma unroll
        for (int k = 0; k < 3; ++k) { float best = -INFINITY; int bi = -1;
#pragma unroll
            for (int j = 0; j < 16; ++j) if (!((selmask >> j) & 1u) && g[j] > best) { best = g[j]; bi = j; }
            if (bi >= 0) selmask |= 1u << bi; }
    }
    float mrun = -INFINITY, lrun = 0.f; f32x16 o0 = {}, o1 = {};
    for (int jj = 0; jj <= qb; ++jj) {
        const int j = qb - jj;
        const bool own = (jj == 0);
        const bool mine = own || ((selmask >> j) & 1u);
        const bool wave_any = __any(mine);
        for (int tl = 0; tl < 4; ++tl) {
            const int kpos0 = j * ABLK + tl * 64;
            __syncthreads();
            {
                const int row = F.tid >> 3, ch = F.tid & 7;
                *(LAS u32x4*)(F.lds + AT_K + row * 144 + ch * 16) = *(const u32x4*)(Kg + (rowb + kpos0 + row) * 512 + h * 64 + ch * 8);
                const u32x4 v = *(const u32x4*)(Vg + (rowb + kpos0 + row) * 512 + h * 64 + ch * 8);
                const unsigned vv[4] = {v.x, v.y, v.z, v.w};
#pragma unroll
                for (int i = 0; i < 4; ++i) { *(LAS bf16_t*)(F.lds + AT_VT + (ch * 8 + 2 * i) * 144 + row * 2) = (bf16_t)(vv[i] & 0xffffu); *(LAS bf16_t*)(F.lds + AT_VT + (ch * 8 + 2 * i + 1) * 144 + row * 2) = (bf16_t)(vv[i] >> 16); }
            }
            __syncthreads();
            if (!wave_any) continue;
            if (own && kpos0 > q0 + 31) continue;
            f32x16 p0 = {}, p1 = {};
#pragma unroll
            for (int d0 = 0; d0 < 4; ++d0) {
                const bf16x8 k0 = *(const LAS bf16x8*)(F.lds + AT_K + r32 * 144 + d0 * 32 + hi * 16);
                const bf16x8 k1 = *(const LAS bf16x8*)(F.lds + AT_K + (32 + r32) * 144 + d0 * 32 + hi * 16);
                p0 = MFMA32(k0, qr[d0], p0); p1 = MFMA32(k1, qr[d0], p1);
            }
            const int qpos = q0 + r32;
            float mx = -INFINITY;
#pragma unroll
            for (int r = 0; r < 16; ++r) { const int kp0 = kpos0 + crow(r, hi), kp1 = kp0 + 32; const int d0 = qpos - kp0, d1 = qpos - kp1;
                p0[r] = (mine && d0 >= 0) ? p0[r] + TB[d0 > 1023 ? 1023 : (d0 < 0 ? 0 : d0)] : -INFINITY;
                p1[r] = (mine && d1 >= 0) ? p1[r] + TB[d1 > 1023 ? 1023 : (d1 < 0 ? 0 : d1)] : -INFINITY;
                mx = fmaxf(mx, fmaxf(p0[r], p1[r])); }
            mx = shx_max<32>(mx);
            const float mnew = fmaxf(mrun, mx);
            const float msafe = (mnew == -INFINITY) ? 0.f : mnew;
            const float alpha = __builtin_amdgcn_exp2f(mrun - msafe);
            float ls = 0.f;
#pragma unroll
            for (int r = 0; r < 16; ++r) { p0[r] = __builtin_amdgcn_exp2f(p0[r] - msafe); p1[r] = __builtin_amdgcn_exp2f(p1[r] - msafe); ls += p0[r] + p1[r]; }
            lrun = lrun * alpha + ls; mrun = mnew;
#pragma unroll
            for (int r = 0; r < 16; ++r) { o0[r] *= alpha; o1[r] *= alpha; }
#pragma unroll
            for (int ks = 0; ks < 4; ++ks) {
                bf16x8 pb; u32x4 pw;
                if (ks == 0) { pw.x = cvt_pk_bf16(p0[0], p0[1]); pw.y = cvt_pk_bf16(p0[2], p0[3]); pw.z = cvt_pk_bf16(p0[4], p0[5]); pw.w = cvt_pk_bf16(p0[6], p0[7]); }
                else if (ks == 1) { pw.x = cvt_pk_bf16(p0[8], p0[9]); pw.y = cvt_pk_bf16(p0[10], p0[11]); pw.z = cvt_pk_bf16(p0[12], p0[13]); pw.w = cvt_pk_bf16(p0[14], p0[15]); }
                else if (ks == 2) { pw.x = cvt_pk_bf16(p1[0], p1[1]); pw.y = cvt_pk_bf16(p1[2], p1[3]); pw.z = cvt_pk_bf16(p1[4], p1[5]); pw.w = cvt_pk_bf16(p1[6], p1[7]); }
                else { pw.x = cvt_pk_bf16(p1[8], p1[9]); pw.y = cvt_pk_bf16(p1[10], p1[11]); pw.z = cvt_pk_bf16(p1[12], p1[13]); pw.w = cvt_pk_bf16(p1[14], p1[15]); }
                pb = __builtin_bit_cast(bf16x8, pw);
                const u32x2 a00 = *(const LAS u32x2*)(F.lds + AT_VT + r32 * 144 + (16 * ks + 4 * hi) * 2), a01 = *(const LAS u32x2*)(F.lds + AT_VT + r32 * 144 + (16 * ks + 8 + 4 * hi) * 2);
                const u32x2 a10 = *(const LAS u32x2*)(F.lds + AT_VT + (32 + r32) * 144 + (16 * ks + 4 * hi) * 2), a11 = *(const LAS u32x2*)(F.lds + AT_VT + (32 + r32) * 144 + (16 * ks + 8 + 4 * hi) * 2);
                const bf16x8 va0 = __builtin_bit_cast(bf16x8, (u32x4){a00.x, a00.y, a01.x, a01.y}), va1 = __builtin_bit_cast(bf16x8, (u32x4){a10.x, a10.y, a11.x, a11.y});
                o0 = MFMA32(va0, pb, o0); o1 = MFMA32(va1, pb, o1);
            }
        }
    }
    lrun = shx_sum<32>(lrun);
    const float il = 1.0f / lrun;
    {
        LAS bf16_t* stg = (LAS bf16_t*)(F.lds + AT_OST + w * 4096);
#pragma unroll
        for (int r = 0; r < 16; ++r) { const int d = crow(r, hi); stg[r32 * 64 + d] = (bf16_t)(cvt_pk_bf16(o0[r] * il, 0.f) & 0xffffu); stg[r32 * 64 + 32 + d] = (bf16_t)(cvt_pk_bf16(o1[r] * il, 0.f) & 0xffffu); }
        LDS_WAIT();
        bf16_t* Ow = (bf16_t*)(F.ws + WS_AQ) + (rowb + q0) * 512 + h * 64;
#pragma unroll
        for (int i = 0; i < 4; ++i) { const int row = i * 8 + (F.lane >> 3), ch = F.lane & 7; const u32x4 v = *(const LAS u32x4*)(stg + row * 64 + ch * 8); *(u32x4*)(Ow + (size_t)row * 512 + ch * 8) = v; }
    }
    __syncthreads();
}

__global__ void __launch_bounds__(512, 2) hybrid_fwd(Args args) {
    extern __shared__ __attribute__((aligned(16))) unsigned char lds[];
    Frame F;
    F.lds = (LAS unsigned char*)lds; F.ws = AWS();
    F.wave = __builtin_amdgcn_readfirstlane((int)threadIdx.x >> 6); F.lane = fresh_lane(); F.tid = F.wave * 64 + F.lane;
    F.G = gridDim.x; { const int bx = blockIdx.x; F.vcu = (F.G % 8 == 0) ? (bx % 8) * (F.G / 8) + bx / 8 : bx; }
    volatile LAS unsigned* MISC = (volatile LAS unsigned*)(F.lds + MISC_OFF);
    if (F.tid < 64) MISC[F.tid] = 0u;
    __syncthreads();
    XcdBarrier bar = xcd_barrier_post(((unsigned*)F.ws + CW_BAR), MISC + 8, F.tid);
#define RELOAD() do { int l_ = fresh_lane(); int w_ = F.wave; asm volatile("" : "+s"(w_)); F.wave = w_; F.lane = l_; F.tid = w_ * 64 + l_; \
        int g_ = gridDim.x, b_ = blockIdx.x; asm volatile("" : "+s"(g_), "+s"(b_)); F.G = g_; F.vcu = (g_ % 8 == 0) ? (b_ % 8) * (g_ / 8) + b_ / 8 : b_; F.ws = AWS(); ws = F.ws; G = g_; bx = b_; } while (0)
#define GRID_BAR() do { xcd_barrier(bar, F.tid); RELOAD(); } while (0)
    unsigned char* ws = F.ws;
    int G = F.G, bx = (int)blockIdx.x;

    p0_convert(F);
    __syncthreads();

#pragma unroll 1
    for (int layer = 0; layer < 2; ++layer) {
        RELOAD();
        float* X = AOUT(); const float* xin = (layer == 0) ? AIN(0) : X;
        norm_pass<0>(F, xin, AIN(2) + layer * DM, AIN(3) + (size_t)layer * DM * INW + 2048, INW, AIN(6) + layer * 4, AIN(7) + layer * 4);
        GRID_BAR();
        { pg8::StaticOrder S; S.init(ws + WS_XN, ws + WS_WIN + (size_t)layer * NIN * DM * 2, MTOK, NIN, DM, G, bx);
          pg8::EpiIn E{ws}; pg8::gemm_phase<pg8::EpiIn, pg8::StaticOrder, true>(F.lds, DM, S, E, F.wave); }
        GRID_BAR();
#if !defined(NO_MIX)
        for (int it = F.vcu; it < 1024; it += G) moba_prep_item(F, it, AIN(9) + layer * 64, AIN(10) + layer * 64);
        for (int u = F.vcu; u < 1024; u += G) mlstm_local(F, u, AIN(4) + layer * 4096, AIN(5) + layer * 1024);
        GRID_BAR();
        for (int it = F.vcu; it < 256; it += G) mlstm_scan(F, it >> 3, it & 7);
        GRID_BAR();
        for (int u = F.vcu; u < 1024; u += G) mlstm_out(F, u, AIN(4) + layer * 4096, AIN(5) + layer * 1024, AIN(8) + layer * 512);
        for (int v = F.vcu; v < 256; v += G) { const int bh = v >> 2, s = v & 3;
#pragma unroll 1
            for (int i = 0; i < 4; ++i) { const int qb = (i == 0) ? s : (i == 1) ? 7 - s : (i == 2) ? 8 + s : 15 - s; moba_unit(F, bh, qb, AIN(1)); } }
        GRID_BAR();
#endif
        { pg8::StaticOrder S; S.init(ws + WS_MO, ws + WS_WA + (size_t)layer * DM * 512 * 2, MTOK, DM, 512, G, bx);
          pg8::EpiBranch<0> E{(bf16_t*)(ws + WS_Y), (const bf16_t*)(ws + WS_GAB)}; pg8::gemm_phase<pg8::EpiBranch<0>, pg8::StaticOrder, true>(F.lds, 512, S, E, F.wave); }
        VM_WAIT();
        { pg8::StaticOrder S; S.init(ws + WS_AQ, ws + WS_WB + (size_t)layer * DM * 512 * 2, MTOK, DM, 512, G, bx);
          pg8::EpiBranch<1> E{(bf16_t*)(ws + WS_Y), (const bf16_t*)(ws + WS_GAB)}; pg8::gemm_phase<pg8::EpiBranch<1>, pg8::StaticOrder, true>(F.lds, 512, S, E, F.wave); }
        GRID_BAR();
        { pg8::StaticOrder S; S.init(ws + WS_Y, ws + WS_WOUT + (size_t)layer * DM * DM * 2, MTOK, DM, DM, G, bx);
          pg8::EpiResid E{xin, X}; pg8::gemm_phase<pg8::EpiResid, pg8::StaticOrder, true>(F.lds, DM, S, E, F.wave); }
        GRID_BAR();
        if (layer == 0) {
            norm_pass<1>(F, X, AIN(14), nullptr, 0, nullptr, nullptr);
            GRID_BAR();
            { pg8::StaticOrder S; S.init(ws + WS_XN, ws + WS_WGU, MTOK, 2 * DFF, DM, G, bx);
              pg8::EpiSwiGLU<false> E{(bf16_t*)(ws + WS_ACT), DFF}; pg8::gemm_phase<pg8::EpiSwiGLU<false>, pg8::StaticOrder, true>(F.lds, DM, S, E, F.wave); }
            GRID_BAR();
            { pg8::StaticOrder S; S.init(ws + WS_ACT, ws + WS_WD, MTOK, DM, DFF, G, bx);
              pg8::EpiResid E{X, X}; pg8::gemm_phase<pg8::EpiResid, pg8::StaticOrder, true>(F.lds, DFF, S, E, F.wave); }
            GRID_BAR();
        } else {
#if !defined(NO_MOE)
            norm_pass<2>(F, X, AIN(14) + DM, AIN(18), 8, nullptr, nullptr);
            p_convert_experts(F);
            GRID_BAR();
#pragma unroll 1
            for (int rk = 0; rk < 2; ++rk) {
                const int* idx = (const int*)(ws + WS_MIDX) + (size_t)rk * 8 * 32768; const float* wgt = (const float*)(ws + WS_MWGT) + (size_t)rk * 8 * 32768;
                const unsigned* cnt = (const unsigned*)(ws + WS_CTL) + CW_MOE + 64 * 8 * rk;
                { pg8::MoeOrder<true> S; S.init(ws + WS_XN, ws + WS_WGUE, DM, idx, cnt, EFF / 128, G, bx);
                  pg8::EpiSwiGLU<true> E{(bf16_t*)(ws + WS_EACT), EFF}; pg8::gemm_phase<pg8::EpiSwiGLU<true>, pg8::MoeOrder<true>, true>(F.lds, DM, S, E, F.wave); }
                GRID_BAR();
                { pg8::MoeOrder<false> S; S.init(ws + WS_EACT, ws + WS_WDE, EFF, idx, cnt, 4, G, bx);
                  pg8::EpiMoeDown E{X, idx, wgt, cnt}; pg8::gemm_phase<pg8::EpiMoeDown, pg8::MoeOrder<false>, true>(F.lds, EFF, S, E, F.wave); }
                if (rk == 0) GRID_BAR();
            }
#endif
        }
    }
}

extern "C" void kernel_launch(void* const* d_in, const int* in_sizes, int n_in, void* d_out, int out_size, void* d_ws, size_t ws_size, hipStream_t stream) {
    static int grid = 0;
    if (grid == 0) {
        if (n_in != 22 || out_size != MTOK * DM || ws_size < WS_END) { fprintf(stderr, "kernel_launch: unexpected shapes (n_in %d, out %d, ws %zu)\n", n_in, out_size, ws_size); grid = -1; return; }
        int dev = 0, cus = 0, per_cu = 0;
        if (hipGetDevice(&dev) != hipSuccess || hipDeviceGetAttribute(&cus, hipDeviceAttributeMultiprocessorCount, dev) != hipSuccess) { grid = -1; return; }
        if (hipFuncSetAttribute((const void*)hybrid_fwd, hipFuncAttributeMaxDynamicSharedMemorySize, LDS_BYTES) != hipSuccess) { fprintf(stderr, "kernel_launch: hipFuncSetAttribute failed\n"); grid = -1; return; }
        if (hipOccupancyMaxActiveBlocksPerMultiprocessor(&per_cu, (const void*)hybrid_fwd, 512, LDS_BYTES) != hipSuccess || per_cu < 1) fprintf(stderr, "kernel_launch: occupancy query reports %d\n", per_cu);
        (void)hipGetLastError();
        grid = cus;
    }
    if (grid < 0) return;
    if (hipMemsetAsync((char*)d_ws + WS_CTL, 0, CTL_ZERO_BYTES, stream) != hipSuccess) return;
    Args a{};
    for (int i = 0; i < 22; ++i) a.in[i] = (const float*)d_in[i];
    a.out = (float*)d_out; a.ws = (unsigned char*)d_ws;
    hipLaunchKernelGGL(hybrid_fwd, dim3(grid), dim3(512), LDS_BYTES, stream, a);
}
```

```cpp
#include <hip/hip_runtime.h>
#include <cstdio>
#include <cstdint>

#define LAS __attribute__((address_space(3)))
#define GAS __attribute__((address_space(1)))
typedef unsigned short bf16_t;
typedef short bf16x8 __attribute__((ext_vector_type(8)));
typedef short s16x4 __attribute__((ext_vector_type(4)));
typedef float f32x2 __attribute__((ext_vector_type(2)));
typedef float f32x4 __attribute__((ext_vector_type(4)));
typedef float f32x16 __attribute__((ext_vector_type(16)));
typedef unsigned u32x4 __attribute__((ext_vector_type(4)));
typedef unsigned u32x2 __attribute__((ext_vector_type(2)));
typedef GAS unsigned gu32;

constexpr int NBATCH = 8, SEQ = 4096, DM = 1024, MTOK = NBATCH * SEQ;
constexpr int INW = 5640, NIN = 5632;
constexpr int MH = 4, MDH = 128, MCH = 128, NCH = SEQ / MCH;
constexpr int AH = 8, ADH = 64, ABLK = 256, NAB = SEQ / ABLK;
constexpr int DFF = 2816, NEXP = 8, EFF = 3584;
constexpr float EPS = 1e-6f;
constexpr float LOG2E = 1.4426950408889634f;
constexpr float QSCALE = 0.125f * LOG2E;

constexpr size_t MiB = 1u << 20;
constexpr size_t WS_CTL = 0, CTL_ZERO_BYTES = 1 * MiB;
constexpr size_t WS_GATES = 1 * MiB;
constexpr size_t WS_KMEAN = 2 * MiB;
constexpr size_t WS_MSC = 2 * MiB + 512 * 1024;
constexpr size_t WS_UN = 3 * MiB;
constexpr size_t WS_NST = 3 * MiB + 512 * 1024;
constexpr size_t WS_MIDX = 4 * MiB;
constexpr size_t WS_MWGT = 6 * MiB;
constexpr size_t WS_WIN = 12 * MiB;
constexpr size_t WS_WA = 34 * MiB;
constexpr size_t WS_WB = 36 * MiB;
constexpr size_t WS_WOUT = 38 * MiB;
constexpr size_t WS_WGU = 42 * MiB;
constexpr size_t WS_WD = 53 * MiB;
constexpr size_t WS_XN = 60 * MiB;
constexpr size_t WS_MQK = 124 * MiB;
constexpr size_t WS_MV = 188 * MiB;
constexpr size_t WS_MO = 220 * MiB, WS_AQ = 252 * MiB, WS_AK = 284 * MiB, WS_AV = 316 * MiB;
constexpr size_t WS_GAB = 348 * MiB;
constexpr size_t WS_CST = 476 * MiB;
constexpr size_t WS_Y = 476 * MiB;
constexpr size_t WS_ACT = 124 * MiB;
constexpr size_t WS_WGUE = 124 * MiB;
constexpr size_t WS_WDE = 236 * MiB;
constexpr size_t WS_EACT = 292 * MiB;
constexpr size_t WS_END = 540 * MiB;
constexpr int CW_BAR = 4096;
constexpr int CW_MOE = 8192;

constexpr int LDS_BYTES = 147456;
constexpr int MISC_OFF = LDS_BYTES - 256;

__device__ __forceinline__ unsigned cvt_pk_bf16(float lo, float hi) { unsigned r; asm volatile("v_cvt_pk_bf16_f32 %0, %1, %2" : "=v"(r) : "v"(lo), "v"(hi)); return r; }
__device__ __forceinline__ float bf_lo(unsigned w) { return __uint_as_float(w << 16); }
__device__ __forceinline__ float bf_hi(unsigned w) { return __uint_as_float(w & 0xffff0000u); }
__device__ __forceinline__ float bf2f(bf16_t b) { return __uint_as_float((unsigned)b << 16); }
__device__ __forceinline__ float sigmoidf_(float x) { return __builtin_amdgcn_rcpf(1.0f + __builtin_amdgcn_exp2f(-x * LOG2E)); }
__device__ __forceinline__ int fresh_lane() { unsigned m = ~0u; asm volatile("" : "+s"(m)); return (int)__builtin_amdgcn_mbcnt_hi(m, __builtin_amdgcn_mbcnt_lo(m, 0u)); }
__device__ __forceinline__ int crow(int r, int hi) { return (r & 3) + 8 * (r >> 2) + 4 * hi; }
#define LDS_WAIT() asm volatile("s_waitcnt lgkmcnt(0)" ::: "memory")
#define VM_WAIT() asm volatile("s_waitcnt vmcnt(0)" ::: "memory")

namespace pg8 {
constexpr int BM = 256, BK = 64, HALF = 128, HTB = HALF * BK * 2, STAGE_BYTES = 8 * HTB, NXCD = 8, WGM = 8;
__host__ __device__ __forceinline__ int lds_byte(int r, int c) { const int st = (r >> 4) * 2 + (c >> 5), rr = r & 15, cc = c & 31, ob = rr * 64 + cc * 2; return st * 1024 + (ob ^ (((ob >> 9) & 1) << 5)); }
__host__ __device__ __forceinline__ void stage_rc(int b, int& R, int& C) { const int st = b / 1024, sb = b % 1024, swz = sb ^ (((sb >> 9) & 1) << 5); R = (st >> 1) * 16 + swz / 64; C = (st & 1) * 32 + (swz % 64) / 2; }
__host__ __device__ __forceinline__ int perm32(int rho) { const int n = rho >> 4, i = rho & 15; return 8 * (i >> 2) + 4 * n + (i & 3); }

struct Unit { int pm, pn, e, lp; };

struct StaticOrder {
    static constexpr bool GATHER = false;
    const char* A; const char* Bt; size_t tstep;
    int nM, nN, nwg, G, c;
    __device__ __forceinline__ void init(const void* A_, const void* Bt_, int M, int N, int K, int G_, int c_) { A = (const char*)A_; Bt = (const char*)Bt_; tstep = (size_t)BM * K * 2; nM = M / BM; nN = N / BM; nwg = nM * nN; G = G_; c = c_; }
    __device__ __forceinline__ bool next(int i, Unit& u) const {
        const long L = (long)i * G + c; if (L >= nwg) return false;
        int wgid = (int)L; { const int q = nwg / NXCD, r = nwg % NXCD, xcd = wgid % NXCD, off = wgid / NXCD; wgid = (xcd < r ? xcd * (q + 1) : r * (q + 1) + (xcd - r) * q) + off; }
        const int nig = WGM * nN, gid = wgid / nig, fm = gid * WGM, gsz = (nM - fm) < WGM ? (nM - fm) : WGM;
        u.pm = fm + ((wgid % nig) % gsz); u.pn = (wgid % nig) / gsz; u.e = 0; u.lp = 0; return true;
    }
    __device__ __forceinline__ const char* abase(const Unit& u) const { return A + (size_t)u.pm * tstep; }
    __device__ __forceinline__ const char* bbase(const Unit& u) const { return Bt + (size_t)u.pn * tstep; }
    __device__ __forceinline__ unsigned tok(const Unit&, int) const { return 0u; }
};

template <class Epi, class Sched, bool ALIGN_EPI>
__device__ __forceinline__ void gemm_phase(LAS unsigned char* lds, const int K, const Sched& S, const Epi& E, const int wave_id) {
    const int lane_ = fresh_lane();
    const int wid = __builtin_amdgcn_readfirstlane(wave_id), lane = lane_, tid = wid * 64 + lane, wr = wid >> 2, wc = wid & 3, fr = lane & 15, fq = lane >> 4;
    const int nt = K / BK;
    unsigned voffB[2]; int RA[2], CA[2];
#pragma unroll
    for (int i = 0; i < 2; ++i) { int R, C; stage_rc(tid * 16 + i * 8192, R, C); RA[i] = R; CA[i] = C; const int Rb = Epi::PERM ? ((R & ~31) + perm32(R & 31)) : R; voffB[i] = (unsigned)(Rb * K + C) * 2u; }
    const size_t kstep = (size_t)(BK * 2);
    const size_t hstep = (size_t)HALF * K * 2;
    const size_t hstepA = Sched::GATHER ? (size_t)0 : hstep;
    const unsigned ldsw = (unsigned)wid * 1024u;
    const int aoff = lds_byte(wr * 64 + fr, fq * 8), boff = lds_byte(wc * 32 + fr, fq * 8);
#define PG8_SA(b, h) (((b) * 2 + (h)) * HTB)
#define PG8_SB(b, h) ((4 + (b) * 2 + (h)) * HTB)
#define PG8_STAGE(bufoff, gbase, voff) do { _Pragma("unroll") for (int _i = 0; _i < 2; ++_i) \
        __builtin_amdgcn_global_load_lds((const unsigned*)((const char*)(gbase) + (voff)[_i]), (LAS unsigned*)(lds + (bufoff) + ldsw + _i * 8192), 16, 0, 0); } while (0)
#define PG8_LDA(dst, b, h) do { _Pragma("unroll") for (int m = 0; m < 4; ++m) _Pragma("unroll") for (int k = 0; k < 2; ++k) dst[m][k] = *(const LAS bf16x8*)(lds + PG8_SA(b, h) + aoff + m * 2048 + k * 1024); } while (0)
#define PG8_LDB(dst, b, h) do { _Pragma("unroll") for (int n = 0; n < 2; ++n) _Pragma("unroll") for (int k = 0; k < 2; ++k) dst[n][k] = *(const LAS bf16x8*)(lds + PG8_SB(b, h) + boff + n * 2048 + k * 1024); } while (0)
#define PG8_MMA(ai, bj, At, Bt) do { __builtin_amdgcn_s_setprio(1); _Pragma("unroll") for (int m = 0; m < 4; ++m) _Pragma("unroll") for (int n = 0; n < 2; ++n) _Pragma("unroll") for (int k = 0; k < 2; ++k) \
        acc[ai][bj][m][n] = __builtin_amdgcn_mfma_f32_16x16x32_bf16(Bt[n][k], At[m][k], acc[ai][bj][m][n], 0, 0, 0); __builtin_amdgcn_s_setprio(0); } while (0)
#define PG8_WAIT_V(n) asm volatile("s_waitcnt vmcnt(" #n ")" ::: "memory")
#define PG8_WAIT_L(n) asm volatile("s_waitcnt lgkmcnt(" #n ")" ::: "memory")
#define PG8_BAR __builtin_amdgcn_s_barrier()
#define PG8_SCHED __builtin_amdgcn_sched_barrier(0)
#define PG8_SETV(v, u) do { _Pragma("unroll") for (int _h = 0; _h < 2; ++_h) _Pragma("unroll") for (int _i = 0; _i < 2; ++_i) \
        v[_h][_i] = Sched::GATHER ? (S.tok(u, _h * HALF + RA[_i]) * (unsigned)K + (unsigned)CA[_i]) * 2u : (unsigned)(RA[_i] * K + CA[_i]) * 2u; } while (0)
    Unit cur, nxt; int ui = 0;
    if (!S.next(0, cur)) return;
    f32x4 acc[2][2][4][2];
#pragma unroll
    for (int a = 0; a < 2; ++a)
#pragma unroll
        for (int b = 0; b < 2; ++b)
#pragma unroll
            for (int m = 0; m < 4; ++m)
#pragma unroll
                for (int n = 0; n < 2; ++n) acc[a][b][m][n] = (f32x4){0.f, 0.f, 0.f, 0.f};
    bf16x8 At[4][2], B0[2][2], B1[2][2];
    unsigned cvA[2][2], nvA[2][2];
    PG8_SETV(cvA, cur);
    const char* cA = S.abase(cur); const char* cB = S.bbase(cur);
    PG8_STAGE(PG8_SB(0, 0), cB, voffB); PG8_STAGE(PG8_SB(0, 1), cB + hstep, voffB); PG8_STAGE(PG8_SA(0, 0), cA, cvA[0]); PG8_STAGE(PG8_SA(0, 1), cA + hstepA, cvA[1]);
    if (wr == 1) PG8_BAR;
    PG8_WAIT_V(2); PG8_BAR;
    PG8_STAGE(PG8_SB(1, 0), cB + kstep, voffB); PG8_STAGE(PG8_SA(1, 0), cA + kstep, cvA[0]); PG8_STAGE(PG8_SB(1, 1), cB + hstep + kstep, voffB);
    PG8_WAIT_V(6); PG8_BAR;
    for (;;) {
        const bool has_next = S.next(ui + 1, nxt);
        const char* nA = has_next ? S.abase(nxt) : cA; const char* nB = has_next ? S.bbase(nxt) : cB;
        if constexpr (Sched::GATHER) {
            if (has_next) { PG8_SETV(nvA, nxt); }
            else {
#pragma unroll
                for (int h = 0; h < 2; ++h)
#pragma unroll
                    for (int i = 0; i < 2; ++i) nvA[h][i] = cvA[h][i];
            }
            asm volatile("" : "+v"(nvA[0][0]), "+v"(nvA[0][1]), "+v"(nvA[1][0]), "+v"(nvA[1][1]));
        }
        for (int t = 0; t < nt; t += 2) {
            const bool last = (t == nt - 2);
            const char* a1 = cA + (size_t)(t + 1) * kstep;
            const char* a2 = last ? nA : cA + (size_t)(t + 2) * kstep; const char* b2 = last ? nB : cB + (size_t)(t + 2) * kstep;
            const char* a3 = a2 + kstep; const char* b3 = b2 + kstep;
            unsigned v0[2], v1[2];
#pragma unroll
            for (int i = 0; i < 2; ++i) { if constexpr (Sched::GATHER) { v0[i] = last ? nvA[0][i] : cvA[0][i]; v1[i] = last ? nvA[1][i] : cvA[1][i]; } else { v0[i] = cvA[0][i]; v1[i] = cvA[1][i]; } }
            PG8_LDB(B0, 0, 0); PG8_LDB(B1, 0, 1); PG8_SCHED; PG8_LDA(At, 0, 0); PG8_STAGE(PG8_SA(1, 1), a1 + hstepA, cvA[1]);
            PG8_WAIT_V(8); PG8_WAIT_L(0); PG8_BAR; PG8_MMA(0, 0, At, B0); PG8_MMA(0, 1, At, B1); PG8_BAR; PG8_SCHED;
            PG8_LDA(At, 0, 1); PG8_STAGE(PG8_SB(0, 0), b2, voffB); PG8_STAGE(PG8_SB(0, 1), b2 + hstep, voffB); PG8_STAGE(PG8_SA(0, 0), a2, v0);
            PG8_WAIT_V(8); PG8_WAIT_L(0); PG8_BAR; PG8_MMA(1, 0, At, B0); PG8_MMA(1, 1, At, B1); PG8_BAR; PG8_SCHED;
            PG8_LDB(B0, 1, 0); PG8_LDB(B1, 1, 1); PG8_SCHED; PG8_LDA(At, 1, 0); PG8_STAGE(PG8_SA(0, 1), a2 + hstepA, v1);
            PG8_WAIT_V(8); PG8_WAIT_L(0); PG8_BAR; PG8_MMA(0, 0, At, B0); PG8_MMA(0, 1, At, B1); PG8_BAR; PG8_SCHED;
            PG8_LDA(At, 1, 1); PG8_STAGE(PG8_SB(1, 0), b3, voffB); PG8_STAGE(PG8_SB(1, 1), b3 + hstep, voffB); PG8_STAGE(PG8_SA(1, 0), a3, v0);
            PG8_WAIT_V(8); PG8_WAIT_L(0); PG8_BAR; PG8_MMA(1, 0, At, B0); PG8_MMA(1, 1, At, B1); PG8_BAR; PG8_SCHED;
        }
        if constexpr (ALIGN_EPI) { if (wr == 0) PG8_BAR; }
        E(acc, cur, wr, wc, fr, fq);
        if (!has_next) break;
#pragma unroll
        for (int a = 0; a < 2; ++a)
#pragma unroll
            for (int b = 0; b < 2; ++b)
#pragma unroll
                for (int m = 0; m < 4; ++m)
#pragma unroll
                    for (int n = 0; n < 2; ++n) acc[a][b][m][n] = (f32x4){0.f, 0.f, 0.f, 0.f};
        cur = nxt; cA = nA; cB = nB; ++ui;
#pragma unroll
        for (int h = 0; h < 2; ++h)
#pragma unroll
            for (int i = 0; i < 2; ++i) cvA[h][i] = nvA[h][i];
        if constexpr (ALIGN_EPI) { if (wr == 1) PG8_BAR; }
    }
    PG8_WAIT_V(0);
    if constexpr (!ALIGN_EPI) { if (wr == 0) PG8_BAR; }
    PG8_BAR;
#undef PG8_SA
#undef PG8_SB
#undef PG8_STAGE
#undef PG8_LDA
#undef PG8_LDB
#undef PG8_MMA
#undef PG8_WAIT_V
#undef PG8_WAIT_L
#undef PG8_BAR
#undef PG8_SCHED
#undef PG8_SETV
}

struct EpiIn {
    static constexpr bool PERM = true;
    unsigned char* ws;
    __device__ __forceinline__ void operator()(const f32x4 (&acc)[2][2][4][2], const Unit& u, int wr, int wc, int fr, int fq) const {
        const int pn = u.pn; bf16_t* base; int ld, colt; bool sg;
        if (pn < 4) { base = (bf16_t*)(ws + WS_MQK); ld = 1024; colt = 256 * pn; sg = false; }
        else if (pn < 14) { const int q = (pn - 4) >> 1; base = (bf16_t*)(ws + WS_MV + (size_t)q * (32 * MiB)); ld = 512; colt = 256 * ((pn - 4) & 1); sg = (q == 1); }
        else { base = (bf16_t*)(ws + WS_GAB); ld = 2048; colt = 256 * (pn - 14); sg = true; }
        const int row0 = u.pm * BM + wr * 64 + fr, col0 = colt + wc * 32 + 8 * fq;
#pragma unroll
        for (int ai = 0; ai < 2; ++ai)
#pragma unroll
            for (int m = 0; m < 4; ++m) { bf16_t* rowp = base + (size_t)(row0 + ai * HALF + m * 16) * ld + col0;
#pragma unroll
                for (int bj = 0; bj < 2; ++bj) { f32x4 v0 = acc[ai][bj][m][0], v1 = acc[ai][bj][m][1];
                    if (sg) {
#pragma unroll
                        for (int j = 0; j < 4; ++j) { v0[j] = sigmoidf_(v0[j]); v1[j] = sigmoidf_(v1[j]); } }
                    u32x4 w; w.x = cvt_pk_bf16(v0[0], v0[1]); w.y = cvt_pk_bf16(v0[2], v0[3]); w.z = cvt_pk_bf16(v1[0], v1[1]); w.w = cvt_pk_bf16(v1[2], v1[3]);
                    *(u32x4*)(rowp + bj * HALF) = w; } }
    }
};
template <int BR> struct EpiBranch {
    static constexpr bool PERM = true;
    bf16_t* Y; const bf16_t* G;
    __device__ __forceinline__ void operator()(const f32x4 (&acc)[2][2][4][2], const Unit& u, int wr, int wc, int fr, int fq) const {
        const int row0 = u.pm * BM + wr * 64 + fr, col0 = u.pn * BM + wc * 32 + 8 * fq;
#pragma unroll
        for (int ai = 0; ai < 2; ++ai)
#pragma unroll
            for (int m = 0; m < 4; ++m) { const size_t r = (size_t)(row0 + ai * HALF + m * 16);
#pragma unroll
                for (int bj = 0; bj < 2; ++bj) { const int c = col0 + bj * HALF;
                    const u32x4 g = *(const u32x4*)(G + r * 2048 + BR * 1024 + c);
                    f32x4 v0 = acc[ai][bj][m][0], v1 = acc[ai][bj][m][1];
                    v0[0] *= bf_lo(g.x); v0[1] *= bf_hi(g.x); v0[2] *= bf_lo(g.y); v0[3] *= bf_hi(g.y); v1[0] *= bf_lo(g.z); v1[1] *= bf_hi(g.z); v1[2] *= bf_lo(g.w); v1[3] *= bf_hi(g.w);
                    if (BR == 1) { const u32x4 y = *(const u32x4*)(Y + r * 1024 + c);
                        v0[0] += bf_lo(y.x); v0[1] += bf_hi(y.x); v0[2] += bf_lo(y.y); v0[3] += bf_hi(y.y); v1[0] += bf_lo(y.z); v1[1] += bf_hi(y.z); v1[2] += bf_lo(y.w); v1[3] += bf_hi(y.w); }
                    u32x4 w; w.x = cvt_pk_bf16(v0[0], v0[1]); w.y = cvt_pk_bf16(v0[2], v0[3]); w.z = cvt_pk_bf16(v1[0], v1[1]); w.w = cvt_pk_bf16(v1[2], v1[3]);
                    *(u32x4*)(Y + r * 1024 + c) = w; } }
    }
};
struct EpiResid {
    static constexpr bool PERM = false;
    const float* base; float* out;
    __device__ __forceinline__ void operator()(const f32x4 (&acc)[2][2][4][2], const Unit& u, int wr, int wc, int fr, int fq) const {
        const int row0 = u.pm * BM + wr * 64 + fr, col0 = u.pn * BM + wc * 32 + 4 * fq;
#pragma unroll
        for (int ai = 0; ai < 2; ++ai)
#pragma unroll
            for (int m = 0; m < 4; ++m) { const size_t off = (size_t)(row0 + ai * HALF + m * 16) * 1024 + col0;
#pragma unroll
                for (int bj = 0; bj < 2; ++bj)
#pragma unroll
                    for (int n = 0; n < 2; ++n) { const f32x4 b = *(const f32x4*)(base + off + bj * HALF + n * 16); *(f32x4*)(out + off + bj * HALF + n * 16) = b + acc[ai][bj][m][n]; } }
    }
};
template <bool MOE> struct EpiSwiGLU {
    static constexpr bool PERM = true;
    bf16_t* O; int ld;
    __device__ __forceinline__ void operator()(const f32x4 (&acc)[2][2][4][2], const Unit& u, int wr, int wc, int fr, int fq) const {
        const int row0 = u.pm * BM + wr * 64 + fr, col0 = (MOE ? u.lp : u.pn) * HALF + wc * 32 + 8 * fq;
#pragma unroll
        for (int ai = 0; ai < 2; ++ai)
#pragma unroll
            for (int m = 0; m < 4; ++m) { bf16_t* rowp = O + (size_t)(row0 + ai * HALF + m * 16) * ld + col0;
                f32x4 v0, v1;
#pragma unroll
                for (int j = 0; j < 4; ++j) { const float g0 = acc[ai][0][m][0][j], g1 = acc[ai][0][m][1][j];
                    v0[j] = g0 * sigmoidf_(g0) * acc[ai][1][m][0][j]; v1[j] = g1 * sigmoidf_(g1) * acc[ai][1][m][1][j]; }
                u32x4 w; w.x = cvt_pk_bf16(v0[0], v0[1]); w.y = cvt_pk_bf16(v0[2], v0[3]); w.z = cvt_pk_bf16(v1[0], v1[1]); w.w = cvt_pk_bf16(v1[2], v1[3]);
                *(u32x4*)rowp = w; }
    }
};
struct EpiMoeDown {
    static constexpr bool PERM = false;
    float* X; const int* idx; const float* wgt; const unsigned* cnt;
    __device__ __forceinline__ void operator()(const f32x4 (&acc)[2][2][4][2], const Unit& u, int wr, int wc, int fr, int fq) const {
        const int n = (int)cnt[64 * u.e]; const int col0 = (u.pn & 3) * BM + wc * 32 + 4 * fq;
#pragma unroll
        for (int ai = 0; ai < 2; ++ai)
#pragma unroll
            for (int m = 0; m < 4; ++m) { const int j = u.lp * 256 + ai * HALF + wr * 64 + m * 16 + fr;
                if (j < n) { const int tk = idx[u.e * 32768 + j]; const float w = wgt[u.e * 32768 + j]; float* p = X + (size_t)tk * 1024 + col0;
#pragma unroll
                    for (int bj = 0; bj < 2; ++bj)
#pragma unroll
                        for (int nn = 0; nn < 2; ++nn) { const f32x4 b = *(const f32x4*)(p + bj * HALF + nn * 16); *(f32x4*)(p + bj * HALF + nn * 16) = b + w * acc[ai][bj][m][nn]; } } }
    }
};
template <bool UP> struct MoeOrder {
    static constexpr bool GATHER = UP;
    const char* A; const char* Bt; size_t tstep; const int* idx; const unsigned* cnt; int ps[9]; int NT, G, c;
    __device__ __forceinline__ void init(const void* A_, const void* Bt_, int K, const int* idx_, const unsigned* cnt_, int NT_, int G_, int c_) {
        A = (const char*)A_; Bt = (const char*)Bt_; tstep = (size_t)BM * K * 2; idx = idx_; cnt = cnt_; NT = NT_; G = G_; c = c_; ps[0] = 0;
#pragma unroll
        for (int e = 0; e < 8; ++e) ps[e + 1] = ps[e] + (((int)cnt[64 * e] + 255) >> 8);
    }
    __device__ __forceinline__ bool next(int i, Unit& u) const {
        const int L = i * G + c; if (L >= ps[8] * NT) return false;
        const int p = L / NT, pl = L - p * NT; int e = 0, st = 0;
#pragma unroll
        for (int k = 1; k < 8; ++k) if (p >= ps[k]) { e = k; st = ps[k]; }
        u.pm = p; u.pn = e * NT + pl; u.e = e; u.lp = UP ? pl : (p - st);
        if (UP) u.e = e | ((p - st) << 8);
        return true;
    }
    __device__ __forceinline__ const char* abase(const Unit& u) const { return UP ? A : A + (size_t)u.pm * tstep; }
    __device__ __forceinline__ const char* bbase(const Unit& u) const { return Bt + (size_t)u.pn * tstep; }
    __device__ __forceinline__ unsigned tok(const Unit& u, int r) const { const int e = u.e & 255, lp = u.e >> 8; const int n = (int)cnt[64 * e]; int j = lp * 256 + r; j = j < n ? j : n - 1; return (unsigned)idx[e * 32768 + j]; }
};
}

#define XB_TMO      128
#define XB_XCNT(j)  (256  + 64 * (j))
#define XB_XSUB(j)  (1280 + 64 * (j))
#define XB_XGEN(j)  (2304 + 64 * (j))
#define XB_TOP      3328
#define XB_TOPGEN   3392
#define XCD_BAR_WORDS 3456
#define XB_SPIN_CAP (1u << 18)

__device__ __forceinline__ unsigned xb_ld(unsigned* p)              { return __hip_atomic_load(p, __ATOMIC_RELAXED, __HIP_MEMORY_SCOPE_AGENT); }
__device__ __forceinline__ unsigned xb_add(unsigned* p, unsigned v) { return __hip_atomic_fetch_add(p, v, __ATOMIC_RELAXED, __HIP_MEMORY_SCOPE_AGENT); }
__device__ __forceinline__ unsigned xb_xcc_id() { return (unsigned)__builtin_amdgcn_s_getreg((3 << 11) | 20) & 0xFu; }
#define XB_SPIN(cond, bar) do { unsigned _sp = 0; while (cond) { __builtin_amdgcn_s_sleep(1); \
    if ((++_sp & 255u) == 0u) { if (xb_ld(&(bar)[XB_TMO])) break; if (_sp > XB_SPIN_CAP) { atomicAdd(&(bar)[XB_TMO], 1u); break; } } } } while (0)

struct XcdBarrier { unsigned* bar; unsigned x; volatile LAS unsigned* st; };
__device__ __forceinline__ XcdBarrier xcd_barrier_post(unsigned* bar, volatile LAS unsigned* st, int tid) {
    XcdBarrier b; b.bar = bar; b.x = xb_xcc_id(); b.st = st;
    if (tid == 0) (void)xb_add(&bar[XB_XCNT(b.x)], 1u);
    return b;
}
__device__ __forceinline__ void xcd_barrier_complete(unsigned* bar, unsigned x, unsigned& nloc, unsigned& nx) {
    const unsigned G = gridDim.x * gridDim.y * gridDim.z;
    unsigned sum, cnt, mine, sp = 0u;
    for (;;) {
        sum = 0u; cnt = 0u; mine = 0u;
#pragma unroll
        for (unsigned j = 0; j < 16; ++j) { const unsigned c = xb_ld(&bar[XB_XCNT(j)]); sum += c; cnt += (c > 0u) ? 1u : 0u; mine = (j == x) ? c : mine; }
        if (sum == G) break;
        __builtin_amdgcn_s_sleep(1);
        if ((++sp & 255u) == 0u) { if (xb_ld(&bar[XB_TMO])) break; if (sp > XB_SPIN_CAP) { atomicAdd(&bar[XB_TMO], 1u); break; } }
    }
    nloc = mine > 0u ? mine : 1u; nx = cnt > 0u ? cnt : 1u;
}
__device__ __forceinline__ void xcd_barrier(const XcdBarrier& b, int tid) {
    asm volatile("s_waitcnt vmcnt(0)" ::: "memory");
    __syncthreads();
    if (tid == 0) {
        unsigned* bar = b.bar; asm volatile("" : "+s"(bar));
        __builtin_amdgcn_s_waitcnt(0);
        unsigned nloc = b.st[0], nx = b.st[1];
        if (nloc == 0u) { xcd_barrier_complete(bar, b.x, nloc, nx); b.st[0] = nloc; b.st[1] = nx; }
        const unsigned old = xb_add(&bar[XB_XSUB(b.x)], 1u);
        const unsigned gen = old / nloc;
        if (old + 1u == (gen + 1u) * nloc) {
            __builtin_amdgcn_fence(__ATOMIC_RELEASE, "agent");
            asm volatile("s_waitcnt vmcnt(0)" ::: "memory");
            const unsigned og = xb_add(&bar[XB_TOP], 1u);
            const unsigned tg = og / nx;
            if (og + 1u == (tg + 1u) * nx) xb_add(&bar[XB_TOPGEN], 1u);
            else XB_SPIN(xb_ld(&bar[XB_TOPGEN]) == tg, bar);
            __builtin_amdgcn_fence(__ATOMIC_ACQUIRE, "agent");
            xb_add(&bar[XB_XGEN(b.x)], 1u);
            asm volatile("s_waitcnt vmcnt(0)" ::: "memory");
        } else {
            XB_SPIN(xb_ld(&bar[XB_XGEN(b.x)]) == gen, bar);
            __builtin_amdgcn_fence(__ATOMIC_ACQUIRE, "agent");
            asm volatile("s_waitcnt vmcnt(0)" ::: "memory");
        }
    }
    __syncthreads();
}

struct Args { const float* in[22]; float* out; unsigned char* ws; };
typedef __attribute__((address_space(4))) const unsigned char* karg_t;
__device__ __forceinline__ karg_t kargs() { karg_t p = (karg_t)__builtin_amdgcn_kernarg_segment_ptr(); asm volatile("" : "+s"(p)); return p; }
#define AIN(i) (((const float* const __attribute__((address_space(4)))*)kargs())[i])
#define AOUT() (((float* const __attribute__((address_space(4)))*)kargs())[22])
#define AWS() (((unsigned char* const __attribute__((address_space(4)))*)kargs())[23])
struct Frame {
    LAS unsigned char* lds; unsigned char* ws;
    int tid, lane, wave, vcu, G;
};


template <int O> __device__ __forceinline__ float shx(float v) {
    if constexpr (O < 32) return __int_as_float(__builtin_amdgcn_ds_swizzle(__float_as_int(v), 0x1f | (O << 10)));
    else { auto rr = __builtin_amdgcn_permlane32_swap(__float_as_uint(v), __float_as_uint(v), false, false); const float lo = __uint_as_float(rr[0]), hi = __uint_as_float(rr[1]); return (lo + hi) - v; }
}
template <int O> __device__ __forceinline__ float shx_sum(float v) {
    if constexpr (O < 32) return v + shx<O>(v);
    else { auto rr = __builtin_amdgcn_permlane32_swap(__float_as_uint(v), __float_as_uint(v), false, false); return __uint_as_float(rr[0]) + __uint_as_float(rr[1]); }
}
template <int O> __device__ __forceinline__ float shx_max(float v) {
    if constexpr (O < 32) return fmaxf(v, shx<O>(v));
    else { auto rr = __builtin_amdgcn_permlane32_swap(__float_as_uint(v), __float_as_uint(v), false, false); return fmaxf(__uint_as_float(rr[0]), __uint_as_float(rr[1])); }
}
__device__ __forceinline__ float bperm(int src_lane, float v) { return __int_as_float(__builtin_amdgcn_ds_bpermute(src_lane << 2, __float_as_int(v))); }
__device__ __forceinline__ Frame unit_frame(const Frame& F) { Frame f = F; LAS unsigned char* L = F.lds; asm volatile("" : "+s"(L)); int l = F.lane; asm volatile("" : "+v"(l)); f.lds = L; f.lane = l; f.tid = f.wave * 64 + l; return f; }
__device__ __forceinline__ float wave_sum(float v) { v = shx_sum<1>(v); v = shx_sum<2>(v); v = shx_sum<4>(v); v = shx_sum<8>(v); v = shx_sum<16>(v); v = shx_sum<32>(v); return v; }
__device__ __forceinline__ float wave_max(float v) { v = shx_max<1>(v); v = shx_max<2>(v); v = shx_max<4>(v); v = shx_max<8>(v); v = shx_max<16>(v); v = shx_max<32>(v); return v; }

__device__ __forceinline__ void tr_item(const float* W, int ldw, int k0, int n0, bf16_t* WT, int Kd, int dst_row0, LAS float* scr, int lane) {
#pragma unroll 8
    for (int i = 0; i < 32; ++i) { const int kk = 2 * i + (lane >> 5); scr[kk * 33 + (lane & 31)] = W[(size_t)(k0 + kk) * ldw + n0 + (lane & 31)]; }
    LDS_WAIT(); asm volatile("" ::: "memory");
    const int c = lane & 7;
#pragma unroll
    for (int j = 0; j < 4; ++j) { const int n = (lane >> 3) + 8 * j; const LAS float* s = scr + (8 * c) * 33 + n;
        u32x4 o; o.x = cvt_pk_bf16(s[0 * 33], s[1 * 33]); o.y = cvt_pk_bf16(s[2 * 33], s[3 * 33]); o.z = cvt_pk_bf16(s[4 * 33], s[5 * 33]); o.w = cvt_pk_bf16(s[6 * 33], s[7 * 33]);
        *(GAS u32x4*)(WT + (size_t)(dst_row0 + n) * Kd + k0 + 8 * c) = o; }
    LDS_WAIT(); asm volatile("" ::: "memory");
}
__device__ __forceinline__ void tr_matrix_item(const float* W, int K, int N, int ldw, bf16_t* WT, int Kd, int mode, int bj, int item, LAS float* scr, int lane) {
    const int nblk = N / 32, kb = item / nblk, nb = item % nblk; const int c0 = 32 * nb;
    int n0 = c0, dr = c0;
    if (mode == 1) { n0 = c0 + (c0 >= 2048 ? 8 : 0); }
    if (mode == 2) { dr = 256 * (c0 >> 7) + 128 * bj + (c0 & 127); }
    tr_item(W, ldw, 64 * kb, n0, WT, Kd, dr, scr, lane);
}

__device__ __forceinline__ void p0_convert(Frame& F) {
    LAS float* scr = (LAS float*)(F.lds + F.wave * 8704);
    const int gw = F.vcu * 8 + F.wave, NGW = F.G * 8;
    constexpr int I_IN = 16 * (NIN / 32), I_BR = 8 * 32, I_OUT = 16 * 32, I_GU = 16 * (DFF / 32), I_D = (DFF / 64) * 32;
    constexpr int NITEMS = 2 * I_IN + 4 * I_BR + 2 * I_OUT + 2 * I_GU + I_D;
    for (int it = gw; it < NITEMS; it += NGW) {
        int r = it;
        if (r < 2 * I_IN) { const int l = r / I_IN; tr_matrix_item(AIN(3) + (size_t)l * DM * INW, DM, NIN, INW, (bf16_t*)(F.ws + WS_WIN) + (size_t)l * NIN * DM, DM, 1, 0, r % I_IN, scr, F.lane); continue; } r -= 2 * I_IN;
        if (r < 2 * I_BR) { const int l = r / I_BR; tr_matrix_item(AIN(11) + (size_t)l * 512 * DM, 512, DM, DM, (bf16_t*)(F.ws + WS_WA) + (size_t)l * DM * 512, 512, 0, 0, r % I_BR, scr, F.lane); continue; } r -= 2 * I_BR;
        if (r < 2 * I_BR) { const int l = r / I_BR; tr_matrix_item(AIN(12) + (size_t)l * 512 * DM, 512, DM, DM, (bf16_t*)(F.ws + WS_WB) + (size_t)l * DM * 512, 512, 0, 0, r % I_BR, scr, F.lane); continue; } r -= 2 * I_BR;
        if (r < 2 * I_OUT) { const int l = r / I_OUT; tr_matrix_item(AIN(13) + (size_t)l * DM * DM, DM, DM, DM, (bf16_t*)(F.ws + WS_WOUT) + (size_t)l * DM * DM, DM, 0, 0, r % I_OUT, scr, F.lane); continue; } r -= 2 * I_OUT;
        if (r < I_GU) { tr_matrix_item(AIN(15), DM, DFF, DFF, (bf16_t*)(F.ws + WS_WGU), DM, 2, 0, r, scr, F.lane); continue; } r -= I_GU;
        if (r < I_GU) { tr_matrix_item(AIN(16), DM, DFF, DFF, (bf16_t*)(F.ws + WS_WGU), DM, 2, 1, r, scr, F.lane); continue; } r -= I_GU;
        tr_matrix_item(AIN(17), DFF, DM, DM, (bf16_t*)(F.ws + WS_WD), DFF, 0, 0, r, scr, F.lane);
    }
}
__device__ __forceinline__ void p_convert_experts(Frame& F) {
    LAS float* scr = (LAS float*)(F.lds + F.wave * 8704);
    const int gw = F.vcu * 8 + F.wave, NGW = F.G * 8;
    constexpr int I_GU = 16 * (EFF / 32), I_D = (EFF / 64) * 32, I_E = 2 * I_GU + I_D;
    for (int it = gw; it < 8 * I_E; it += NGW) {
        const int e = it / I_E; int r = it % I_E;
        bf16_t* gu = (bf16_t*)(F.ws + WS_WGUE) + (size_t)e * 2 * EFF * DM; bf16_t* wd = (bf16_t*)(F.ws + WS_WDE) + (size_t)e * DM * EFF;
        if (r < I_GU) { tr_matrix_item(AIN(19) + (size_t)e * DM * EFF, DM, EFF, EFF, gu, DM, 2, 0, r, scr, F.lane); continue; } r -= I_GU;
        if (r < I_GU) { tr_matrix_item(AIN(20) + (size_t)e * DM * EFF, DM, EFF, EFF, gu, DM, 2, 1, r, scr, F.lane); continue; } r -= I_GU;
        tr_matrix_item(AIN(21) + (size_t)e * EFF * DM, EFF, DM, DM, wd, EFF, 0, 0, r, scr, F.lane);
    }
}

template <int MODE>
__device__ __forceinline__ void norm_pass(Frame& F, const float* X, const float* gain, const float* W8, int ldw8, const float* bi, const float* bf) {
    LAS float* w8 = (LAS float*)F.lds;
    if (MODE != 1) {
        for (int i = F.tid; i < 1024 * 8; i += 512) w8[i] = W8[(size_t)(i >> 3) * ldw8 + (i & 7)];
        __syncthreads();
    }
    bf16_t* XN = (bf16_t*)(F.ws + WS_XN);
    const int gw = F.vcu * 8 + F.wave, NGW = F.G * 8;
    f32x4 gv[4];
#pragma unroll
    for (int j = 0; j < 4; ++j) gv[j] = *(const f32x4*)(gain + 4 * F.lane + 256 * j);
    for (int m = gw; m < MTOK; m += NGW) {
        const f32x4* xr = (const f32x4*)(X + (size_t)m * DM) + F.lane;
        f32x4 v[4]; float s = 0.f;
#pragma unroll
        for (int j = 0; j < 4; ++j) { v[j] = xr[64 * j]; s += (v[j].x * v[j].x + v[j].y * v[j].y) + (v[j].z * v[j].z + v[j].w * v[j].w); }
        const float r = 1.0f / sqrtf(wave_sum(s) * (1.f / DM) + EPS);
#pragma unroll
        for (int j = 0; j < 4; ++j) v[j] = v[j] * r * gv[j];
        unsigned long long* o8 = (unsigned long long*)(XN + (size_t)m * DM) + F.lane;
#pragma unroll
        for (int j = 0; j < 4; ++j) o8[64 * j] = (unsigned long long)cvt_pk_bf16(v[j].x, v[j].y) | ((unsigned long long)cvt_pk_bf16(v[j].z, v[j].w) << 32);
        if (MODE != 1) {
            float d[8];
#pragma unroll
            for (int c = 0; c < 8; ++c) d[c] = 0.f;
#pragma unroll
            for (int j = 0; j < 4; ++j)
#pragma unroll
                for (int q = 0; q < 4; ++q) { const LAS float* wp = w8 + (4 * F.lane + 256 * j + q) * 8; const f32x4 wa = *(const LAS f32x4*)wp, wb = *(const LAS f32x4*)(wp + 4); const float y = v[j][q];
                    d[0] += y * wa.x; d[1] += y * wa.y; d[2] += y * wa.z; d[3] += y * wa.w; d[4] += y * wb.x; d[5] += y * wb.y; d[6] += y * wb.z; d[7] += y * wb.w; }
#pragma unroll
            for (int c = 0; c < 8; ++c) d[c] = wave_sum(d[c]);
            if (MODE == 0) {
                if (F.lane < 8) { float val = 0.f;
#pragma unroll
                    for (int c = 0; c < 8; ++c) val = (F.lane == c) ? d[c] : val;
                    float o;
                    if (F.lane < 4) o = val + bi[F.lane];
                    else { const float fp = val + bf[F.lane - 4]; o = fminf(fp, 0.f) - log1pf(__expf(-fabsf(fp))); }
                    ((float*)(F.ws + WS_GATES))[(size_t)m * 8 + F.lane] = o; }
            } else {
                int e1 = 0; float v1 = d[0];
#pragma unroll
                for (int c = 1; c < 8; ++c) if (d[c] > v1) { v1 = d[c]; e1 = c; }
                int e2 = -1; float v2 = -INFINITY;
#pragma unroll
                for (int c = 0; c < 8; ++c) if (c != e1 && d[c] > v2) { v2 = d[c]; e2 = c; }
                const float ex = __expf(v2 - v1), w1 = 1.0f / (1.0f + ex), w2 = ex * w1;
                if (F.lane < 2) { const int e = F.lane == 0 ? e1 : e2; const float w = F.lane == 0 ? w1 : w2;
                    const unsigned pos = __hip_atomic_fetch_add(((unsigned*)F.ws + CW_MOE + 64 * (F.lane * 8 + e)), 1u, __ATOMIC_RELAXED, __HIP_MEMORY_SCOPE_AGENT);
                    ((int*)(F.ws + WS_MIDX))[(size_t)(F.lane * 8 + e) * 32768 + pos] = m; ((float*)(F.ws + WS_MWGT))[(size_t)(F.lane * 8 + e) * 32768 + pos] = w; }
            }
        }
    }
    __syncthreads();
}

__device__ __forceinline__ void moba_prep_item(const Frame& F0, int it, const float* qg, const float* kg) {
    Frame F = unit_frame(F0);
    const int h = it & 7, blk = (it >> 3) & 15, b = it >> 7;
    const size_t r0 = (size_t)b * SEQ + blk * ABLK;
    const int row = F.tid >> 1, half = F.tid & 1;
    LAS float* part = (LAS float*)F.lds;
    bf16_t* qp = (bf16_t*)(F.ws + WS_AQ) + (r0 + row) * 512 + h * 64 + half * 32;
    bf16_t* kp = (bf16_t*)(F.ws + WS_AK) + (r0 + row) * 512 + h * 64 + half * 32;
    float gq[32], gk[32];
#pragma unroll
    for (int i = 0; i < 32; ++i) { gq[i] = qg[half * 32 + i] * QSCALE; gk[i] = kg[half * 32 + i]; }
    {
        u32x4 w[4]; float x[32]; float ss = 0.f;
#pragma unroll
        for (int i = 0; i < 4; ++i) w[i] = ((const u32x4*)qp)[i];
#pragma unroll
        for (int i = 0; i < 4; ++i) { x[8 * i + 0] = bf_lo(w[i].x); x[8 * i + 1] = bf_hi(w[i].x); x[8 * i + 2] = bf_lo(w[i].y); x[8 * i + 3] = bf_hi(w[i].y); x[8 * i + 4] = bf_lo(w[i].z); x[8 * i + 5] = bf_hi(w[i].z); x[8 * i + 6] = bf_lo(w[i].w); x[8 * i + 7] = bf_hi(w[i].w); }
#pragma unroll
        for (int i = 0; i < 32; ++i) ss += x[i] * x[i];
        ss = shx_sum<1>(ss);
        const float r = 1.0f / sqrtf(ss * (1.f / 64.f) + EPS);
#pragma unroll
        for (int i = 0; i < 4; ++i) { u32x4 o; o.x = cvt_pk_bf16(x[8 * i] * r * gq[8 * i], x[8 * i + 1] * r * gq[8 * i + 1]); o.y = cvt_pk_bf16(x[8 * i + 2] * r * gq[8 * i + 2], x[8 * i + 3] * r * gq[8 * i + 3]);
            o.z = cvt_pk_bf16(x[8 * i + 4] * r * gq[8 * i + 4], x[8 * i + 5] * r * gq[8 * i + 5]); o.w = cvt_pk_bf16(x[8 * i + 6] * r * gq[8 * i + 6], x[8 * i + 7] * r * gq[8 * i + 7]); ((u32x4*)qp)[i] = o; }
    }
    {
        u32x4 w[4]; float x[32]; float ss = 0.f;
#pragma unroll
        for (int i = 0; i < 4; ++i) w[i] = ((const u32x4*)kp)[i];
#pragma unroll
        for (int i = 0; i < 4; ++i) { x[8 * i + 0] = bf_lo(w[i].x); x[8 * i + 1] = bf_hi(w[i].x); x[8 * i + 2] = bf_lo(w[i].y); x[8 * i + 3] = bf_hi(w[i].y); x[8 * i + 4] = bf_lo(w[i].z); x[8 * i + 5] = bf_hi(w[i].z); x[8 * i + 6] = bf_lo(w[i].w); x[8 * i + 7] = bf_hi(w[i].w); }
#pragma unroll
        for (int i = 0; i < 32; ++i) ss += x[i] * x[i];
        ss = shx_sum<1>(ss);
        const float r = 1.0f / sqrtf(ss * (1.f / 64.f) + EPS);
#pragma unroll
        for (int i = 0; i < 32; ++i) x[i] = x[i] * r * gk[i];
#pragma unroll
        for (int i = 0; i < 4; ++i) { u32x4 o; o.x = cvt_pk_bf16(x[8 * i], x[8 * i + 1]); o.y = cvt_pk_bf16(x[8 * i + 2], x[8 * i + 3]); o.z = cvt_pk_bf16(x[8 * i + 4], x[8 * i + 5]); o.w = cvt_pk_bf16(x[8 * i + 6], x[8 * i + 7]); ((u32x4*)kp)[i] = o; }
#pragma unroll
        for (int i = 0; i < 32; ++i) { float s = x[i]; s = shx_sum<2>(s); s = shx_sum<4>(s); s = shx_sum<8>(s); s = shx_sum<16>(s); s = shx_sum<32>(s); x[i] = s; }
        if (F.lane < 2) {
#pragma unroll
            for (int i = 0; i < 32; ++i) part[F.wave * 64 + half * 32 + i] = x[i]; }
    }
    __syncthreads();
    if (F.tid < 64) { float s = 0.f;
#pragma unroll
        for (int w = 0; w < 8; ++w) s += part[w * 64 + F.tid];
        ((float*)(F.ws + WS_KMEAN))[((size_t)(b * 8 + h) * 16 + blk) * 64 + F.tid] = s * (1.f / 256.f); }
    __syncthreads();
}

constexpr int ML_TILE = 128 * 272;
constexpr int ML_Q = 0, ML_K = ML_TILE, ML_VT = 2 * ML_TILE, ML_CT = 3 * ML_TILE, ML_TAB = 4 * ML_TILE;
constexpr int MT_BB = 0, MT_U = 1, MT_M = 2, MT_WST = 3, MT_LIM = 4, MT_N = 5, MT_QN = 6, MT_INV = 7, MT_WS = 8, MT_SC = 9;
static_assert(ML_TAB + 10 * 512 <= MISC_OFF, "mLSTM LDS map");

__device__ __forceinline__ void ml_scalars(Frame& F, size_t r0, int h, LAS float* tab, float& umax_out, float& blast_out) {
    const float* G = (const float*)(F.ws + WS_GATES);
    const int l = F.lane;
    const float i0 = G[(r0 + 2 * l) * 8 + h], i1 = G[(r0 + 2 * l + 1) * 8 + h];
    const float f0 = G[(r0 + 2 * l) * 8 + 4 + h], f1 = G[(r0 + 2 * l + 1) * 8 + 4 + h];
    float ps = f0 + f1, sc = ps;
#pragma unroll
    for (int o = 1; o < 64; o <<= 1) { const float t = bperm(l >= o ? l - o : l, sc); if (l >= o) sc += t; }
    const float ex = sc - ps;
    const float b0 = ex + f0, b1 = ex + ps;
    const float u0 = i0 - b0, u1 = i1 - b1;
    float pm = fmaxf(u0, u1), sm = pm;
#pragma unroll
    for (int o = 1; o < 64; o <<= 1) { const float t = bperm(l >= o ? l - o : l, sm); if (l >= o) sm = fmaxf(sm, t); }
    const float pe = bperm(l >= 1 ? l - 1 : l, sm);
    const float p0 = (l == 0) ? u0 : fmaxf(pe, u0), p1 = fmaxf(p0, u1);
    tab[MT_BB * 128 + 2 * l] = b0; tab[MT_BB * 128 + 2 * l + 1] = b1;
    tab[MT_U * 128 + 2 * l] = u0; tab[MT_U * 128 + 2 * l + 1] = u1;
    tab[MT_M * 128 + 2 * l] = p0; tab[MT_M * 128 + 2 * l + 1] = p1;
    umax_out = __int_as_float(__builtin_amdgcn_readlane(__float_as_int(sm), 63)); blast_out = __int_as_float(__builtin_amdgcn_readlane(__float_as_int(sc), 63));
}
template <bool TR>
__device__ __forceinline__ void ml_stage_conv(Frame& F, LAS unsigned char* tile, size_t r0, int tpos0, int col0, const float* cw, const float* cb, float scale) {
    const bf16_t* src = (const bf16_t*)(F.ws + WS_MQK);
    const int cg = F.tid & 15, rg = F.tid >> 4;
    float w[4][8], bias[8];
#pragma unroll
    for (int j = 0; j < 4; ++j)
#pragma unroll
        for (int i = 0; i < 8; ++i) w[j][i] = cw[j * 1024 + col0 + cg * 8 + i];
#pragma unroll
    for (int i = 0; i < 8; ++i) bias[i] = cb[col0 + cg * 8 + i];
    float x[7][8];
#pragma unroll
    for (int j = 0; j < 7; ++j) { const int rr = 4 * rg - 3 + j;
        if (tpos0 + rr >= 0) { const u32x4 v = *(const u32x4*)(src + (size_t)((long)r0 + rr) * 1024 + col0 + cg * 8);
            x[j][0] = bf_lo(v.x); x[j][1] = bf_hi(v.x); x[j][2] = bf_lo(v.y); x[j][3] = bf_hi(v.y); x[j][4] = bf_lo(v.z); x[j][5] = bf_hi(v.z); x[j][6] = bf_lo(v.w); x[j][7] = bf_hi(v.w); }
        else {
#pragma unroll
            for (int i = 0; i < 8; ++i) x[j][i] = 0.f; } }
#pragma unroll
    for (int rr = 0; rr < 4; ++rr) { float y[8];
#pragma unroll
        for (int i = 0; i < 8; ++i) { float a = bias[i] + w[0][i] * x[rr][i] + w[1][i] * x[rr + 1][i] + w[2][i] * x[rr + 2][i] + w[3][i] * x[rr + 3][i]; y[i] = a * sigmoidf_(a) * scale; }
        const int row = 4 * rg + rr;
        if (!TR) { u32x4 o; o.x = cvt_pk_bf16(y[0], y[1]); o.y = cvt_pk_bf16(y[2], y[3]); o.z = cvt_pk_bf16(y[4], y[5]); o.w = cvt_pk_bf16(y[6], y[7]); *(LAS u32x4*)(tile + row * 272 + cg * 16) = o; }
        else {
#pragma unroll
            for (int i = 0; i < 8; i += 2) { const unsigned pk = cvt_pk_bf16(y[i], y[i + 1]); *(LAS bf16_t*)(tile + (cg * 8 + i) * 272 + row * 2) = (bf16_t)(pk & 0xffffu); *(LAS bf16_t*)(tile + (cg * 8 + i + 1) * 272 + row * 2) = (bf16_t)(pk >> 16); } }
    }
}
__device__ __forceinline__ void ml_stage_vt(Frame& F, LAS unsigned char* tile, size_t r0, int col0, const LAS float* rs) {
    const bf16_t* src = (const bf16_t*)(F.ws + WS_MV);
    const int cg = F.tid & 15, rg = F.tid >> 4;
#pragma unroll
    for (int rr = 0; rr < 4; ++rr) { const int row = 4 * rg + rr; const u32x4 v = *(const u32x4*)(src + (r0 + row) * 512 + col0 + cg * 8);
        float y[8] = {bf_lo(v.x), bf_hi(v.x), bf_lo(v.y), bf_hi(v.y), bf_lo(v.z), bf_hi(v.z), bf_lo(v.w), bf_hi(v.w)};
        const float sc = rs ? rs[row] : 1.0f;
#pragma unroll
        for (int i = 0; i < 8; i += 2) { const unsigned pk = cvt_pk_bf16(y[i] * sc, y[i + 1] * sc); *(LAS bf16_t*)(tile + (cg * 8 + i) * 272 + row * 2) = (bf16_t)(pk & 0xffffu); *(LAS bf16_t*)(tile + (cg * 8 + i + 1) * 272 + row * 2) = (bf16_t)(pk >> 16); } }
}
#define SYNC_SB() do { __syncthreads(); __builtin_amdgcn_sched_barrier(0); } while (0)
#define MFMA32(a, b, c) __builtin_amdgcn_mfma_f32_32x32x16_bf16(a, b, c, 0, 0, 0)
__device__ __forceinline__ void ml_mma(LAS unsigned char* TA, LAS unsigned char* TB, int rb, int cb, int lane, f32x16& c0, f32x16& c1) {
    const int r32 = lane & 31, hi = lane >> 5;
#pragma unroll 2
    for (int k = 0; k < 8; ++k) {
        const bf16x8 a = *(const LAS bf16x8*)(TA + (rb + r32) * 272 + k * 32 + hi * 16);
        const bf16x8 b0 = *(const LAS bf16x8*)(TB + (cb + r32) * 272 + k * 32 + hi * 16);
        const bf16x8 b1 = *(const LAS bf16x8*)(TB + (cb + 32 + r32) * 272 + k * 32 + hi * 16);
        c0 = MFMA32(a, b0, c0); c1 = MFMA32(a, b1, c1);
    }
}


__device__ __forceinline__ float ml_dot32(const LAS unsigned char* row, const LAS float* tabv) {
    float s = 0.f;
#pragma unroll 1
    for (int q = 0; q < 4; ++q) { const u32x4 w = *(const LAS u32x4*)(row + q * 16);
        if (tabv) { const f32x4 a = *(const LAS f32x4*)(tabv + q * 8), b = *(const LAS f32x4*)(tabv + q * 8 + 4);
            s += bf_lo(w.x) * a.x + bf_hi(w.x) * a.y + bf_lo(w.y) * a.z + bf_hi(w.y) * a.w + bf_lo(w.z) * b.x + bf_hi(w.z) * b.y + bf_lo(w.w) * b.z + bf_hi(w.w) * b.w; }
        else s += (bf_lo(w.x) + bf_hi(w.x)) + (bf_lo(w.y) + bf_hi(w.y)) + (bf_lo(w.z) + bf_hi(w.z)) + (bf_lo(w.w) + bf_hi(w.w)); }
    return s;
}
__device__ __forceinline__ void mlstm_local(const Frame& F0, int unit, const float* cw, const float* cb) {
    Frame F = unit_frame(F0);
    const int c = unit & 31, h = (unit >> 5) & 3, b = unit >> 7;
    const size_t r0 = (size_t)b * SEQ + c * MCH;
    LAS float* tab = (LAS float*)(F.lds + ML_TAB);
    if (F.wave == 0) { float umax, blast; ml_scalars(F, r0, h, tab, umax, blast);
        tab[MT_WS * 128 + 2 * F.lane] = __expf(tab[MT_U * 128 + 2 * F.lane] - umax); tab[MT_WS * 128 + 2 * F.lane + 1] = __expf(tab[MT_U * 128 + 2 * F.lane + 1] - umax);
        if (F.lane == 0) { float* sc = (float*)(F.ws + WS_MSC); sc[unit] = umax; sc[1024 + unit] = blast; } }
    SYNC_SB();
    ml_stage_conv<true>(F, F.lds + ML_K, r0, c * MCH, 512 + h * 128, cw, cb, 0.08838834764831845f);
    __builtin_amdgcn_sched_barrier(0);
    ml_stage_vt(F, F.lds + ML_VT, r0, h * 128, tab + MT_WS * 128);
    SYNC_SB();
    {
        f32x16 c0 = {}, c1 = {}; const int rb = 32 * (F.wave & 3), cbk = 64 * (F.wave >> 2);
        ml_mma(F.lds + ML_VT, F.lds + ML_K, rb, cbk, F.lane, c0, c1);
        float* U = (float*)(F.ws + WS_XN) + (size_t)unit * 16384; const int r32 = F.lane & 31, hi = F.lane >> 5;
#pragma unroll
        for (int r = 0; r < 16; ++r) { const int e = rb + crow(r, hi); U[e * 128 + cbk + r32] = c0[r]; U[e * 128 + cbk + 32 + r32] = c1[r]; }
    }
    {
        const int d = F.tid >> 2, part = F.tid & 3; float s = ml_dot32(F.lds + ML_K + d * 272 + part * 64, tab + MT_WS * 128 + part * 32);
        s = shx_sum<1>(s); s = shx_sum<2>(s);
        if (part == 0) ((float*)(F.ws + WS_UN))[(size_t)unit * 128 + d] = s;
    }
    SYNC_SB();
}
__device__ __forceinline__ void mlstm_scan(const Frame& F0, int bh, int slice) {
    Frame F = unit_frame(F0);
    const float* sc = (const float*)(F.ws + WS_MSC);
    const float* U = (const float*)(F.ws + WS_XN); bf16_t* C = (bf16_t*)(F.ws + WS_CST);
    const int eoff = slice * 2048 + F.tid * 4;
    f32x4 cst = {0.f, 0.f, 0.f, 0.f}; float nst = 0.f; float m = 0.f;
    const bool don = (slice == 0) && (F.tid < 128);
    for (int c = 0; c < NCH; ++c) { const int unit = bh * 32 + c;
        *(u32x2*)(C + (size_t)unit * 16384 + eoff) = (u32x2){cvt_pk_bf16(cst.x, cst.y), cvt_pk_bf16(cst.z, cst.w)};
        if (don) ((float*)(F.ws + WS_NST))[(size_t)unit * 128 + F.tid] = nst;
        if (slice == 0 && F.tid == 0) ((float*)(F.ws + WS_MSC))[2048 + unit] = m;
        const float umax = sc[unit], blast = sc[1024 + unit];
        const float Mx = fmaxf(m, umax); const float dc = __expf(m - Mx), du = __expf(umax - Mx);
        const f32x4 u = *(const f32x4*)(U + (size_t)unit * 16384 + eoff);
        cst = cst * dc + u * du;
        if (don) nst = nst * dc + ((const float*)(F.ws + WS_UN))[(size_t)unit * 128 + F.tid] * du;
        m = blast + Mx;
    }
}
__device__ __forceinline__ void mlstm_out(const Frame& F0, int unit, const float* cw, const float* cb, const float* ng) {
    Frame F = unit_frame(F0);
    const int c = unit & 31, h = (unit >> 5) & 3, b = unit >> 7;
    const size_t r0 = (size_t)b * SEQ + c * MCH;
    LAS float* tab = (LAS float*)(F.lds + ML_TAB);
    const float m = ((const float*)(F.ws + WS_MSC))[2048 + unit];
    if (F.wave == 0) { float umax, blast; ml_scalars(F, r0, h, tab, umax, blast);
#pragma unroll
        for (int q = 0; q < 2; ++q) { const int t = 2 * F.lane + q; const float Mt = fmaxf(m, tab[MT_M * 128 + t]);
            tab[MT_M * 128 + t] = Mt; tab[MT_WST * 128 + t] = __expf(m - Mt); tab[MT_LIM * 128 + t] = __expf(-tab[MT_BB * 128 + t] - Mt); } }
    if (F.tid >= 64 && F.tid < 192) tab[MT_N * 128 + F.tid - 64] = ((const float*)(F.ws + WS_NST))[(size_t)unit * 128 + F.tid - 64];
    __builtin_amdgcn_sched_barrier(0);
    ml_stage_conv<false>(F, F.lds + ML_Q, r0, c * MCH, h * 128, cw, cb, 1.0f);
    __builtin_amdgcn_sched_barrier(0);
    ml_stage_conv<false>(F, F.lds + ML_K, r0, c * MCH, 512 + h * 128, cw, cb, 0.08838834764831845f);
    __builtin_amdgcn_sched_barrier(0);
    ml_stage_vt(F, F.lds + ML_VT, r0, h * 128, nullptr);
    __builtin_amdgcn_sched_barrier(0);
    {
        const bf16_t* C = (const bf16_t*)(F.ws + WS_CST) + (size_t)unit * 16384;
#pragma unroll
        for (int i = 0; i < 4; ++i) { const int q = F.tid + 512 * i; const int e = q >> 4, ch = q & 15; *(LAS u32x4*)(F.lds + ML_CT + e * 272 + ch * 16) = *(const u32x4*)(C + e * 128 + ch * 8); }
    }
    SYNC_SB();
    const int rb = 32 * (F.wave & 3), cbk = 64 * (F.wave >> 2), r32 = F.lane & 31, hi = F.lane >> 5;
    f32x16 s0 = {}, s1 = {};
    ml_mma(F.lds + ML_Q, F.lds + ML_K, rb, cbk, F.lane, s0, s1);
    {
        const float u0 = tab[MT_U * 128 + cbk + r32], u1 = tab[MT_U * 128 + cbk + 32 + r32];
#pragma unroll
        for (int r = 0; r < 16; ++r) { const int t = rb + crow(r, hi); const float Mt = tab[MT_M * 128 + t];
            s0[r] = (cbk + r32 <= t) ? s0[r] * __expf(u0 - Mt) : 0.f; s1[r] = (cbk + 32 + r32 <= t) ? s1[r] * __expf(u1 - Mt) : 0.f; }
    }
    {
        const int t = F.tid >> 2, part = F.tid & 3; float s = ml_dot32(F.lds + ML_Q + t * 272 + part * 64, tab + MT_N * 128 + part * 32);
        s = shx_sum<1>(s); s = shx_sum<2>(s);
        if (part == 0) tab[MT_QN * 128 + t] = s;
    }
    SYNC_SB();
#pragma unroll
    for (int r = 0; r < 16; r += 2) {
        const unsigned pa = cvt_pk_bf16(s0[r], s0[r + 1]), pb = cvt_pk_bf16(s1[r], s1[r + 1]);
        const int t0 = rb + crow(r, hi), t1 = rb + crow(r + 1, hi);
        *(LAS bf16_t*)(F.lds + ML_K + t0 * 272 + (cbk + r32) * 2) = (bf16_t)(pa & 0xffffu); *(LAS bf16_t*)(F.lds + ML_K + t1 * 272 + (cbk + r32) * 2) = (bf16_t)(pa >> 16);
        *(LAS bf16_t*)(F.lds + ML_K + t0 * 272 + (cbk + 32 + r32) * 2) = (bf16_t)(pb & 0xffffu); *(LAS bf16_t*)(F.lds + ML_K + t1 * 272 + (cbk + 32 + r32) * 2) = (bf16_t)(pb >> 16);
    }
    SYNC_SB();
    f32x16 p0 = {}, p1 = {}, q0 = {}, q1 = {};
    ml_mma(F.lds + ML_K, F.lds + ML_VT, rb, cbk, F.lane, p0, p1);
    __builtin_amdgcn_sched_barrier(0);
    ml_mma(F.lds + ML_Q, F.lds + ML_CT, rb, cbk, F.lane, q0, q1);
    {
        const int t = F.tid >> 2, part = F.tid & 3; float s = ml_dot32(F.lds + ML_K + t * 272 + part * 64, nullptr);
        s = shx_sum<1>(s); s = shx_sum<2>(s);
        if (part == 0) { const float den = s + tab[MT_WST * 128 + t] * tab[MT_QN * 128 + t]; tab[MT_INV * 128 + t] = 1.0f / fmaxf(fabsf(den), tab[MT_LIM * 128 + t]); }
    }
    SYNC_SB();
    LAS float* H = (LAS float*)(F.lds + ML_Q);
#pragma unroll
    for (int r = 0; r < 16; ++r) { const int t = rb + crow(r, hi); const float w = tab[MT_WST * 128 + t], iv = tab[MT_INV * 128 + t];
        H[t * 132 + cbk + r32] = (p0[r] + w * q0[r]) * iv; H[t * 132 + cbk + 32 + r32] = (p1[r] + w * q1[r]) * iv; }
    SYNC_SB();
    {
        const int t = F.tid >> 2, part = F.tid & 3;
        bf16_t* op = (bf16_t*)(F.ws + WS_MO) + (r0 + t) * 512 + h * 128 + part * 32;
        float x[32]; float ss = 0.f;
#pragma unroll
        for (int i = 0; i < 4; ++i) { const u32x4 g = ((const u32x4*)op)[i]; const LAS float* hp = H + t * 132 + part * 32 + 8 * i;
            x[8 * i] = hp[0] * bf_lo(g.x); x[8 * i + 1] = hp[1] * bf_hi(g.x); x[8 * i + 2] = hp[2] * bf_lo(g.y); x[8 * i + 3] = hp[3] * bf_hi(g.y);
            x[8 * i + 4] = hp[4] * bf_lo(g.z); x[8 * i + 5] = hp[5] * bf_hi(g.z); x[8 * i + 6] = hp[6] * bf_lo(g.w); x[8 * i + 7] = hp[7] * bf_hi(g.w); }
#pragma unroll
        for (int i = 0; i < 32; ++i) ss += x[i] * x[i];
        ss = shx_sum<1>(ss); ss = shx_sum<2>(ss);
        const float r = 1.0f / sqrtf(ss * (1.f / 128.f) + EPS);
        const float* gp = ng + h * 128 + part * 32;
#pragma unroll
        for (int i = 0; i < 4; ++i) { u32x4 o; o.x = cvt_pk_bf16(x[8 * i] * r * gp[8 * i], x[8 * i + 1] * r * gp[8 * i + 1]); o.y = cvt_pk_bf16(x[8 * i + 2] * r * gp[8 * i + 2], x[8 * i + 3] * r * gp[8 * i + 3]);
            o.z = cvt_pk_bf16(x[8 * i + 4] * r * gp[8 * i + 4], x[8 * i + 5] * r * gp[8 * i + 5]); o.w = cvt_pk_bf16(x[8 * i + 6] * r * gp[8 * i + 6], x[8 * i + 7] * r * gp[8 * i + 7]); ((u32x4*)op)[i] = o; }
    }
    SYNC_SB();
}

namespace attn {
constexpr int DMP = 512;
constexpr int NW = 8, QBLK = 32, QB = 256, KVBLK = 64;
#define SBAR() __builtin_amdgcn_sched_barrier(0)
constexpr int NSLOT = 3, SLOTB = 8192;
constexpr int LDS_K = 0, LDS_V = NSLOT * SLOTB, LDS_WS = 2 * NSLOT * SLOTB, LDS_OST = LDS_WS + NW * 64 * 4, LDS_END = LDS_OST + NW * 4096;
constexpr int TB_N = 1536, TB_COPY = TB_N * 4, LDS_TB = LDS_END;
constexpr int LDS_KM = LDS_TB + 4 * TB_COPY;
constexpr int LDS_ATT_END = LDS_KM + 4096;
static_assert(LDS_ATT_END <= MISC_OFF, "attention LDS map");
typedef LAS const char* lds_cptr;
typedef short v4i16_t __attribute__((ext_vector_type(4)));
__device__ __forceinline__ void glds16(const void* gsrc, unsigned lds_dst) { unsigned keep;
  asm volatile("s_mov_b32 %0, m0\n\ts_mov_b32 m0, %2\n\ts_nop 0\n\tglobal_load_lds_dwordx4 %1, off\n\ts_mov_b32 m0, %0" : "=&s"(keep) : "v"(gsrc), "s"(lds_dst) : "memory"); }
__device__ __forceinline__ float max3f(float a, float b, float c) { float r; asm("v_max3_f32 %0, %1, %2, %3" : "=v"(r) : "v"(a), "v"(b), "v"(c)); return r; }
__device__ __forceinline__ float max2f(float a, float b) { float r; asm("v_max_f32_e32 %0, %1, %2" : "=v"(r) : "v"(a), "v"(b)); return r; }
__device__ __forceinline__ float fadd_s(float a, float b) { float r; asm("v_add_f32_e32 %0, %1, %2" : "=v"(r) : "v"(a), "v"(b)); return r; }
__device__ __forceinline__ float fsub_s(float a, float b) { float r; asm("v_sub_f32_e32 %0, %1, %2" : "=v"(r) : "v"(a), "v"(b)); return r; }
typedef __bf16 bf16x2_t __attribute__((ext_vector_type(2)));
__device__ __forceinline__ unsigned cvtpk_s(float lo, float hi) { f32x2 v = {lo, hi}; bf16x2_t b = __builtin_convertvector(v, bf16x2_t); return __builtin_bit_cast(unsigned, b); }
#define WAIT_BAR(N) asm volatile("s_waitcnt vmcnt(" #N ") lgkmcnt(0)\n\ts_barrier" ::: "memory")
__device__ __forceinline__ void kload8(bf16x8* kf, lds_cptr kp) {
  kf[0] = *(const LAS bf16x8*)(kp);        kf[1] = *(const LAS bf16x8*)(kp + 512);
  kf[2] = *(const LAS bf16x8*)(kp + 2048); kf[3] = *(const LAS bf16x8*)(kp + 2560);
  kf[4] = *(const LAS bf16x8*)(kp + 4096); kf[5] = *(const LAS bf16x8*)(kp + 4608);
  kf[6] = *(const LAS bf16x8*)(kp + 6144); kf[7] = *(const LAS bf16x8*)(kp + 6656);
}
__device__ __forceinline__ void kload2(bf16x8* kf, lds_cptr kp, int j) { kf[2 * j] = *(const LAS bf16x8*)(kp + j * 2048); kf[2 * j + 1] = *(const LAS bf16x8*)(kp + j * 2048 + 512); }
__device__ __forceinline__ s16x4 vtr(lds_cptr p) { return __builtin_bit_cast(s16x4, __builtin_amdgcn_ds_read_tr16_b64_v4i16((LAS v4i16_t*)p)); }
__device__ __forceinline__ float rowmax(const f32x16& p0, const f32x16& p1) {
  float a = max3f(p0[0], p0[1], p1[0]), b = max3f(p0[2], p0[3], p1[1]); a = max3f(a, p1[2], p1[3]);
#pragma unroll
  for (int r = 4; r < 16; r += 4) { a = max3f(a, p0[r], p0[r + 1]); b = max3f(b, p0[r + 2], p0[r + 3]); a = max3f(a, p1[r], p1[r + 1]); b = max3f(b, p1[r + 2], p1[r + 3]); }
  const float m = max2f(a, b);
  auto rr = __builtin_amdgcn_permlane32_swap(__float_as_uint(m), __float_as_uint(m), false, false);
  return max2f(__uint_as_float(rr[0]), __uint_as_float(rr[1]));
}
__device__ __forceinline__ void pv(f32x16* o, int vb, bf16x8 pa0, bf16x8 pa1, bf16x8 pa2, bf16x8 pa3) {
#pragma unroll
  for (int d0 = 0; d0 < 2; ++d0) { s16x4 lo[4], hi[4];
#pragma unroll
    for (int ks = 0; ks < 4; ++ks) {
      asm volatile("ds_read_b64_tr_b16 %0,%1 offset:%c2" : "=&v"(lo[ks]) : "v"(vb), "i"(d0 * 4096 + ks * 1024) : "memory");
      asm volatile("ds_read_b64_tr_b16 %0,%1 offset:%c2" : "=&v"(hi[ks]) : "v"(vb), "i"(d0 * 4096 + ks * 1024 + 512) : "memory"); }
    asm volatile("s_waitcnt lgkmcnt(0)" ::: "memory"); SBAR();
#define PK(k) (bf16x8){lo[k][0], lo[k][1], lo[k][2], lo[k][3], hi[k][0], hi[k][1], hi[k][2], hi[k][3]}
    o[d0] = MFMA32(pa0, PK(0), o[d0]); o[d0] = MFMA32(pa1, PK(1), o[d0]); o[d0] = MFMA32(pa2, PK(2), o[d0]); o[d0] = MFMA32(pa3, PK(3), o[d0]);
#undef PK
  }
}
template <int THRL> __device__ __forceinline__ void attn_unit(int b, int h, int qb, const bf16_t* Q, const bf16_t* __restrict__ K, const bf16_t* __restrict__ V, bf16_t* O, LAS unsigned char* shm, int wid, int lane, float b31) {
  const int r32 = lane & 31, hi = lane >> 5;
  const long rowbase = (long)b * SEQ; const int q0 = qb * QB;
  const bf16_t* Qw = Q + (rowbase + q0 + wid * QBLK) * DMP + h * ADH;
  const bf16_t* Kh = K + rowbase * DMP + h * ADH; const bf16_t* Vh = V + rowbase * DMP + h * ADH;
  const unsigned lds0 = (unsigned)(uintptr_t)shm;
  LAS float* wsf = (LAS float*)(shm + LDS_WS) + wid * 64;
  const bf16_t* ksrc = Kh + (long)lane * DMP + wid * 8;
  const bf16_t* vsrc = Vh + (long)(16 * (wid & 3) + (lane >> 2)) * DMP + (wid >> 2) * 32 + (lane & 3) * 8;
  const unsigned kdst = lds0 + LDS_K + wid * 1024, vdst = lds0 + LDS_V + wid * 1024;
#define PT(t) (4 * (qb - ((t) >> 2)) + ((t) & 3))
#define DMA_K(t, slot) glds16(ksrc + (long)PT(t) * KVBLK * DMP, (unsigned)__builtin_amdgcn_readfirstlane(kdst + (slot)))
#define DMA_V(t, slot) glds16(vsrc + (long)PT(t) * KVBLK * DMP, (unsigned)__builtin_amdgcn_readfirstlane(vdst + (slot)))
  const int vb0 = (int)(lds0 + LDS_V) + ((lane >> 4) & 1) * 32 + (lane & 3) * 8 + (4 * hi + ((lane & 15) >> 2)) * 64;
  const lds_cptr shm3 = (lds_cptr)shm; const lds_cptr Kbase = shm3 + LDS_K; bf16x8 kf[8];
  const lds_cptr kp0 = shm3 + LDS_K + hi * 1024 + r32 * 16; const lds_cptr vp0 = shm3 + LDS_V + ((lane >> 4) & 1) * 32 + (lane & 3) * 8 + (4 * hi + ((lane & 15) >> 2)) * 64;
  const int NT = 4 * (qb + 1);
  DMA_K(0, 0); DMA_V(0, 0); DMA_K(1, SLOTB);
  bf16x8 qr[4];
#pragma unroll
  for (int d0 = 0; d0 < 4; ++d0) qr[d0] = *reinterpret_cast<const bf16x8*>(&Qw[(long)r32 * DMP + d0 * 16 + hi * 8]);
  DMA_K(2, 2 * SLOTB);
  const int ta = (3 - (r32 & 3)) & 3;
  const lds_cptr tb0 = shm3 + LDS_TB + ta * TB_COPY + 4 * (1279 - 32 * wid - r32 - ta) + 16 * hi;
#define TBP(t) (tb0 - 1024 * ((t) >> 2) + 256 * ((t) & 3))
#define BLD(X, sw, p, off) X.sw = *(const LAS f32x4*)((p) + (off))
  f32x16 pA0, pA1, pB0, pB1;
  { const lds_cptr p = TBP(0); BLD(pA0, s0123, p, 0); BLD(pA0, s4567, p, 32); BLD(pA0, s89ab, p, 64); BLD(pA0, scdef, p, 96); BLD(pA1, s0123, p, 128); BLD(pA1, s4567, p, 160); BLD(pA1, s89ab, p, 192); BLD(pA1, scdef, p, 224); }
  unsigned selmask = 0u;
  { float v1 = -INFINITY, v2 = -INFINITY, v3 = -INFINITY; int i1 = -1, i2 = -1, i3 = -1;
    const LAS float* KM = (const LAS float*)(shm + LDS_KM);
#pragma unroll 1
    for (int j = 0; j < qb; ++j) { float s = 0.f;
#pragma unroll
      for (int d0 = 0; d0 < 4; ++d0) { const f32x4 ka = *(const LAS f32x4*)(KM + j * 64 + d0 * 16 + hi * 8), kb = *(const LAS f32x4*)(KM + j * 64 + d0 * 16 + hi * 8 + 4);
        s += bf2f((bf16_t)qr[d0][0]) * ka.x + bf2f((bf16_t)qr[d0][1]) * ka.y + bf2f((bf16_t)qr[d0][2]) * ka.z + bf2f((bf16_t)qr[d0][3]) * ka.w
           + bf2f((bf16_t)qr[d0][4]) * kb.x + bf2f((bf16_t)qr[d0][5]) * kb.y + bf2f((bf16_t)qr[d0][6]) * kb.z + bf2f((bf16_t)qr[d0][7]) * kb.w; }
      s = shx_sum<32>(s);
      if (s > v1) { v3 = v2; i3 = i2; v2 = v1; i2 = i1; v1 = s; i1 = j; } else if (s > v2) { v3 = v2; i3 = i2; v2 = s; i2 = j; } else if (s > v3) { v3 = s; i3 = j; } }
    if (i1 >= 0) selmask |= 1u << i1; if (i2 >= 0) selmask |= 1u << i2; if (i3 >= 0) selmask |= 1u << i3; }
  float mhat = 0.f, l_reg = 0.f; f32x16 o[2]; o[0] = f32x16{}; o[1] = f32x16{};
  float selneg = 0.f, msel = 0.f;
#define BLOCKSEL(t, MODE) do { if ((t) >= 4) selneg = ((selmask >> (qb - ((t) >> 2))) & 1u) ? 0.f : -INFINITY; \
    msel = (MODE) ? (selneg - mhat) : (selneg + (b31 - mhat)); } while (0)
  bool resc = false;
#define RESC() do { if (resc) { asm volatile("s_waitcnt lgkmcnt(0)" ::: "memory"); \
      _Pragma("unroll") for (int d_ = 0; d_ < 2; ++d_) _Pragma("unroll") for (int r = 0; r < 16; ++r) o[d_][r] *= wsf[crow(r, hi)]; } } while (0)
  int sl_prev = 0, sl_cur = 0, sl_next = SLOTB;
#define ROT() do { sl_prev = sl_cur; sl_cur = sl_next; sl_next = (sl_next == (NSLOT - 1) * SLOTB) ? 0 : sl_next + SLOTB; } while (0)
  WAIT_BAR(3);
  { const lds_cptr kb = Kbase + hi * 1024 + r32 * 16;
#pragma unroll
    for (int d0 = 0; d0 < 4; ++d0) { const bf16x8 b0 = *(const LAS bf16x8*)(kb + d0 * 2048), b1 = *(const LAS bf16x8*)(kb + d0 * 2048 + 512); pA0 = MFMA32(b0, qr[d0], pA0); pA1 = MFMA32(b1, qr[d0], pA1); } }
  asm volatile("s_nop 15\n\ts_nop 7" : "+v"(pA0), "+v"(pA1));
  { const float rm = rowmax(pA0, pA1); mhat = fadd_s(mhat, rm);
#pragma unroll
    for (int r = 0; r < 16; ++r) { pA0[r] = fsub_s(pA0[r], rm); pA1[r] = fsub_s(pA1[r], rm); }
    msel = selneg - mhat;
#pragma unroll
    for (int r = 0; r < 16; ++r) pA0[r] = __builtin_amdgcn_exp2f(pA0[r]);
#pragma unroll
    for (int r = 0; r < 16; ++r) pA1[r] = __builtin_amdgcn_exp2f(pA1[r]); }
  { const lds_cptr p = TBP(1); BLD(pB0, s0123, p, 0); BLD(pB0, s4567, p, 32); BLD(pB0, s89ab, p, 64); BLD(pB0, scdef, p, 96); BLD(pB1, s0123, p, 128); BLD(pB1, s4567, p, 160); BLD(pB1, s89ab, p, 192); BLD(pB1, scdef, p, 224); }
  WAIT_BAR(0);
  DMA_K(3, 0); DMA_V(1, SLOTB);
  ROT();
  kload8(kf, kp0 + sl_cur);
  WAIT_BAR(2);
  s16x4 vlo[8], vhi[8]; u32x4 pw0, pw1, pw2, pw3;
#define PKW(P, B) cvtpk_s(P[B], P[B + 1])
#define PAF(k) __builtin_bit_cast(bf16x8, pw##k)
#define VFR(i) (bf16x8){vlo[i][0], vlo[i][1], vlo[i][2], vlo[i][3], vhi[i][0], vhi[i][1], vhi[i][2], vhi[i][3]}
#define PIN(x) asm volatile("" : "+v"(x))
#define MX3(a, b, c) __builtin_fmaxf(__builtin_fmaxf((a), (b)), (c))
#define GAPA(MF, A0, A1, A2, A3, W0, W1, PW) do { MF; sacc += A0; sacc += A1; sacc += A2; sacc += A3; PIN(sacc); W0; W1; PIN(PW); SBAR(); } while (0)
#define EX(v) __builtin_amdgcn_exp2f(v)
#define GAPB(MF, X, B, BR) do { MF; X[B] = EX(X[B]); X[B + 1] = EX(X[B + 1]); X[B + 2] = EX(X[B + 2]); X[B + 3] = EX(X[B + 3]); PIN(X); BR; SBAR(); } while (0)
#define VRD(i) do { vlo[i] = vtr(vp_ + (((i) >> 2) * 4096 + ((i) & 3) * 1024)); vhi[i] = vtr(vp_ + (((i) >> 2) * 4096 + ((i) & 3) * 1024 + 512)); } while (0)
#define KRD(G, j) do { if (G) { kload2(kf, kp0 + sl_next, j); SBAR(); } } while (0)
#define NB(X, sw, off) BLD(X, sw, tbn_, off)
#define STEP(C0, C1, P0, P1, t, GK, GV, GL, BS) do { SBAR(); \
    const bool tab_ = ((t) < 20); \
    if (BS) { if ((((t)) & 3) == 0) BLOCKSEL(t, tab_); } \
    PIN(C0); PIN(C1); \
    if (tab_) { _Pragma("unroll") for (int r = 0; r < 16; ++r) { C0[r] += msel; C1[r] += msel; } } \
    else { _Pragma("unroll") for (int r = 0; r < 16; ++r) { C0[r] = msel; C1[r] = msel; } } \
    PIN(C0); PIN(C1); \
    const lds_cptr vp_ = vp0 + sl_prev; const lds_cptr tbn_ = TBP((t) + 1); \
    VRD(0); SBAR(); float sacc = (P0[0] + P0[1]); \
    GAPA(C0 = MFMA32(kf[0], qr[0], C0), P0[2], P0[3], P0[4], P0[5],     pw0[0] = PKW(P0, 0), pw0[1] = PKW(P0, 2), pw0); \
    VRD(4); SBAR(); GAPA(C1 = MFMA32(kf[1], qr[0], C1), P0[6], P0[7], P0[8], P0[9],     pw0[2] = PKW(P0, 4), pw0[3] = PKW(P0, 6), pw0); \
    VRD(1); SBAR(); GAPA(C0 = MFMA32(kf[2], qr[1], C0),   P0[10], P0[11], P0[12], P0[13], pw1[0] = PKW(P0, 8), pw1[1] = PKW(P0, 10), pw1); \
    VRD(5); SBAR(); GAPA(C1 = MFMA32(kf[3], qr[1], C1),   P0[14], P0[15], P1[0], P1[1],   pw1[2] = PKW(P0, 12), pw1[3] = PKW(P0, 14), pw1); \
    VRD(2); SBAR(); GAPA(C0 = MFMA32(kf[4], qr[2], C0),   P1[2], P1[3], P1[4], P1[5],     pw2[0] = PKW(P1, 0), pw2[1] = PKW(P1, 2), pw2); \
    VRD(6); SBAR(); GAPA(C1 = MFMA32(kf[5], qr[2], C1),   P1[6], P1[7], P1[8], P1[9],     pw2[2] = PKW(P1, 4), pw2[3] = PKW(P1, 6), pw2); \
    VRD(3); SBAR(); GAPA(C0 = MFMA32(kf[6], qr[3], C0),   P1[10], P1[11], P1[12], P1[13], pw3[0] = PKW(P1, 8), pw3[1] = PKW(P1, 10), pw3); \
    VRD(7); SBAR(); GAPA(C1 = MFMA32(kf[7], qr[3], C1),   P1[14], P1[15], 0.f, 0.f,       pw3[2] = PKW(P1, 12), pw3[3] = PKW(P1, 14), pw3); \
    l_reg += sacc; \
    if (GK) { DMA_K((t) + 3, sl_cur); } if (GV) { DMA_V((t) + 1, sl_next); } \
    { float a = MX3(C0[0], C0[1], C1[0]), b = MX3(C0[2], C0[3], C1[1]); a = MX3(a, C1[2], C1[3]); \
      _Pragma("unroll") for (int r = 4; r < 16; r += 4) { a = MX3(a, C0[r], C0[r + 1]); b = MX3(b, C0[r + 2], C0[r + 3]); a = MX3(a, C1[r], C1[r + 1]); b = MX3(b, C1[r + 2], C1[r + 3]); } \
      float rm = __builtin_fmaxf(a, b); { auto rr = __builtin_amdgcn_permlane32_swap(__float_as_uint(rm), __float_as_uint(rm), false, false); rm = __builtin_fmaxf(__uint_as_float(rr[0]), __uint_as_float(rr[1])); } \
      resc = false; \
      if (__builtin_expect(__any(rm > (float)THRL), 0)) { const float dl = __builtin_fmaxf(rm, 0.f); mhat += dl; \
        _Pragma("unroll") for (int r = 0; r < 16; ++r) { C0[r] -= dl; C1[r] -= dl; } \
        msel -= dl; \
        const float f = __builtin_amdgcn_exp2f(-dl); l_reg *= f; if (hi == 0) wsf[r32] = f; resc = true; } } \
    SBAR(); \
    GAPB(o[0] = MFMA32(PAF(0), VFR(0), o[0]), C0, 0, NB(P0, s0123, 0)); \
    GAPB(o[1] = MFMA32(PAF(0), VFR(4), o[1]), C0, 4, NB(P0, s4567, 32)); \
    KRD(GL, 0); GAPB(o[0] = MFMA32(PAF(1), VFR(1), o[0]), C0, 8, NB(P0, s89ab, 64)); \
    KRD(GL, 1); GAPB(o[1] = MFMA32(PAF(1), VFR(5), o[1]), C0, 12, NB(P0, scdef, 96)); \
    KRD(GL, 2); GAPB(o[0] = MFMA32(PAF(2), VFR(2), o[0]), C1, 0, NB(P1, s0123, 128)); \
    KRD(GL, 3); GAPB(o[1] = MFMA32(PAF(2), VFR(6), o[1]), C1, 4, NB(P1, s4567, 160)); \
    GAPB(o[0] = MFMA32(PAF(3), VFR(3), o[0]), C1, 8, NB(P1, s89ab, 192)); \
    GAPB(o[1] = MFMA32(PAF(3), VFR(7), o[1]), C1, 12, NB(P1, scdef, 224)); \
    } while (0)
#define ENDW(tt) do { if ((tt) + 3 < NT) { WAIT_BAR(2); } else if ((tt) + 2 < NT) { WAIT_BAR(1); } else { WAIT_BAR(0); } } while (0)
  int t = 1;
  for (; t + 5 < NT; t += 2) {
    STEP(pB0, pB1, pA0, pA1, t, true, true, true, 0);     WAIT_BAR(2); RESC(); ROT();
    STEP(pA0, pA1, pB0, pB1, t + 1, true, true, true, 1); WAIT_BAR(2); RESC(); ROT(); }
  for (; t + 1 < NT; t += 2) {
    STEP(pB0, pB1, pA0, pA1, t, (t + 3 < NT), (t + 1 < NT), (t + 1 < NT), 0);     ENDW(t);     RESC(); ROT();
    STEP(pA0, pA1, pB0, pB1, t + 1, (t + 4 < NT), (t + 2 < NT), (t + 2 < NT), 1); ENDW(t + 1); RESC(); ROT(); }
  STEP(pB0, pB1, pA0, pA1, NT - 1, false, false, false, 0); RESC();
  { float sacc = pB0[0] + pB0[1];
#pragma unroll
    for (int r = 2; r < 16; ++r) sacc += pB0[r];
#pragma unroll
    for (int r = 0; r < 16; ++r) sacc += pB1[r];
    l_reg += sacc;
    pw0 = (u32x4){PKW(pB0, 0), PKW(pB0, 2), PKW(pB0, 4), PKW(pB0, 6)}; pw1 = (u32x4){PKW(pB0, 8), PKW(pB0, 10), PKW(pB0, 12), PKW(pB0, 14)}; pw2 = (u32x4){PKW(pB1, 0), PKW(pB1, 2), PKW(pB1, 4), PKW(pB1, 6)}; pw3 = (u32x4){PKW(pB1, 8), PKW(pB1, 10), PKW(pB1, 12), PKW(pB1, 14)};
    SBAR(); pv(o, vb0 + sl_cur, PAF(0), PAF(1), PAF(2), PAF(3)); }
  { auto rr = __builtin_amdgcn_permlane32_swap(__float_as_uint(l_reg), __float_as_uint(l_reg), false, false); l_reg = __uint_as_float(rr[0]) + __uint_as_float(rr[1]); }
  if (hi == 0) wsf[32 + r32] = l_reg; asm volatile("s_waitcnt lgkmcnt(0)" ::: "memory");
  float rli[16];
#pragma unroll
  for (int r = 0; r < 16; ++r) rli[r] = __builtin_amdgcn_rcpf(wsf[32 + crow(r, hi)]);
  bf16_t* Ow = O + (rowbase + q0 + wid * QBLK) * DMP + h * ADH;
  { LAS bf16_t* stg = (LAS bf16_t*)(shm + LDS_OST) + wid * 2048;
#pragma unroll
    for (int r = 0; r < 16; ++r) { const int orow = crow(r, hi);
#pragma unroll
      for (int d0 = 0; d0 < 2; ++d0) stg[orow * 64 + d0 * 32 + r32] = (bf16_t)(cvtpk_s(o[d0][r] * rli[r], 0.f) & 0xffffu); }
    asm volatile("s_waitcnt lgkmcnt(0)" ::: "memory");
#pragma unroll
    for (int i = 0; i < 4; ++i) { const int row = i * 8 + (lane >> 3), ch = lane & 7; const u32x4 v = *(const LAS u32x4*)(stg + row * 64 + ch * 8); *(u32x4*)(Ow + (long)row * DMP + ch * 8) = v; } }
  asm volatile("s_waitcnt lgkmcnt(0)\n\ts_barrier" ::: "memory");
#undef PT
#undef DMA_K
#undef DMA_V
#undef TBP
#undef BLD
#undef BLOCKSEL
#undef RESC
#undef ROT
#undef PKW
#undef PAF
#undef VFR
#undef PIN
#undef MX3
#undef GAPA
#undef EX
#undef GAPB
#undef VRD
#undef KRD
#undef NB
#undef STEP
#undef ENDW
}
#undef SBAR
#undef WAIT_BAR
}

__device__ __forceinline__ void moba_tables(const Frame& F, int bh, const float* rel_bias) {
    const int h = bh & 7;
    LAS float* TB = (LAS float*)(F.lds + attn::LDS_TB); LAS float* KM = (LAS float*)(F.lds + attn::LDS_KM);
    for (int i = F.tid; i < 4 * attn::TB_N; i += 512) { const int a = i / attn::TB_N, k = i - a * attn::TB_N; const int d = 1279 - (k + a); float v;
        if (d < 0) v = -INFINITY;
        else { int bk; if (d < 16) bk = d; else bk = 16 + (d >= 21) + (d >= 27) + (d >= 35) + (d >= 46) + (d >= 59) + (d >= 77) + (d >= 99) + (d >= 128) + (d >= 166) + (d >= 216) + (d >= 280) + (d >= 363) + (d >= 470) + (d >= 609) + (d >= 790);
            v = rel_bias[bk * 8 + h] * LOG2E; }
        TB[i] = v; }
    for (int i = F.tid; i < 1024; i += 512) KM[i] = ((const float*)(F.ws + WS_KMEAN))[(size_t)bh * 1024 + i];
    __syncthreads();
}

__global__ void __launch_bounds__(512, 2) hybrid_fwd(Args args) {
    extern __shared__ __attribute__((aligned(16))) unsigned char lds[];
    Frame F;
    F.lds = (LAS unsigned char*)lds; F.ws = AWS();
    F.wave = __builtin_amdgcn_readfirstlane((int)threadIdx.x >> 6); F.lane = fresh_lane(); F.tid = F.wave * 64 + F.lane;
    F.G = gridDim.x; { const int bx = blockIdx.x; F.vcu = (F.G % 8 == 0) ? (bx % 8) * (F.G / 8) + bx / 8 : bx; }
    volatile LAS unsigned* MISC = (volatile LAS unsigned*)(F.lds + MISC_OFF);
    if (F.tid < 64) MISC[F.tid] = 0u;
    __syncthreads();
    XcdBarrier bar = xcd_barrier_post(((unsigned*)F.ws + CW_BAR), MISC + 8, F.tid);
#define RELOAD() do { int l_ = fresh_lane(); int w_ = F.wave; asm volatile("" : "+s"(w_)); F.wave = w_; F.lane = l_; F.tid = w_ * 64 + l_; \
        int g_ = gridDim.x, b_ = blockIdx.x; asm volatile("" : "+s"(g_), "+s"(b_)); F.G = g_; F.vcu = (g_ % 8 == 0) ? (b_ % 8) * (g_ / 8) + b_ / 8 : b_; F.ws = AWS(); ws = F.ws; G = g_; bx = b_; } while (0)
#define GRID_BAR() do { xcd_barrier(bar, F.tid); RELOAD(); } while (0)
    unsigned char* ws = F.ws;
    int G = F.G, bx = (int)blockIdx.x;

    p0_convert(F);
    __syncthreads();

#pragma unroll 1
    for (int layer = 0; layer < 2; ++layer) {
        RELOAD();
        float* X = AOUT(); const float* xin = (layer == 0) ? AIN(0) : X;
        norm_pass<0>(F, xin, AIN(2) + layer * DM, AIN(3) + (size_t)layer * DM * INW + 2048, INW, AIN(6) + layer * 4, AIN(7) + layer * 4);
        GRID_BAR();
        { pg8::StaticOrder S; S.init(ws + WS_XN, ws + WS_WIN + (size_t)layer * NIN * DM * 2, MTOK, NIN, DM, G, bx);
          pg8::EpiIn E{ws}; pg8::gemm_phase<pg8::EpiIn, pg8::StaticOrder, true>(F.lds, DM, S, E, F.wave); }
        GRID_BAR();
#if !defined(NO_MIX)
        for (int it = F.vcu; it < 1024; it += G) moba_prep_item(F, it, AIN(9) + layer * 64, AIN(10) + layer * 64);
        for (int u = F.vcu; u < 1024; u += G) mlstm_local(F, u, AIN(4) + layer * 4096, AIN(5) + layer * 1024);
        GRID_BAR();
        for (int it = F.vcu; it < 256; it += G) mlstm_scan(F, it >> 3, it & 7);
        GRID_BAR();
        for (int u = F.vcu; u < 1024; u += G) mlstm_out(F, u, AIN(4) + layer * 4096, AIN(5) + layer * 1024, AIN(8) + layer * 512);
        for (int v = F.vcu; v < 256; v += G) { const int bh = v >> 2, s = v & 3;
            moba_tables(F, bh, AIN(1));
            const float b31 = AIN(1)[31 * 8 + (bh & 7)] * LOG2E;
#pragma unroll 1
            for (int i = 0; i < 4; ++i) { const int qb = (i == 0) ? s : (i == 1) ? 7 - s : (i == 2) ? 8 + s : 15 - s;
                Frame f = unit_frame(F);
                attn::attn_unit<8>(bh >> 3, bh & 7, qb, (const bf16_t*)(f.ws + WS_AQ), (const bf16_t*)(f.ws + WS_AK), (const bf16_t*)(f.ws + WS_AV), (bf16_t*)(f.ws + WS_AQ), f.lds, f.wave, f.lane, b31); }
            __syncthreads(); }
        GRID_BAR();
#endif
        { pg8::StaticOrder S; S.init(ws + WS_MO, ws + WS_WA + (size_t)layer * DM * 512 * 2, MTOK, DM, 512, G, bx);
          pg8::EpiBranch<0> E{(bf16_t*)(ws + WS_Y), (const bf16_t*)(ws + WS_GAB)}; pg8::gemm_phase<pg8::EpiBranch<0>, pg8::StaticOrder, true>(F.lds, 512, S, E, F.wave); }
        VM_WAIT();
        { pg8::StaticOrder S; S.init(ws + WS_AQ, ws + WS_WB + (size_t)layer * DM * 512 * 2, MTOK, DM, 512, G, bx);
          pg8::EpiBranch<1> E{(bf16_t*)(ws + WS_Y), (const bf16_t*)(ws + WS_GAB)}; pg8::gemm_phase<pg8::EpiBranch<1>, pg8::StaticOrder, true>(F.lds, 512, S, E, F.wave); }
        GRID_BAR();
        { pg8::StaticOrder S; S.init(ws + WS_Y, ws + WS_WOUT + (size_t)layer * DM * DM * 2, MTOK, DM, DM, G, bx);
          pg8::EpiResid E{xin, X}; pg8::gemm_phase<pg8::EpiResid, pg8::StaticOrder, true>(F.lds, DM, S, E, F.wave); }
        GRID_BAR();
        if (layer == 0) {
            norm_pass<1>(F, X, AIN(14), nullptr, 0, nullptr, nullptr);
            GRID_BAR();
            { pg8::StaticOrder S; S.init(ws + WS_XN, ws + WS_WGU, MTOK, 2 * DFF, DM, G, bx);
              pg8::EpiSwiGLU<false> E{(bf16_t*)(ws + WS_ACT), DFF}; pg8::gemm_phase<pg8::EpiSwiGLU<false>, pg8::StaticOrder, true>(F.lds, DM, S, E, F.wave); }
            GRID_BAR();
            { pg8::StaticOrder S; S.init(ws + WS_ACT, ws + WS_WD, MTOK, DM, DFF, G, bx);
              pg8::EpiResid E{X, X}; pg8::gemm_phase<pg8::EpiResid, pg8::StaticOrder, true>(F.lds, DFF, S, E, F.wave); }
            GRID_BAR();
        } else {
#if !defined(NO_MOE)
            norm_pass<2>(F, X, AIN(14) + DM, AIN(18), 8, nullptr, nullptr);
            p_convert_experts(F);
            GRID_BAR();
#pragma unroll 1
            for (int rk = 0; rk < 2; ++rk) {
                const int* idx = (const int*)(ws + WS_MIDX) + (size_t)rk * 8 * 32768; const float* wgt = (const float*)(ws + WS_MWGT) + (size_t)rk * 8 * 32768;
                const unsigned* cnt = (const unsigned*)(ws + WS_CTL) + CW_MOE + 64 * 8 * rk;
                { pg8::MoeOrder<true> S; S.init(ws + WS_XN, ws + WS_WGUE, DM, idx, cnt, EFF / 128, G, bx);
                  pg8::EpiSwiGLU<true> E{(bf16_t*)(ws + WS_EACT), EFF}; pg8::gemm_phase<pg8::EpiSwiGLU<true>, pg8::MoeOrder<true>, true>(F.lds, DM, S, E, F.wave); }
                GRID_BAR();
                { pg8::MoeOrder<false> S; S.init(ws + WS_EACT, ws + WS_WDE, EFF, idx, cnt, 4, G, bx);
                  pg8::EpiMoeDown E{X, idx, wgt, cnt}; pg8::gemm_phase<pg8::EpiMoeDown, pg8::MoeOrder<false>, true>(F.lds, EFF, S, E, F.wave); }
                if (rk == 0) GRID_BAR();
            }
#endif
        }
    }
}

extern "C" void kernel_launch(void* const* d_in, const int* in_sizes, int n_in, void* d_out, int out_size, void* d_ws, size_t ws_size, hipStream_t stream) {
    static int grid = 0;
    if (grid == 0) {
        if (n_in != 22 || out_size != MTOK * DM || ws_size < WS_END) { fprintf(stderr, "kernel_launch: unexpected shapes (n_in %d, out %d, ws %zu)\n", n_in, out_size, ws_size); grid = -1; return; }
        int dev = 0, cus = 0, per_cu = 0;
        if (hipGetDevice(&dev) != hipSuccess || hipDeviceGetAttribute(&cus, hipDeviceAttributeMultiprocessorCount, dev) != hipSuccess) { grid = -1; return; }
        if (hipFuncSetAttribute((const void*)hybrid_fwd, hipFuncAttributeMaxDynamicSharedMemorySize, LDS_BYTES) != hipSuccess) { fprintf(stderr, "kernel_launch: hipFuncSetAttribute failed\n"); grid = -1; return; }
        if (hipOccupancyMaxActiveBlocksPerMultiprocessor(&per_cu, (const void*)hybrid_fwd, 512, LDS_BYTES) != hipSuccess || per_cu < 1) fprintf(stderr, "kernel_launch: occupancy query reports %d\n", per_cu);
        (void)hipGetLastError();
        grid = cus;
    }
    if (grid < 0) return;
    if (hipMemsetAsync((char*)d_ws + WS_CTL, 0, CTL_ZERO_BYTES, stream) != hipSuccess) return;
    Args a{};
    for (int i = 0; i < 22; ++i) a.in[i] = (const float*)d_in[i];
    a.out = (float*)d_out; a.ws = (unsigned char*)d_ws;
    hipLaunchKernelGGL(hybrid_fwd, dim3(grid), dim3(512), LDS_BYTES, stream, a);
}
```

```cpp
#include <hip/hip_runtime.h>
#ifndef OUT8
#define OUT8 0
#endif
#ifndef DUP8
#define DUP8 1
#endif
#ifndef DDN8
#define DDN8 0
#endif
#ifndef AEPI_LD
#define AEPI_LD true
#endif
#ifndef IN8
#define IN8 2
#endif
#include <cstdio>
#include <cstdint>

#define LAS __attribute__((address_space(3)))
#define GAS __attribute__((address_space(1)))
typedef unsigned short bf16_t;
typedef short bf16x8 __attribute__((ext_vector_type(8)));
typedef short s16x4 __attribute__((ext_vector_type(4)));
typedef float f32x2 __attribute__((ext_vector_type(2)));
typedef float f32x4 __attribute__((ext_vector_type(4)));
typedef float f32x16 __attribute__((ext_vector_type(16)));
typedef unsigned u32x4 __attribute__((ext_vector_type(4)));
typedef unsigned u32x2 __attribute__((ext_vector_type(2)));
typedef GAS unsigned gu32;

constexpr int NBATCH = 8, SEQ = 4096, DM = 1024, MTOK = NBATCH * SEQ;
constexpr int INW = 5640, NIN = 5632;
constexpr int MH = 4, MDH = 128, MCH = 128, NCH = SEQ / MCH;
constexpr int AH = 8, ADH = 64, ABLK = 256, NAB = SEQ / ABLK;
constexpr int DFF = 2816, NEXP = 8, EFF = 3584;
constexpr float EPS = 1e-6f;
constexpr float LOG2E = 1.4426950408889634f;
constexpr float QSCALE = 0.125f * LOG2E;

constexpr size_t MiB = 1u << 20;
constexpr size_t WS_CTL = 0, CTL_ZERO_BYTES = 1 * MiB;
constexpr size_t WS_GATES = 1 * MiB;
constexpr size_t WS_KMEAN = 2 * MiB;
constexpr size_t WS_MSC = 2 * MiB + 512 * 1024;
constexpr size_t WS_UN = 3 * MiB;
constexpr size_t WS_NST = 3 * MiB + 512 * 1024;
constexpr size_t WS_MIDX = 4 * MiB;
constexpr size_t WS_MWGT = 6 * MiB;
constexpr size_t WS_WIN = 12 * MiB;
constexpr size_t WS_WA = 34 * MiB;
constexpr size_t WS_WB = 36 * MiB;
constexpr size_t WS_WOUT = 38 * MiB;
constexpr size_t WS_WGU = 42 * MiB;
constexpr size_t WS_WD = 53 * MiB;
constexpr size_t WS_XN = 60 * MiB;
constexpr size_t WS_MQK = 124 * MiB;
constexpr size_t WS_MV = 188 * MiB;
constexpr size_t WS_MO = 220 * MiB, WS_AQ = 252 * MiB, WS_AK = 284 * MiB, WS_AV = 316 * MiB;
constexpr size_t WS_GAB = 348 * MiB;
constexpr size_t WS_CST = 476 * MiB;
constexpr size_t WS_Y = 476 * MiB;
constexpr size_t WS_ACT = 124 * MiB;
constexpr size_t WS_XN8 = WS_XN;
constexpr size_t WS_XN8S = 92 * MiB;
constexpr size_t WS_WGUE = 160 * MiB;
constexpr size_t WS_WDE = 482 * MiB;
constexpr size_t WS_YP = 92 * MiB;
constexpr size_t WS_YP2 = 228 * MiB;
constexpr size_t WS_EACT = 244 * MiB;
constexpr size_t WS_XN8IN = 476 * MiB;
constexpr size_t WS_RINFO = 8 * MiB;
constexpr size_t XB_OFF = 64 * MiB;
constexpr size_t WS_X3A = 12 * MiB, WS_X3B = 510 * MiB;
constexpr int X3_SPLIT = 24576;
constexpr size_t WS_Y8 = WS_XN;
constexpr size_t WS_WOUT8 = 553 * MiB;
constexpr size_t WS_END = 555 * MiB;
constexpr int CW_BAR = 4096;
constexpr int CW_MOE = 8192;

constexpr int LDS_BYTES = 163840;
constexpr int LDS_UNITS = LDS_BYTES - 2560;
constexpr int MISC_OFF = LDS_BYTES - 256;

__device__ __forceinline__ unsigned cvt_pk_bf16(float lo, float hi) { unsigned r; asm volatile("v_cvt_pk_bf16_f32 %0, %1, %2" : "=v"(r) : "v"(lo), "v"(hi)); return r; }
__device__ __forceinline__ float clamp_e4m3(float x) { return __builtin_amdgcn_fmed3f(x, -448.0f, 448.0f); }
__device__ __forceinline__ unsigned cvt_pk4_fp8(float a, float b, float c, float d) { int w = __builtin_amdgcn_cvt_pk_fp8_f32(clamp_e4m3(a), clamp_e4m3(b), 0, false); w = __builtin_amdgcn_cvt_pk_fp8_f32(clamp_e4m3(c), clamp_e4m3(d), w, true); return (unsigned)w; }
__device__ __forceinline__ float bf_lo(unsigned w) { return __uint_as_float(w << 16); }
__device__ __forceinline__ float bf_hi(unsigned w) { return __uint_as_float(w & 0xffff0000u); }
__device__ __forceinline__ float bf2f(bf16_t b) { return __uint_as_float((unsigned)b << 16); }
__device__ __forceinline__ float sigmoidf_(float x) { return __builtin_amdgcn_rcpf(1.0f + __builtin_amdgcn_exp2f(-x * LOG2E)); }
__device__ __forceinline__ int fresh_lane() { unsigned m = ~0u; asm volatile("" : "+s"(m)); return (int)__builtin_amdgcn_mbcnt_hi(m, __builtin_amdgcn_mbcnt_lo(m, 0u)); }
__device__ __forceinline__ int crow(int r, int hi) { return (r & 3) + 8 * (r >> 2) + 4 * hi; }
#define LDS_WAIT() asm volatile("s_waitcnt lgkmcnt(0)" ::: "memory")
#define VM_WAIT() asm volatile("s_waitcnt vmcnt(0)" ::: "memory")

template <int CTRL> __device__ __forceinline__ float dppf(float v) { return __int_as_float(__builtin_amdgcn_update_dpp(0, __float_as_int(v), CTRL, 0xf, 0xf, true)); }
template <int O> __device__ __forceinline__ float shx_sum(float v);
namespace pg8 {
constexpr int BM = 256, BK = 64, HALF = 128, HTB = HALF * BK * 2, STAGE_BYTES = 8 * HTB, NXCD = 8, WGM = 8;
__host__ __device__ __forceinline__ int lds_byte(int r, int c) { const int st = (r >> 4) * 2 + (c >> 5), rr = r & 15, cc = c & 31, ob = rr * 64 + cc * 2; return st * 1024 + (ob ^ (((ob >> 9) & 1) << 5)); }
__host__ __device__ __forceinline__ void stage_rc(int b, int& R, int& C) { const int st = b / 1024, sb = b % 1024, swz = sb ^ (((sb >> 9) & 1) << 5); R = (st >> 1) * 16 + swz / 64; C = (st & 1) * 32 + (swz % 64) / 2; }
__host__ __device__ __forceinline__ int perm32(int rho) { const int n = rho >> 4, i = rho & 15; return 8 * (i >> 2) + 4 * n + (i & 3); }

struct Unit { int pm, pn, e, lp; };

struct StaticOrder {
    static constexpr bool GATHER = false;
    const char* A; const char* Bt; size_t tstep;
    int nM, nN, nwg, G, c; LAS int* tbl;
    __device__ __forceinline__ void init(const void* A_, const void* Bt_, int M, int N, int Kb, int G_, int c_, int tid, LAS unsigned char* ldsb) { A = (const char*)A_; Bt = (const char*)Bt_; tstep = (size_t)BM * Kb; nM = M / BM; nN = N / BM; nwg = nM * nN; G = G_; c = c_;
        tbl = (LAS int*)(ldsb + LDS_UNITS);
        if (tid < 64) { Unit u; u.pm = 0; u.pn = 0; u.e = 0; u.lp = 0; const bool ok = compute(tid, u); tbl[2 * tid] = ok ? u.pm : -1; tbl[2 * tid + 1] = u.pn; }
        __syncthreads();
    }
    __device__ __forceinline__ bool next(int i, Unit& u) const {
        if (i >= 64) return false;
        const int pm = __builtin_amdgcn_readfirstlane(tbl[2 * i]); if (pm < 0) return false;
        u.pm = pm; u.pn = __builtin_amdgcn_readfirstlane(tbl[2 * i + 1]); u.e = 0; u.lp = 0; return true;
    }
    __device__ __forceinline__ bool compute(int i, Unit& u) const {
        const long L = (long)i * G + c; if (L >= nwg) return false;
        int wgid = (int)L; { const int q = nwg / NXCD, r = nwg % NXCD, xcd = wgid % NXCD, off = wgid / NXCD; wgid = (xcd < r ? xcd * (q + 1) : r * (q + 1) + (xcd - r) * q) + off; }
        const int nig = WGM * nN, gid = wgid / nig, fm = gid * WGM, gsz = (nM - fm) < WGM ? (nM - fm) : WGM;
        u.pm = fm + ((wgid % nig) % gsz); u.pn = (wgid % nig) / gsz; u.e = 0; u.lp = 0; return true;
    }
    __device__ __forceinline__ const char* abase(const Unit& u) const { return A + (size_t)u.pm * tstep; }
    __device__ __forceinline__ const char* bbase(const Unit& u) const { return Bt + (size_t)u.pn * tstep; }
    __device__ __forceinline__ unsigned tok(const Unit&, int) const { return 0u; }
};

typedef int v8i32 __attribute__((ext_vector_type(8)));
template <class T, class = void> struct HasChain { static constexpr bool value = false; };
template <class T> struct HasChain<T, decltype((void)T::CHAIN, void())> { static constexpr bool value = true; };
template <class Epi, class Sched, bool ALIGN_EPI, bool F8 = false, int SCW = 127>
__device__ __forceinline__ void gemm_phase(LAS unsigned char* lds, const int Kb, const Sched& S, const Epi& E, const int wave_id, const int nt_ov = 0) {
    const int lane_ = fresh_lane();
    const int wid = __builtin_amdgcn_readfirstlane(wave_id), lane = lane_, tid = wid * 64 + lane, wr = wid >> 2, wc = wid & 3, fr = lane & 15, fq = lane >> 4;
    const int nt = nt_ov ? nt_ov : Kb / 128;
    unsigned voffB[2]; int RA[2], CA[2];
#pragma unroll
    for (int i = 0; i < 2; ++i) { int R, C; stage_rc(tid * 16 + i * 8192, R, C); RA[i] = R; CA[i] = C; const int Rb = Epi::PERM ? ((R & ~31) + perm32(R & 31)) : R; voffB[i] = (unsigned)(Rb * Kb + C * 2); }
    const size_t kstep = (size_t)(BK * 2);
    const size_t hstep = (size_t)HALF * Kb;
    const size_t hstepA = Sched::GATHER ? (size_t)0 : hstep;
    const unsigned ldsw = (unsigned)wid * 1024u;
    const int aoff = lds_byte(wr * 64 + fr, fq * 8), boff = lds_byte(wc * 32 + fr, fq * 8);
#define PG8_SA(b, h) (((b) * 2 + (h)) * HTB)
#define PG8_SB(b, h) ((4 + (b) * 2 + (h)) * HTB)
#define PG8_STAGE(bufoff, gbase, voff) do { _Pragma("unroll") for (int _i = 0; _i < 2; ++_i) \
        __builtin_amdgcn_global_load_lds((const unsigned*)((const char*)(gbase) + (voff)[_i]), (LAS unsigned*)(lds + (bufoff) + ldsw + _i * 8192), 16, 0, 0); } while (0)
#define PG8_LDA(dst, b, h) do { _Pragma("unroll") for (int m = 0; m < 4; ++m) _Pragma("unroll") for (int k = 0; k < 2; ++k) dst[m][k] = *(const LAS bf16x8*)(lds + PG8_SA(b, h) + aoff + m * 2048 + k * 1024); } while (0)
#define PG8_LDB(dst, b, h) do { _Pragma("unroll") for (int n = 0; n < 2; ++n) _Pragma("unroll") for (int k = 0; k < 2; ++k) dst[n][k] = *(const LAS bf16x8*)(lds + PG8_SB(b, h) + boff + n * 2048 + k * 1024); } while (0)
#define PG8_F8CAT(x) __builtin_bit_cast(v8i32, __builtin_shufflevector(x[0], x[1], 0, 1, 2, 3, 4, 5, 6, 7, 8, 9, 10, 11, 12, 13, 14, 15))
#define PG8_MMA(ai, bj, At, Bt) do { __builtin_amdgcn_s_setprio(1); _Pragma("unroll") for (int m = 0; m < 4; ++m) _Pragma("unroll") for (int n = 0; n < 2; ++n) { \
        if constexpr (F8) { asm volatile("v_mfma_f32_16x16x128_f8f6f4 %0, %1, %2, %0" : "+v"(acc[ai][bj][m][n]) : "v"(PG8_F8CAT(Bt[n])), "v"(PG8_F8CAT(At[m]))); } \
        else { _Pragma("unroll") for (int k = 0; k < 2; ++k) acc[ai][bj][m][n] = __builtin_amdgcn_mfma_f32_16x16x32_bf16(Bt[n][k], At[m][k], acc[ai][bj][m][n], 0, 0, 0); } } __builtin_amdgcn_s_setprio(0); } while (0)
#define PG8_WAIT_V(n) asm volatile("s_waitcnt vmcnt(" #n ")" ::: "memory")
#define PG8_WAIT_L(n) asm volatile("s_waitcnt lgkmcnt(" #n ")" ::: "memory")
#define PG8_BAR __builtin_amdgcn_s_barrier()
#define PG8_SCHED __builtin_amdgcn_sched_barrier(0)
#define PG8_SETV(v, u) do { _Pragma("unroll") for (int _h = 0; _h < 2; ++_h) _Pragma("unroll") for (int _i = 0; _i < 2; ++_i) \
        v[_h][_i] = Sched::GATHER ? (S.tok(u, _h * HALF + RA[_i]) * (unsigned)Kb + (unsigned)CA[_i] * 2u) : (unsigned)(RA[_i] * Kb + CA[_i] * 2); } while (0)
    Unit cur, nxt; int ui = 0;
    if (!S.next(0, cur)) return;
    f32x4 acc[2][2][4][2];
#pragma unroll
    for (int a = 0; a < 2; ++a)
#pragma unroll
        for (int b = 0; b < 2; ++b)
#pragma unroll
            for (int m = 0; m < 4; ++m)
#pragma unroll
                for (int n = 0; n < 2; ++n) acc[a][b][m][n] = (f32x4){0.f, 0.f, 0.f, 0.f};
    bf16x8 At[4][2], B0[2][2], B1[2][2];
    unsigned cvA[2][2], nvA[2][2];
    PG8_SETV(cvA, cur);
    const char* cA = S.abase(cur); const char* cB = S.bbase(cur);
    PG8_STAGE(PG8_SB(0, 0), cB, voffB); PG8_STAGE(PG8_SB(0, 1), cB + hstep, voffB); PG8_STAGE(PG8_SA(0, 0), cA, cvA[0]); PG8_STAGE(PG8_SA(0, 1), cA + hstepA, cvA[1]);
    if (wr == 1) PG8_BAR;
    PG8_WAIT_V(2); PG8_BAR;
    PG8_STAGE(PG8_SB(1, 0), cB + kstep, voffB); PG8_STAGE(PG8_SA(1, 0), cA + kstep, cvA[0]); PG8_STAGE(PG8_SB(1, 1), cB + hstep + kstep, voffB);
    PG8_WAIT_V(6); PG8_BAR;
#if defined(PROBE_A)
    volatile LAS unsigned* pm_ = (volatile LAS unsigned*)(lds + (LDS_BYTES - 256));
    const bool pw_ = (blockIdx.x == 0 && tid == 0);
#define PTICK(slot) do { if (pw_) { const unsigned now_ = (unsigned)__builtin_amdgcn_s_memrealtime(); pm_[34 + (slot)] += now_ - pm_[31]; pm_[31] = now_; } } while (0)
    if (pw_) pm_[31] = (unsigned)__builtin_amdgcn_s_memrealtime();
#else
#define PTICK(slot) do { } while (0)
#endif
    for (;;) {
        PTICK(22);
        const bool has_next = S.next(ui + 1, nxt);
        const char* nA = has_next ? S.abase(nxt) : cA; const char* nB = has_next ? S.bbase(nxt) : cB;
        if constexpr (Sched::GATHER) {
            if (has_next) { PG8_SETV(nvA, nxt); }
            else {
#pragma unroll
                for (int h = 0; h < 2; ++h)
#pragma unroll
                    for (int i = 0; i < 2; ++i) nvA[h][i] = cvA[h][i];
            }
            asm volatile("" : "+v"(nvA[0][0]), "+v"(nvA[0][1]), "+v"(nvA[1][0]), "+v"(nvA[1][1]));
        }
        PTICK(20);
#pragma unroll 1
        for (int t = 0; t < nt; t += 2) {
            const bool last = (t == nt - 2);
            const char* a1 = cA + (size_t)(t + 1) * kstep;
            const char* a2 = last ? nA : cA + (size_t)(t + 2) * kstep; const char* b2 = last ? nB : cB + (size_t)(t + 2) * kstep;
            const char* a3 = a2 + kstep; const char* b3 = b2 + kstep;
            unsigned v0[2], v1[2];
#pragma unroll
            for (int i = 0; i < 2; ++i) { if constexpr (Sched::GATHER) { v0[i] = last ? nvA[0][i] : cvA[0][i]; v1[i] = last ? nvA[1][i] : cvA[1][i]; } else { v0[i] = cvA[0][i]; v1[i] = cvA[1][i]; } }
            PG8_LDB(B0, 0, 0); PG8_LDB(B1, 0, 1); PG8_SCHED; PG8_LDA(At, 0, 0); PG8_STAGE(PG8_SA(1, 1), a1 + hstepA, cvA[1]);
            PG8_WAIT_V(8); PG8_WAIT_L(0); PG8_BAR; PG8_MMA(0, 0, At, B0); PG8_MMA(0, 1, At, B1); PG8_BAR; PG8_SCHED;
            PG8_LDA(At, 0, 1); PG8_STAGE(PG8_SB(0, 0), b2, voffB); PG8_STAGE(PG8_SB(0, 1), b2 + hstep, voffB); PG8_STAGE(PG8_SA(0, 0), a2, v0);
            PG8_WAIT_V(8); PG8_WAIT_L(0); PG8_BAR; PG8_MMA(1, 0, At, B0); PG8_MMA(1, 1, At, B1); PG8_BAR; PG8_SCHED;
            PG8_LDB(B0, 1, 0); PG8_LDB(B1, 1, 1); PG8_SCHED; PG8_LDA(At, 1, 0); PG8_STAGE(PG8_SA(0, 1), a2 + hstepA, v1);
            PG8_WAIT_V(8); PG8_WAIT_L(0); PG8_BAR; PG8_MMA(0, 0, At, B0); PG8_MMA(0, 1, At, B1); PG8_BAR; PG8_SCHED;
            PG8_LDA(At, 1, 1); PG8_STAGE(PG8_SB(1, 0), b3, voffB); PG8_STAGE(PG8_SB(1, 1), b3 + hstep, voffB); PG8_STAGE(PG8_SA(1, 0), a3, v0);
            PG8_WAIT_V(8); PG8_WAIT_L(0); PG8_BAR; PG8_MMA(1, 0, At, B0); PG8_MMA(1, 1, At, B1); PG8_BAR; PG8_SCHED;
        }
        PTICK(21);
        if constexpr (ALIGN_EPI) { if (wr == 0) PG8_BAR; }
        bool keep = false;
        if constexpr (HasChain<Epi>::value) { E.chain(acc, cur, wr, wc, fr, fq); keep = (cur.e == 0); } else E(acc, cur, wr, wc, fr, fq);
        if (!has_next) break;
        if (!keep) {
#pragma unroll
        for (int a = 0; a < 2; ++a)
#pragma unroll
            for (int b = 0; b < 2; ++b)
#pragma unroll
                for (int m = 0; m < 4; ++m)
#pragma unroll
                    for (int n = 0; n < 2; ++n) acc[a][b][m][n] = (f32x4){0.f, 0.f, 0.f, 0.f};
        }
        cur = nxt; cA = nA; cB = nB; ++ui;
#pragma unroll
        for (int h = 0; h < 2; ++h)
#pragma unroll
            for (int i = 0; i < 2; ++i) cvA[h][i] = nvA[h][i];
        if constexpr (ALIGN_EPI) { if (wr == 1) PG8_BAR; }
    }
    PG8_WAIT_V(0);
    if constexpr (!ALIGN_EPI) { if (wr == 0) PG8_BAR; }
    PG8_BAR;
#undef PG8_SA
#undef PG8_SB
#undef PG8_STAGE
#undef PG8_LDA
#undef PG8_LDB
#undef PG8_MMA
#undef PG8_F8CAT
#undef PG8_WAIT_V
#undef PG8_WAIT_L
#undef PG8_BAR
#undef PG8_SCHED
#undef PG8_SETV
#undef PTICK
}

struct EpiIn {
    static constexpr bool PERM = true;
    unsigned char* ws; float sc; int pn0; const float* qg; const float* kg;
    __device__ __forceinline__ void qk_tile(const f32x4 (&acc)[2][2][4][2], const Unit& u, int pn, int wr, int wc, int fr, int fq) const {
        const bool isq = pn < 10; const int head = 4 * (pn & 1) + wc;
        bf16_t* base = (bf16_t*)(ws + (isq ? WS_AQ : WS_AK)); const float* gp = (isq ? qg : kg);
        f32x4 g[2][2], ks[2][2];
#pragma unroll
        for (int bj = 0; bj < 2; ++bj)
#pragma unroll
            for (int n = 0; n < 2; ++n) { g[bj][n] = *(const f32x4*)(gp + 32 * bj + 8 * fq + 4 * n) * (isq ? QSCALE : 1.0f); ks[bj][n] = (f32x4){0.f, 0.f, 0.f, 0.f}; }
#pragma unroll
        for (int ai = 0; ai < 2; ++ai)
#pragma unroll
            for (int m = 0; m < 4; ++m) { f32x4 v[2][2]; float ss = 0.f;
#pragma unroll
                for (int bj = 0; bj < 2; ++bj)
#pragma unroll
                    for (int n = 0; n < 2; ++n) { v[bj][n] = acc[ai][bj][m][n] * sc; ss += (v[bj][n].x * v[bj][n].x + v[bj][n].y * v[bj][n].y) + (v[bj][n].z * v[bj][n].z + v[bj][n].w * v[bj][n].w); }
                ss = shx_sum<16>(ss); ss = shx_sum<32>(ss);
                const float r = 1.0f / sqrtf(ss * (1.f / 64.f) + EPS);
                bf16_t* rowp = base + (size_t)(u.pm * BM + ai * HALF + wr * 64 + m * 16 + fr) * 512 + 64 * head + 8 * fq;
#pragma unroll
                for (int bj = 0; bj < 2; ++bj) { const f32x4 y0 = v[bj][0] * r * g[bj][0], y1 = v[bj][1] * r * g[bj][1]; ks[bj][0] += y0; ks[bj][1] += y1;
                    u32x4 w; w.x = cvt_pk_bf16(y0[0], y0[1]); w.y = cvt_pk_bf16(y0[2], y0[3]); w.z = cvt_pk_bf16(y1[0], y1[1]); w.w = cvt_pk_bf16(y1[2], y1[3]);
                    *(u32x4*)(rowp + 32 * bj) = w; } }
        if (!isq) {
#pragma unroll
            for (int bj = 0; bj < 2; ++bj)
#pragma unroll
                for (int n = 0; n < 2; ++n)
#pragma unroll
                    for (int j = 0; j < 4; ++j) { float t = ks[bj][n][j]; t += dppf<0xB1>(t); t += dppf<0x4E>(t); t += dppf<0x141>(t); t += dppf<0x140>(t); ks[bj][n][j] = t; }
            if (fr == 0) { float* km = (float*)(ws + WS_KMEAN) + (size_t)wr * 65536 + ((size_t)((u.pm >> 4) * 8 + head) * 16 + (u.pm & 15)) * 64 + 8 * fq;
#pragma unroll
                for (int bj = 0; bj < 2; ++bj) { *(f32x4*)(km + 32 * bj) = ks[bj][0]; *(f32x4*)(km + 32 * bj + 4) = ks[bj][1]; } }
        }
    }
    __device__ __forceinline__ void operator()(const f32x4 (&acc)[2][2][4][2], const Unit& u, int wr, int wc, int fr, int fq) const {
        const int pn = u.pn + pn0; bf16_t* base; int ld, colt; bool sg;
        if (pn >= 8 && pn < 12) { qk_tile(acc, u, pn, wr, wc, fr, fq); return; }
        if (pn < 4) { base = (bf16_t*)(ws + WS_MQK); ld = 1024; colt = 256 * pn; sg = false; }
        else if (pn < 14) { const int q = (pn - 4) >> 1; base = (bf16_t*)(ws + WS_MV + (size_t)q * (32 * MiB)); ld = 512; colt = 256 * ((pn - 4) & 1); sg = (q == 1); }
        else { base = (bf16_t*)(ws + WS_GAB); ld = 2048; colt = 256 * (pn - 14); sg = true; }
        const int row0 = u.pm * BM + wr * 64 + fr, col0 = colt + wc * 32 + 8 * fq;
#pragma unroll
        for (int ai = 0; ai < 2; ++ai)
#pragma unroll
            for (int m = 0; m < 4; ++m) { bf16_t* rowp = base + (size_t)(row0 + ai * HALF + m * 16) * ld + col0;
#pragma unroll
                for (int bj = 0; bj < 2; ++bj) { f32x4 v0 = acc[ai][bj][m][0] * sc, v1 = acc[ai][bj][m][1] * sc;
                    if (sg) {
                        v0 = v0 * (-LOG2E); v1 = v1 * (-LOG2E);
#pragma unroll
                        for (int j = 0; j < 4; ++j) { v0[j] = __builtin_amdgcn_exp2f(v0[j]); v1[j] = __builtin_amdgcn_exp2f(v1[j]); }
                        v0 = v0 + 1.0f; v1 = v1 + 1.0f;
#pragma unroll
                        for (int j = 0; j < 4; ++j) { v0[j] = __builtin_amdgcn_rcpf(v0[j]); v1[j] = __builtin_amdgcn_rcpf(v1[j]); } }
                    u32x4 w; w.x = cvt_pk_bf16(v0[0], v0[1]); w.y = cvt_pk_bf16(v0[2], v0[3]); w.z = cvt_pk_bf16(v1[0], v1[1]); w.w = cvt_pk_bf16(v1[2], v1[3]);
                    *(u32x4*)(rowp + bj * HALF) = w; } }
    }
};
template <int BR> struct EpiBranch {
    static constexpr bool PERM = true;
    bf16_t* Y; const bf16_t* G; unsigned char* Y8;
    __device__ __forceinline__ void operator()(const f32x4 (&acc)[2][2][4][2], const Unit& u, int wr, int wc, int fr, int fq) const {
        const int row0 = u.pm * BM + wr * 64 + fr, col0 = u.pn * BM + wc * 32 + 8 * fq;
#pragma unroll
        for (int ai = 0; ai < 2; ++ai) {
            u32x4 g[4][2], yo[4][2];
#pragma unroll
            for (int m = 0; m < 4; ++m)
#pragma unroll
                for (int bj = 0; bj < 2; ++bj) { const size_t r = (size_t)(row0 + ai * HALF + m * 16); const int c = col0 + bj * HALF;
                    g[m][bj] = *(const u32x4*)(G + r * 2048 + BR * 1024 + c); if (BR == 1) yo[m][bj] = *(const u32x4*)(Y + r * 1024 + c); }
            __builtin_amdgcn_sched_barrier(0);
#pragma unroll
            for (int m = 0; m < 4; ++m)
#pragma unroll
                for (int bj = 0; bj < 2; ++bj) { const size_t r = (size_t)(row0 + ai * HALF + m * 16); const int c = col0 + bj * HALF; const u32x4 gg = g[m][bj];
                    f32x4 v0 = acc[ai][bj][m][0], v1 = acc[ai][bj][m][1];
                    v0[0] *= bf_lo(gg.x); v0[1] *= bf_hi(gg.x); v0[2] *= bf_lo(gg.y); v0[3] *= bf_hi(gg.y); v1[0] *= bf_lo(gg.z); v1[1] *= bf_hi(gg.z); v1[2] *= bf_lo(gg.w); v1[3] *= bf_hi(gg.w);
                    if (BR == 1) { const u32x4 y = yo[m][bj];
                        v0[0] += bf_lo(y.x); v0[1] += bf_hi(y.x); v0[2] += bf_lo(y.y); v0[3] += bf_hi(y.y); v1[0] += bf_lo(y.z); v1[1] += bf_hi(y.z); v1[2] += bf_lo(y.w); v1[3] += bf_hi(y.w); }
                    if (BR == 1 && OUT8 && Y8 != nullptr) { v0 = v0 * 16.0f; v1 = v1 * 16.0f; u32x2 w8; w8.x = cvt_pk4_fp8(v0[0], v0[1], v0[2], v0[3]); w8.y = cvt_pk4_fp8(v1[0], v1[1], v1[2], v1[3]); *(u32x2*)(Y8 + r * 1024 + c) = w8; }
                    else { u32x4 w; w.x = cvt_pk_bf16(v0[0], v0[1]); w.y = cvt_pk_bf16(v0[2], v0[3]); w.z = cvt_pk_bf16(v1[0], v1[1]); w.w = cvt_pk_bf16(v1[2], v1[3]);
                        *(u32x4*)(Y + r * 1024 + c) = w; } }
            __builtin_amdgcn_sched_barrier(0);
        }
    }
};
struct MergeOrder {
    static constexpr bool GATHER = false;
    StaticOrder so; const char* A1; const char* B1;
    __device__ __forceinline__ bool next(int i, Unit& u) const { const bool ok = so.next(i >> 1, u); u.e = i & 1; return ok; }
    __device__ __forceinline__ const char* abase(const Unit& u) const { return (u.e ? A1 : so.A) + (size_t)u.pm * so.tstep; }
    __device__ __forceinline__ const char* bbase(const Unit& u) const { return (u.e ? B1 : so.Bt) + (size_t)u.pn * so.tstep; }
    __device__ __forceinline__ unsigned tok(const Unit&, int) const { return 0u; }
};
struct EpiMerge {
    static constexpr bool PERM = true;
    static constexpr bool CHAIN = true;
    bf16_t* Y; const bf16_t* G; unsigned char* Y8;
    __device__ __forceinline__ void chain(f32x4 (&acc)[2][2][4][2], const Unit& u, int wr, int wc, int fr, int fq) const {
        const int row0 = u.pm * BM + wr * 64 + fr, col0 = u.pn * BM + wc * 32 + 8 * fq;
        if (u.e == 0) {
#pragma unroll
            for (int ai = 0; ai < 2; ++ai) {
                u32x4 ga[4][2], gb[4][2];
#pragma unroll
                for (int m = 0; m < 4; ++m)
#pragma unroll
                    for (int bj = 0; bj < 2; ++bj) { const size_t r = (size_t)(row0 + ai * HALF + m * 16); const int c = col0 + bj * HALF;
                        ga[m][bj] = *(const u32x4*)(G + r * 2048 + c); gb[m][bj] = *(const u32x4*)(G + r * 2048 + 1024 + c); }
                __builtin_amdgcn_sched_barrier(0);
#pragma unroll
                for (int m = 0; m < 4; ++m)
#pragma unroll
                    for (int bj = 0; bj < 2; ++bj) { const u32x4 a = ga[m][bj], b = gb[m][bj];
                        f32x4 q0, q1;
                        q0[0] = bf_lo(a.x) * __builtin_amdgcn_rcpf(bf_lo(b.x)); q0[1] = bf_hi(a.x) * __builtin_amdgcn_rcpf(bf_hi(b.x)); q0[2] = bf_lo(a.y) * __builtin_amdgcn_rcpf(bf_lo(b.y)); q0[3] = bf_hi(a.y) * __builtin_amdgcn_rcpf(bf_hi(b.y));
                        q1[0] = bf_lo(a.z) * __builtin_amdgcn_rcpf(bf_lo(b.z)); q1[1] = bf_hi(a.z) * __builtin_amdgcn_rcpf(bf_hi(b.z)); q1[2] = bf_lo(a.w) * __builtin_amdgcn_rcpf(bf_lo(b.w)); q1[3] = bf_hi(a.w) * __builtin_amdgcn_rcpf(bf_hi(b.w));
                        acc[ai][bj][m][0] = acc[ai][bj][m][0] * q0; acc[ai][bj][m][1] = acc[ai][bj][m][1] * q1; }
                __builtin_amdgcn_sched_barrier(0);
            }
        } else {
#pragma unroll
            for (int ai = 0; ai < 2; ++ai) {
                u32x4 gb[4][2];
#pragma unroll
                for (int m = 0; m < 4; ++m)
#pragma unroll
                    for (int bj = 0; bj < 2; ++bj) { const size_t r = (size_t)(row0 + ai * HALF + m * 16); const int c = col0 + bj * HALF; gb[m][bj] = *(const u32x4*)(G + r * 2048 + 1024 + c); }
                __builtin_amdgcn_sched_barrier(0);
#pragma unroll
                for (int m = 0; m < 4; ++m)
#pragma unroll
                    for (int bj = 0; bj < 2; ++bj) { const size_t r = (size_t)(row0 + ai * HALF + m * 16); const int c = col0 + bj * HALF; const u32x4 b = gb[m][bj];
                        f32x4 v0 = acc[ai][bj][m][0], v1 = acc[ai][bj][m][1];
                        v0[0] *= bf_lo(b.x); v0[1] *= bf_hi(b.x); v0[2] *= bf_lo(b.y); v0[3] *= bf_hi(b.y); v1[0] *= bf_lo(b.z); v1[1] *= bf_hi(b.z); v1[2] *= bf_lo(b.w); v1[3] *= bf_hi(b.w);
                        if (OUT8 && Y8 != nullptr) { v0 = v0 * 16.0f; v1 = v1 * 16.0f; u32x2 w8; w8.x = cvt_pk4_fp8(v0[0], v0[1], v0[2], v0[3]); w8.y = cvt_pk4_fp8(v1[0], v1[1], v1[2], v1[3]); *(u32x2*)(Y8 + r * 1024 + c) = w8; }
                        else { u32x4 w; w.x = cvt_pk_bf16(v0[0], v0[1]); w.y = cvt_pk_bf16(v0[2], v0[3]); w.z = cvt_pk_bf16(v1[0], v1[1]); w.w = cvt_pk_bf16(v1[2], v1[3]);
                            *(u32x4*)(Y + r * 1024 + c) = w; } }
                __builtin_amdgcn_sched_barrier(0);
            }
        }
    }
};
struct EpiResid {
    static constexpr bool PERM = true;
    const void* base; bf16_t* out; float sc; bool basebf;
    __device__ __forceinline__ void operator()(const f32x4 (&acc)[2][2][4][2], const Unit& u, int wr, int wc, int fr, int fq) const {
        const int row0 = u.pm * BM + wr * 64 + fr, col0 = u.pn * BM + wc * 32 + 8 * fq;
#pragma unroll
        for (int ai = 0; ai < 2; ++ai) {
            if (basebf) {
                u32x4 b[4][2];
#pragma unroll
                for (int m = 0; m < 4; ++m)
#pragma unroll
                    for (int bj = 0; bj < 2; ++bj) b[m][bj] = *(const u32x4*)((const bf16_t*)base + (size_t)(row0 + ai * HALF + m * 16) * 1024 + col0 + bj * HALF);
                __builtin_amdgcn_sched_barrier(0);
#pragma unroll
                for (int m = 0; m < 4; ++m)
#pragma unroll
                    for (int bj = 0; bj < 2; ++bj) { const u32x4 y = b[m][bj];
                        const f32x4 v0 = (f32x4){bf_lo(y.x), bf_hi(y.x), bf_lo(y.y), bf_hi(y.y)} + acc[ai][bj][m][0] * sc, v1 = (f32x4){bf_lo(y.z), bf_hi(y.z), bf_lo(y.w), bf_hi(y.w)} + acc[ai][bj][m][1] * sc;
                        u32x4 w; w.x = cvt_pk_bf16(v0[0], v0[1]); w.y = cvt_pk_bf16(v0[2], v0[3]); w.z = cvt_pk_bf16(v1[0], v1[1]); w.w = cvt_pk_bf16(v1[2], v1[3]);
                        *(u32x4*)(out + (size_t)(row0 + ai * HALF + m * 16) * 1024 + col0 + bj * HALF) = w; }
            } else {
                f32x4 b[4][2][2];
#pragma unroll
                for (int m = 0; m < 4; ++m)
#pragma unroll
                    for (int bj = 0; bj < 2; ++bj)
#pragma unroll
                        for (int n = 0; n < 2; ++n) b[m][bj][n] = *(const f32x4*)((const float*)base + (size_t)(row0 + ai * HALF + m * 16) * 1024 + col0 + bj * HALF + 4 * n);
                __builtin_amdgcn_sched_barrier(0);
#pragma unroll
                for (int m = 0; m < 4; ++m)
#pragma unroll
                    for (int bj = 0; bj < 2; ++bj) { const f32x4 v0 = b[m][bj][0] + acc[ai][bj][m][0] * sc, v1 = b[m][bj][1] + acc[ai][bj][m][1] * sc;
                        u32x4 w; w.x = cvt_pk_bf16(v0[0], v0[1]); w.y = cvt_pk_bf16(v0[2], v0[3]); w.z = cvt_pk_bf16(v1[0], v1[1]); w.w = cvt_pk_bf16(v1[2], v1[3]);
                        *(u32x4*)(out + (size_t)(row0 + ai * HALF + m * 16) * 1024 + col0 + bj * HALF) = w; }
            }
            __builtin_amdgcn_sched_barrier(0);
        }
    }
};
template <bool MOE, bool F8OUT = false> struct EpiSwiGLU {
    static constexpr bool PERM = true;
    void* Ov; int ld; float sc;
    __device__ __forceinline__ void operator()(const f32x4 (&acc)[2][2][4][2], const Unit& u, int wr, int wc, int fr, int fq) const {
        const int row0 = u.pm * BM + wr * 64 + fr, col0 = (MOE ? u.lp : u.pn) * HALF + wc * 32 + 8 * fq;
#pragma unroll
        for (int ai = 0; ai < 2; ++ai)
#pragma unroll
            for (int m = 0; m < 4; ++m) { const size_t off = (size_t)(row0 + ai * HALF + m * 16) * ld + col0;
                f32x4 v0, v1;
                { const float c1 = -sc * LOG2E, c2 = sc * sc;
                  const f32x4 ga = acc[ai][0][m][0], gb = acc[ai][0][m][1];
                  const f32x4 xa = ga * c1, xb = gb * c1; f32x4 ea, eb;
#pragma unroll
                  for (int j = 0; j < 4; ++j) { ea[j] = __builtin_amdgcn_exp2f(xa[j]); eb[j] = __builtin_amdgcn_exp2f(xb[j]); }
                  const f32x4 da = ea + 1.0f, db = eb + 1.0f; f32x4 ra, rb;
#pragma unroll
                  for (int j = 0; j < 4; ++j) { ra[j] = __builtin_amdgcn_rcpf(da[j]); rb[j] = __builtin_amdgcn_rcpf(db[j]); }
                  v0 = (ga * acc[ai][1][m][0]) * c2 * ra; v1 = (gb * acc[ai][1][m][1]) * c2 * rb; }
                if constexpr (F8OUT) { u32x2 w; w.x = cvt_pk4_fp8(v0[0], v0[1], v0[2], v0[3]); w.y = cvt_pk4_fp8(v1[0], v1[1], v1[2], v1[3]); *(u32x2*)((unsigned char*)Ov + off) = w; }
                else { u32x4 w; w.x = cvt_pk_bf16(v0[0], v0[1]); w.y = cvt_pk_bf16(v0[2], v0[3]); w.z = cvt_pk_bf16(v1[0], v1[1]); w.w = cvt_pk_bf16(v1[2], v1[3]); *(u32x4*)((bf16_t*)Ov + off) = w; } }
    }
};
struct EpiMoeStore {
    static constexpr bool PERM = true;
    bf16_t* O; float sc; bf16_t* O2;
    __device__ __forceinline__ void operator()(const f32x4 (&acc)[2][2][4][2], const Unit& u, int wr, int wc, int fr, int fq) const {
        const bool second = (u.e >> 8) != 0;
        const int row0 = (second ? u.lp : u.pm) * BM + wr * 64 + fr, col0 = (u.pn & 3) * BM + wc * 32 + 8 * fq; bf16_t* Ob = second ? O2 : O;
#pragma unroll
        for (int ai = 0; ai < 2; ++ai)
#pragma unroll
            for (int m = 0; m < 4; ++m) { bf16_t* rowp = Ob + (size_t)(row0 + ai * HALF + m * 16) * 1024 + col0;
#pragma unroll
                for (int bj = 0; bj < 2; ++bj) { const f32x4 v0 = acc[ai][bj][m][0] * sc, v1 = acc[ai][bj][m][1] * sc;
                    u32x4 w; w.x = cvt_pk_bf16(v0[0], v0[1]); w.y = cvt_pk_bf16(v0[2], v0[3]); w.z = cvt_pk_bf16(v1[0], v1[1]); w.w = cvt_pk_bf16(v1[2], v1[3]);
                    *(u32x4*)(rowp + bj * HALF) = w; } }
    }
};
struct EpiMoeDown {
    static constexpr bool PERM = false;
    float* X; const int* idx; const float* wgt; const unsigned* cnt;
    __device__ __forceinline__ void operator()(const f32x4 (&acc)[2][2][4][2], const Unit& u, int wr, int wc, int fr, int fq) const {
        const int n = (int)cnt[64 * u.e]; const int col0 = (u.pn & 3) * BM + wc * 32 + 4 * fq;
        int tk[2][4]; float w[2][4];
#pragma unroll
        for (int ai = 0; ai < 2; ++ai)
#pragma unroll
            for (int m = 0; m < 4; ++m) { const int j = u.lp * 256 + ai * HALF + wr * 64 + m * 16 + fr; const bool ok = j < n; const int jj = ok ? j : 0;
                tk[ai][m] = ok ? idx[u.e * 32768 + jj] : -1; w[ai][m] = wgt[u.e * 32768 + jj] * (1.0f / 128.0f); }
        __builtin_amdgcn_sched_barrier(0);
#pragma unroll
        for (int ai = 0; ai < 2; ++ai) {
            f32x4 b[4][2][2];
#pragma unroll
            for (int m = 0; m < 4; ++m) { const float* p = X + (size_t)(tk[ai][m] < 0 ? 0 : tk[ai][m]) * 1024 + col0;
#pragma unroll
                for (int bj = 0; bj < 2; ++bj)
#pragma unroll
                    for (int nn = 0; nn < 2; ++nn) b[m][bj][nn] = *(const f32x4*)(p + bj * HALF + nn * 16); }
            __builtin_amdgcn_sched_barrier(0);
#pragma unroll
            for (int m = 0; m < 4; ++m) { if (tk[ai][m] >= 0) { float* p = X + (size_t)tk[ai][m] * 1024 + col0;
#pragma unroll
                for (int bj = 0; bj < 2; ++bj)
#pragma unroll
                    for (int nn = 0; nn < 2; ++nn) *(f32x4*)(p + bj * HALF + nn * 16) = b[m][bj][nn] + w[ai][m] * acc[ai][bj][m][nn]; } }
            __builtin_amdgcn_sched_barrier(0);
        }
    }
};
template <bool UP> struct MoeOrder {
    static constexpr bool GATHER = false;
    const char* A; const char* Bt; size_t tstep; const int* idx; const unsigned* cnt; int NT, G, c, g0, g1; LAS int* psl; int fake = 0; int mode = 0, khalf = 0;
    __device__ __forceinline__ void init(const void* A_, const void* Bt_, int Kb, const int* idx_, const unsigned* cnt_, int NT_, int G_, int c_, int g0_, int g1_, int tid, LAS unsigned char* ldsb) {
        A = (const char*)A_; Bt = (const char*)Bt_; tstep = (size_t)BM * Kb; idx = idx_; cnt = cnt_; NT = NT_; G = G_; c = c_; g0 = g0_; g1 = g1_; psl = (LAS int*)(ldsb + LDS_BYTES - 512);
        if (tid < 64) { const int mine = ((int)cnt[64 * (tid & 15)] + 255) >> 8; int acc_ = 0;
#pragma unroll
            for (int g = 0; g < 16; ++g) { if (tid == g) psl[g] = acc_; acc_ += __builtin_amdgcn_readlane(mine, g); }
            if (tid == 16) psl[16] = acc_; }
        __syncthreads();
        if (tid < 64) { Unit u; u.pm = 0; u.pn = 0; u.e = 0; u.lp = 0; const bool ok = compute(tid, u); LAS int* t = (LAS int*)((LAS unsigned char*)psl - (LDS_BYTES - 512) + LDS_UNITS) + 4 * tid; t[0] = ok ? u.pm : -1; t[1] = u.pn; t[2] = u.e; t[3] = u.lp; }
        __syncthreads();
    }
    __device__ __forceinline__ bool next(int i, Unit& u) const {
        if (i >= 64) return false;
        const LAS int* t = (const LAS int*)((LAS unsigned char*)psl - (LDS_BYTES - 512) + LDS_UNITS) + 4 * i; const int pm = __builtin_amdgcn_readfirstlane(t[0]);
        if (pm < 0) return false;
        u.pm = pm; u.pn = __builtin_amdgcn_readfirstlane(t[1]); u.e = __builtin_amdgcn_readfirstlane(t[2]); u.lp = __builtin_amdgcn_readfirstlane(t[3]); return true;
    }
    __device__ __forceinline__ bool compute(int i, Unit& u) const {
        int g = -1, lp = 0, pl = 0; int ps[17];
#pragma unroll
        for (int k = 0; k < 17; ++k) ps[k] = __builtin_amdgcn_readfirstlane(psl[k]);
        if (UP && (G % 8 == 0)) {
            const int x = c & 7, n = i * (G >> 3) + (c >> 3); int acc_ = 0;
#pragma unroll
            for (int k = 0; k < 16; ++k) { const int p0_ = (x + k) & 7, tc = (p0_ <= ((NT - 1) & 7)) ? ((NT - 1) >> 3) + 1 : ((NT - 1) >> 3); const int np_ = ps[k + 1] - ps[k], ne = np_ * tc;
                if (k >= g0 && k < g1) { if (g < 0 && n < acc_ + ne) { g = k; const int r = n - acc_; lp = r / tc; pl = p0_ + 8 * (r - lp * tc); } acc_ += ne; } }
            if (g < 0) return false;
        } else if (!UP && (G % 8 == 0)) {
            const int x = c & 7, np_ = ps[g1] - ps[g0]; const int pa = (x * np_) >> 3, pb = ((x + 1) * np_) >> 3;
            int n = i * (G >> 3) + (c >> 3), half = 0; const int nfull = 4 * (G >> 3);
            if (mode == 1) { if (n >= nfull) return false; }
            if (mode == 2) { half = n & 1; n = nfull + (n >> 1); }
            if (n >= (pb - pa) * NT) return false;
            const int p = ps[g0] + pa + n / NT; pl = n % NT;
#pragma unroll
            for (int k = 0; k < 16; ++k) if (p >= ps[k] && p < ps[k + 1]) { g = k; lp = p - ps[k]; }
            if (mode == 2) { int pbase2 = 0;
#pragma unroll
                for (int k = 0; k < 16; ++k) if (k == g) pbase2 = ps[k];
                u.pm = pbase2 + lp; u.pn = (g & 7) * NT + pl; u.e = g | (half << 8); u.lp = x * 4 + (n / NT - nfull / NT); return true; }
        } else {
            const int L = i * G + c, p = ps[g0] + L / NT; if (L >= (ps[g1] - ps[g0]) * NT) return false;
            pl = L % NT;
#pragma unroll
            for (int k = 0; k < 16; ++k) if (p >= ps[k] && p < ps[k + 1]) { g = k; lp = p - ps[k]; }
        }
        int pbase = 0;
#pragma unroll
        for (int k = 0; k < 16; ++k) if (k == g) pbase = ps[k];
        u.pm = pbase + lp; u.pn = (g & 7) * NT + pl; u.e = UP ? (g | (lp << 8)) : g; u.lp = UP ? pl : lp;
        return true;
    }
    __device__ __forceinline__ const char* abase(const Unit& u) const { return A + (size_t)u.pm * tstep + ((!UP && (u.e >> 8)) ? khalf : 0); }
    __device__ __forceinline__ const char* bbase(const Unit& u) const { return Bt + (size_t)(fake ? 0 : u.pn) * tstep + ((!UP && (u.e >> 8)) ? khalf : 0); }
    __device__ __forceinline__ unsigned tok(const Unit& u, int r) const { const int g = fake ? 0 : (u.e & 255), lp = fake ? 0 : (u.e >> 8); const int n = (int)cnt[64 * g]; int j = lp * 256 + r; j = j < n ? j : n - 1; return (unsigned)idx[g * 32768 + j]; }
};
}

#define XB_TMO      128
#define XB_XCNT(j)  (256  + 64 * (j))
#define XB_XSUB(j)  (1280 + 64 * (j))
#define XB_XGEN(j)  (2304 + 64 * (j))
#define XB_TOP      3328
#define XB_TOPGEN   3392
#define XCD_BAR_WORDS 3456
#define XB_SPIN_CAP (1u << 18)

__device__ __forceinline__ unsigned xb_ld(unsigned* p)              { return __hip_atomic_load(p, __ATOMIC_RELAXED, __HIP_MEMORY_SCOPE_AGENT); }
__device__ __forceinline__ unsigned xb_add(unsigned* p, unsigned v) { return __hip_atomic_fetch_add(p, v, __ATOMIC_RELAXED, __HIP_MEMORY_SCOPE_AGENT); }
__device__ __forceinline__ unsigned xb_xcc_id() { return (unsigned)__builtin_amdgcn_s_getreg((3 << 11) | 20) & 0xFu; }
#define XB_SPIN(cond, bar) do { unsigned _sp = 0; while (cond) { __builtin_amdgcn_s_sleep(1); \
    if ((++_sp & 255u) == 0u) { if (xb_ld(&(bar)[XB_TMO])) break; if (_sp > XB_SPIN_CAP) { atomicAdd(&(bar)[XB_TMO], 1u); break; } } } } while (0)

struct XcdBarrier { unsigned* bar; unsigned x; volatile LAS unsigned* st; };
__device__ __forceinline__ XcdBarrier xcd_barrier_post(unsigned* bar, volatile LAS unsigned* st, int tid) {
    XcdBarrier b; b.bar = bar; b.x = xb_xcc_id(); b.st = st;
    if (tid == 0) (void)xb_add(&bar[XB_XCNT(b.x)], 1u);
    return b;
}
__device__ __forceinline__ void xcd_barrier_complete(unsigned* bar, unsigned x, unsigned& nloc, unsigned& nx) {
    const unsigned G = gridDim.x * gridDim.y * gridDim.z;
    unsigned sum, cnt, mine, sp = 0u;
    for (;;) {
        sum = 0u; cnt = 0u; mine = 0u;
#pragma unroll
        for (unsigned j = 0; j < 16; ++j) { const unsigned c = xb_ld(&bar[XB_XCNT(j)]); sum += c; cnt += (c > 0u) ? 1u : 0u; mine = (j == x) ? c : mine; }
        if (sum == G) break;
        __builtin_amdgcn_s_sleep(1);
        if ((++sp & 255u) == 0u) { if (xb_ld(&bar[XB_TMO])) break; if (sp > XB_SPIN_CAP) { atomicAdd(&bar[XB_TMO], 1u); break; } }
    }
    nloc = mine > 0u ? mine : 1u; nx = cnt > 0u ? cnt : 1u;
}
__device__ __forceinline__ void xcd_barrier(const XcdBarrier& b, int tid) {
    asm volatile("s_waitcnt vmcnt(0)" ::: "memory");
    __syncthreads();
    if (tid == 0) {
        unsigned* bar = b.bar; asm volatile("" : "+s"(bar));
        __builtin_amdgcn_s_waitcnt(0);
        unsigned nloc = b.st[0], nx = b.st[1];
        if (nloc == 0u) { xcd_barrier_complete(bar, b.x, nloc, nx); b.st[0] = nloc; b.st[1] = nx; }
        const unsigned old = xb_add(&bar[XB_XSUB(b.x)], 1u);
        const unsigned gen = old / nloc;
        if (old + 1u == (gen + 1u) * nloc) {
            __builtin_amdgcn_fence(__ATOMIC_RELEASE, "agent");
            asm volatile("s_waitcnt vmcnt(0)" ::: "memory");
            const unsigned og = xb_add(&bar[XB_TOP], 1u);
            const unsigned tg = og / nx;
            if (og + 1u == (tg + 1u) * nx) xb_add(&bar[XB_TOPGEN], 1u);
            else XB_SPIN(xb_ld(&bar[XB_TOPGEN]) == tg, bar);
            __builtin_amdgcn_fence(__ATOMIC_ACQUIRE, "agent");
            xb_add(&bar[XB_XGEN(b.x)], 1u);
            asm volatile("s_waitcnt vmcnt(0)" ::: "memory");
        } else {
            XB_SPIN(xb_ld(&bar[XB_XGEN(b.x)]) == gen, bar);
            __builtin_amdgcn_fence(__ATOMIC_ACQUIRE, "agent");
            asm volatile("s_waitcnt vmcnt(0)" ::: "memory");
        }
    }
    __syncthreads();
}

struct Args { const float* in[22]; float* out; unsigned char* ws; };
typedef __attribute__((address_space(4))) const unsigned char* karg_t;
__device__ __forceinline__ karg_t kargs() { karg_t p = (karg_t)__builtin_amdgcn_kernarg_segment_ptr(); asm volatile("" : "+s"(p)); return p; }
#define AIN(i) (((const float* const __attribute__((address_space(4)))*)kargs())[i])
#define AOUT() (((float* const __attribute__((address_space(4)))*)kargs())[22])
#define AWS() (((unsigned char* const __attribute__((address_space(4)))*)kargs())[23])
struct Frame {
    LAS unsigned char* lds; unsigned char* ws;
    int tid, lane, wave, vcu, G;
};


template <int O> __device__ __forceinline__ float shx(float v) {
    if constexpr (O < 32) return __int_as_float(__builtin_amdgcn_ds_swizzle(__float_as_int(v), 0x1f | (O << 10)));
    else { auto rr = __builtin_amdgcn_permlane32_swap(__float_as_uint(v), __float_as_uint(v), false, false); const float lo = __uint_as_float(rr[0]), hi = __uint_as_float(rr[1]); return (lo + hi) - v; }
}
template <int O> __device__ __forceinline__ float shx_sum(float v) {
    if constexpr (O < 32) return v + shx<O>(v);
    else { auto rr = __builtin_amdgcn_permlane32_swap(__float_as_uint(v), __float_as_uint(v), false, false); return __uint_as_float(rr[0]) + __uint_as_float(rr[1]); }
}
template <int O> __device__ __forceinline__ float shx_max(float v) {
    if constexpr (O < 32) return fmaxf(v, shx<O>(v));
    else { auto rr = __builtin_amdgcn_permlane32_swap(__float_as_uint(v), __float_as_uint(v), false, false); return fmaxf(__uint_as_float(rr[0]), __uint_as_float(rr[1])); }
}
__device__ __forceinline__ float bperm(int src_lane, float v) { return __int_as_float(__builtin_amdgcn_ds_bpermute(src_lane << 2, __float_as_int(v))); }
__device__ __forceinline__ Frame unit_frame(const Frame& F) { Frame f = F; LAS unsigned char* L = F.lds; asm volatile("" : "+s"(L)); int l = F.lane; asm volatile("" : "+v"(l)); f.lds = L; f.lane = l; f.tid = f.wave * 64 + l; return f; }
__device__ __forceinline__ float wave_sum(float v) { v = shx_sum<1>(v); v = shx_sum<2>(v); v = shx_sum<4>(v); v = shx_sum<8>(v); v = shx_sum<16>(v); v = shx_sum<32>(v); return v; }
__device__ __forceinline__ float wave_max(float v) { v = shx_max<1>(v); v = shx_max<2>(v); v = shx_max<4>(v); v = shx_max<8>(v); v = shx_max<16>(v); v = shx_max<32>(v); return v; }

struct TrDesc { const float* src; int ldw; unsigned char* dst; int Kd; };
__device__ __forceinline__ void tr_load(float (&v)[32], const TrDesc& d, int lane) {
#pragma unroll
    for (int i = 0; i < 32; ++i) v[i] = __builtin_nontemporal_load(d.src + (size_t)(2 * i + (lane >> 5)) * d.ldw + (lane & 31));
}
template <bool F8> __device__ __forceinline__ void tr_store(const float (&v)[32], const TrDesc& d, LAS float* scr, int lane, float sc) {
#pragma unroll
    for (int i = 0; i < 32; ++i) scr[(2 * i + (lane >> 5)) * 33 + (lane & 31)] = F8 ? v[i] * sc : v[i];
    LDS_WAIT(); asm volatile("" ::: "memory");
    if constexpr (F8) { const int c = lane & 3;
#pragma unroll
        for (int j = 0; j < 2; ++j) { const int n = (lane >> 2) + 16 * j; const LAS float* s = scr + (16 * c) * 33 + n;
            u32x4 o; o.x = cvt_pk4_fp8(s[0 * 33], s[1 * 33], s[2 * 33], s[3 * 33]); o.y = cvt_pk4_fp8(s[4 * 33], s[5 * 33], s[6 * 33], s[7 * 33]);
            o.z = cvt_pk4_fp8(s[8 * 33], s[9 * 33], s[10 * 33], s[11 * 33]); o.w = cvt_pk4_fp8(s[12 * 33], s[13 * 33], s[14 * 33], s[15 * 33]);
            *(GAS u32x4*)(d.dst + (size_t)n * d.Kd + 16 * c) = o; } }
    else { const int c = lane & 7;
#pragma unroll
        for (int j = 0; j < 4; ++j) { const int n = (lane >> 3) + 8 * j; const LAS float* s = scr + (8 * c) * 33 + n;
            u32x4 o; o.x = cvt_pk_bf16(s[0 * 33], s[1 * 33]); o.y = cvt_pk_bf16(s[2 * 33], s[3 * 33]); o.z = cvt_pk_bf16(s[4 * 33], s[5 * 33]); o.w = cvt_pk_bf16(s[6 * 33], s[7 * 33]);
            *(GAS u32x4*)(d.dst + ((size_t)n * d.Kd + 8 * c) * 2) = o; } }
    LDS_WAIT(); asm volatile("" ::: "memory");
}
__device__ __forceinline__ TrDesc tr_desc(const float* W, int N, int ldw, void* WT, int Kd, int esz, int mode, int bj, int item, int cb = 0) {
    const int nblk = N / 32, kb = item / nblk, nb = item % nblk; const int c0 = cb + 32 * nb;
    int n0 = c0, dr = c0;
    if (mode == 1) { n0 = c0 + (c0 >= 2048 ? 8 : 0);
        if (c0 >= 2048 && c0 < 3072) { const int cl = (c0 - 2048) & 255; dr = (c0 & ~255) + 128 * ((cl >> 5) & 1) + 32 * (cl >> 6); } }
    if (mode == 2) { dr = 256 * (c0 >> 7) + 128 * bj + (c0 & 127); }
    TrDesc d; d.src = W + (size_t)(64 * kb) * ldw + n0; d.ldw = ldw; d.dst = (unsigned char*)WT + ((size_t)dr * Kd + 64 * kb) * esz; d.Kd = Kd; return d;
}
constexpr int P0_IN_BF = (IN8 == 2) ? 2048 : NIN, P0_IN_F8 = (IN8 == 2) ? NIN - 2048 : NIN;
constexpr int P0_I_IN = 16 * (P0_IN_BF / 32), P0_I_IN8 = 16 * (P0_IN_F8 / 32), P0_I_BR = 8 * 32, P0_I_OUT = 16 * 32, P0_I_GU = 16 * (DFF / 32), P0_I_D = (DFF / 64) * 32;
constexpr int P0_GU_MAIN = DUP8 ? 0 : P0_I_GU, P0_D_MAIN = DDN8 ? 0 : P0_I_D;
constexpr int P0_NITEMS = 2 * P0_I_IN + 4 * P0_I_BR + 2 * P0_I_OUT + 2 * P0_GU_MAIN + P0_D_MAIN;
__device__ __forceinline__ TrDesc p0_desc(Frame& F, int it) {
    int r = it;
    if (r < 2 * P0_I_IN) { const int l = r / P0_I_IN; return tr_desc(AIN(3) + (size_t)l * DM * INW, P0_IN_BF, INW, (bf16_t*)(F.ws + WS_WIN) + (size_t)l * NIN * DM, DM, 2, 1, 0, r % P0_I_IN); } r -= 2 * P0_I_IN;
    if (r < 2 * P0_I_BR) { const int l = r / P0_I_BR; return tr_desc(AIN(11) + (size_t)l * 512 * DM, DM, DM, (bf16_t*)(F.ws + WS_WA) + (size_t)l * DM * 512, 512, 2, 0, 0, r % P0_I_BR); } r -= 2 * P0_I_BR;
    if (r < 2 * P0_I_BR) { const int l = r / P0_I_BR; return tr_desc(AIN(12) + (size_t)l * 512 * DM, DM, DM, (bf16_t*)(F.ws + WS_WB) + (size_t)l * DM * 512, 512, 2, 0, 0, r % P0_I_BR); } r -= 2 * P0_I_BR;
    if (r < 2 * P0_I_OUT) { const int l = r / P0_I_OUT; return tr_desc(AIN(13) + (size_t)l * DM * DM, DM, DM, (bf16_t*)(F.ws + WS_WOUT) + (size_t)l * DM * DM, DM, 2, 0, 0, r % P0_I_OUT); } r -= 2 * P0_I_OUT;
    if (r < P0_GU_MAIN) return tr_desc(AIN(15), DFF, DFF, F.ws + WS_WGU, DM, 2, 2, 0, r); r -= P0_GU_MAIN;
    if (r < P0_GU_MAIN) return tr_desc(AIN(16), DFF, DFF, F.ws + WS_WGU, DM, 2, 2, 1, r); r -= P0_GU_MAIN;
    return tr_desc(AIN(17), DM, DM, F.ws + WS_WD, DFF, 2, 0, 0, r);
}
constexpr int PE_I_GU = 16 * (EFF / 32), PE_I_D = (EFF / 64) * 32, PE_I_E = 2 * PE_I_GU + PE_I_D;
__device__ __forceinline__ TrDesc pe_desc(Frame& F, int it, float& sc) {
    const int e = it / PE_I_E; int r = it % PE_I_E;
    if (r < 2 * PE_I_GU) { const int bj = r >= PE_I_GU; r -= bj * PE_I_GU; sc = 64.0f; return tr_desc((bj ? AIN(20) : AIN(19)) + (size_t)e * DM * EFF, EFF, EFF, F.ws + WS_WGUE + (size_t)e * 2 * EFF * DM, DM, 1, 2, bj, r); }
    r -= 2 * PE_I_GU; sc = 128.0f;
    return tr_desc(AIN(21) + (size_t)e * EFF * DM, DM, DM, F.ws + WS_WDE + (size_t)e * DM * EFF, EFF, 1, 0, 0, r);
}
__device__ __forceinline__ void p0_convert(Frame& F) {
    LAS float* scr = (LAS float*)(F.lds + F.wave * 8704);
    const int gw = F.vcu * 8 + F.wave, NGW = F.G * 8;
    float va[32], vb[32]; TrDesc da, db; int it = gw;
    if (it < P0_NITEMS) { da = p0_desc(F, it); tr_load(va, da, F.lane); }
    while (it < P0_NITEMS) {
        int itn = it + NGW; if (itn < P0_NITEMS) { db = p0_desc(F, itn); tr_load(vb, db, F.lane); }
        tr_store<false>(va, da, scr, F.lane, 1.0f); it = itn; if (it >= P0_NITEMS) break;
        itn = it + NGW; if (itn < P0_NITEMS) { da = p0_desc(F, itn); tr_load(va, da, F.lane); }
        tr_store<false>(vb, db, scr, F.lane, 1.0f); it = itn;
    }
#if DUP8
    for (int i8 = gw; i8 < 2 * P0_I_GU; i8 += NGW) { const int bj = i8 >= P0_I_GU; const TrDesc d8 = tr_desc(bj ? AIN(16) : AIN(15), DFF, DFF, F.ws + WS_WGU, DM, 1, 2, bj, i8 - bj * P0_I_GU);
        tr_load(va, d8, F.lane); tr_store<true>(va, d8, scr, F.lane, 64.0f); }
#endif
#if DDN8
    for (int i8 = gw; i8 < P0_I_D; i8 += NGW) { const TrDesc d8 = tr_desc(AIN(17), DM, DM, F.ws + WS_WD, DFF, 1, 0, 0, i8);
        tr_load(va, d8, F.lane); tr_store<true>(va, d8, scr, F.lane, 128.0f); }
#endif
#if OUT8
    for (int i8 = gw; i8 < 2 * P0_I_OUT; i8 += NGW) { const int l = i8 / P0_I_OUT; const TrDesc d8 = tr_desc(AIN(13) + (size_t)l * DM * DM, DM, DM, F.ws + WS_WOUT8 + (size_t)l * DM * DM, DM, 1, 0, 0, i8 % P0_I_OUT);
        tr_load(va, d8, F.lane); tr_store<true>(va, d8, scr, F.lane, 64.0f); }
#endif
#if IN8
    for (int i8 = gw; i8 < 2 * P0_I_IN8; i8 += NGW) { const int l = i8 / P0_I_IN8; const TrDesc d8 = tr_desc(AIN(3) + (size_t)l * DM * INW, P0_IN_F8, INW, F.ws + 541 * MiB + (size_t)l * NIN * DM, DM, 1, 1, 0, i8 % P0_I_IN8, NIN - P0_IN_F8);
        tr_load(va, d8, F.lane); tr_store<true>(va, d8, scr, F.lane, 64.0f); }
#endif
}
__device__ __forceinline__ void p_convert_experts(Frame& F) {
    LAS float* scr = (LAS float*)(F.lds + F.wave * 8704);
    const int gw = F.vcu * 8 + F.wave, NGW = F.G * 8; constexpr int NI = 8 * PE_I_E;
    float va[32], vb[32]; TrDesc da, db; float sa = 1.f, sb = 1.f; int it = gw;
    if (it < NI) { da = pe_desc(F, it, sa); tr_load(va, da, F.lane); }
    while (it < NI) {
        int itn = it + NGW; if (itn < NI) { db = pe_desc(F, itn, sb); tr_load(vb, db, F.lane); }
        tr_store<true>(va, da, scr, F.lane, sa); it = itn; if (it >= NI) break;
        itn = it + NGW; if (itn < NI) { da = pe_desc(F, itn, sa); tr_load(va, da, F.lane); }
        tr_store<true>(vb, db, scr, F.lane, sb); it = itn;
    }
}

__device__ __forceinline__ float wave_sum_fast(float v) {
    v += dppf<0xB1>(v); v += dppf<0x4E>(v); v += dppf<0x141>(v); v += dppf<0x140>(v); v = shx_sum<16>(v); v = shx_sum<32>(v); return v; }
__device__ __forceinline__ float reduce8(const float (&d)[8], int lane) {
    const bool b0 = lane & 1, b1 = lane & 2, b2 = lane & 4;
    float e[4];
#pragma unroll
    for (int i = 0; i < 4; ++i) { const float snd = b0 ? d[i] : d[4 + i], kp = b0 ? d[4 + i] : d[i]; e[i] = kp + dppf<0xB1>(snd); }
    float f[2];
#pragma unroll
    for (int i = 0; i < 2; ++i) { const float snd = b1 ? e[i] : e[2 + i], kp = b1 ? e[2 + i] : e[i]; f[i] = kp + dppf<0x4E>(snd); }
    const float snd = b2 ? f[0] : f[1], kp = b2 ? f[1] : f[0];
    float g = kp + shx<4>(snd);
    g = shx_sum<8>(g); g = shx_sum<16>(g); g = shx_sum<32>(g);
    return g;
}
template <int MODE>
__device__ __forceinline__ void norm_store_row(Frame& F, f32x4 (&v)[4], const f32x4 (&gv)[4], float ss, int m, bool on) {
    const float r = 1.0f / sqrtf(ss * (1.f / DM) + EPS);
#pragma unroll
    for (int j = 0; j < 4; ++j) v[j] = v[j] * r * gv[j];
    if (!on) return;
    if (MODE == 2 || MODE == 3 || (MODE == 0 && IN8)) { u32x2* o4 = (u32x2*)(F.ws + (MODE == 0 ? WS_XN8IN : WS_XN8) + (size_t)m * DM) + F.lane;
#pragma unroll
        for (int j = 0; j < 2; ++j) { u32x2 w; w.x = cvt_pk4_fp8(v[2 * j].x, v[2 * j].y, v[2 * j].z, v[2 * j].w); w.y = cvt_pk4_fp8(v[2 * j + 1].x, v[2 * j + 1].y, v[2 * j + 1].z, v[2 * j + 1].w); o4[64 * j] = w; } }
    if (!(MODE == 2 || MODE == 3 || (MODE == 0 && IN8 == 1))) { u32x4* o8 = (u32x4*)((bf16_t*)(F.ws + WS_XN) + (size_t)m * DM) + F.lane;
#pragma unroll
        for (int j = 0; j < 2; ++j) { u32x4 w; w.x = cvt_pk_bf16(v[2 * j].x, v[2 * j].y); w.y = cvt_pk_bf16(v[2 * j].z, v[2 * j].w); w.z = cvt_pk_bf16(v[2 * j + 1].x, v[2 * j + 1].y); w.w = cvt_pk_bf16(v[2 * j + 1].z, v[2 * j + 1].w); o8[64 * j] = w; } }
}
struct Top2 { int e1, e2; float w1, w2; };
__device__ __forceinline__ Top2 route_top2(float g) {
    float lg[8];
#pragma unroll
    for (int c = 0; c < 8; ++c) lg[c] = __int_as_float(__builtin_amdgcn_readlane(__float_as_int(g), ((c >> 2) & 1) | (c & 2) | ((c & 1) << 2)));
    Top2 t; t.e1 = 0; float v1 = lg[0];
#pragma unroll
    for (int c = 1; c < 8; ++c) if (lg[c] > v1) { v1 = lg[c]; t.e1 = c; }
    t.e2 = -1; float v2 = -INFINITY;
#pragma unroll
    for (int c = 0; c < 8; ++c) if (c != t.e1 && lg[c] > v2) { v2 = lg[c]; t.e2 = c; }
    const float ex = __expf(v2 - v1); t.w1 = 1.0f / (1.0f + ex); t.w2 = ex * t.w1; return t;
}
template <int MODE>
__device__ __forceinline__ void norm_rows2(Frame& F, f32x4 (&va)[4], f32x4 (&vb)[4], const f32x4 (&gv)[4], float sa, float sb, int ma, int mb, bool has2, const LAS float* w8, const float* bi, const float* bf) {
    norm_store_row<MODE>(F, va, gv, sa, ma, true); norm_store_row<MODE>(F, vb, gv, sb, mb, has2);
    if (MODE != 1 && MODE != 3) {
        f32x2 da[4], db[4];
#pragma unroll
        for (int c = 0; c < 4; ++c) { da[c] = f32x2{0.f, 0.f}; db[c] = f32x2{0.f, 0.f}; }
#pragma unroll
        for (int j = 0; j < 4; ++j)
#pragma unroll
            for (int q = 0; q < 4; ++q) { const LAS f32x4* wp = (const LAS f32x4*)w8 + ((j * 4 + q) * 2) * 64 + F.lane; const f32x4 wa = wp[0], wb = wp[64];
                const f32x2 w01 = {wa.x, wa.y}, w23 = {wa.z, wa.w}, w45 = {wb.x, wb.y}, w67 = {wb.z, wb.w};
                const f32x2 ya = {va[j][q], va[j][q]}, yb = {vb[j][q], vb[j][q]};
                da[0] += ya * w01; da[1] += ya * w23; da[2] += ya * w45; da[3] += ya * w67;
                db[0] += yb * w01; db[1] += yb * w23; db[2] += yb * w45; db[3] += yb * w67; }
        const float d0[8] = {da[0].x, da[0].y, da[1].x, da[1].y, da[2].x, da[2].y, da[3].x, da[3].y};
        const float d1[8] = {db[0].x, db[0].y, db[1].x, db[1].y, db[2].x, db[2].y, db[3].x, db[3].y};
        const float ga = reduce8(d0, F.lane), gb = reduce8(d1, F.lane);
        const int myc = 4 * (F.lane & 1) + (F.lane & 2) + ((F.lane >> 2) & 1);
        if (MODE == 0) {
            if (F.lane < 16 && (has2 || F.lane < 8)) { const float g = F.lane < 8 ? ga : gb; float o;
                if (myc < 4) o = g + bi[myc];
                else { const float fp = g + bf[myc - 4]; o = fminf(fp, 0.f) - __logf(1.0f + __expf(-fabsf(fp))); }
                ((float*)(F.ws + WS_GATES))[(size_t)(F.lane < 8 ? ma : mb) * 8 + myc] = o; }
        } else {
            const Top2 ta = route_top2(ga), tb = route_top2(gb);
            if (F.lane < 4 && (has2 || F.lane < 2)) { const bool rb = F.lane >= 2; const int rk = F.lane & 1, m = rb ? mb : ma;
                const int e = rb ? (rk ? tb.e2 : tb.e1) : (rk ? ta.e2 : ta.e1); const float w = rb ? (rk ? tb.w2 : tb.w1) : (rk ? ta.w2 : ta.w1);
                const unsigned pos = __hip_atomic_fetch_add(((unsigned*)F.ws + CW_MOE + 64 * (rk * 8 + e)), 1u, __ATOMIC_RELAXED, __HIP_MEMORY_SCOPE_AGENT);
                ((int*)(F.ws + WS_MIDX))[(size_t)(rk * 8 + e) * 32768 + pos] = m; ((float*)(F.ws + WS_MWGT))[(size_t)(rk * 8 + e) * 32768 + pos] = w;
                ((unsigned*)(F.ws + WS_RINFO))[(size_t)m * 2 + rk] = (unsigned)(rk * 8 + e) | (pos << 4); }
        }
    }
}
template <int MODE>
__device__ __forceinline__ void norm_pass(Frame& F, const void* Xv, bool xbf, const float* gain, const float* W8, int ldw8, const float* bi, const float* bf) {
    LAS float* w8 = (LAS float*)F.lds;
    if (MODE != 1 && MODE != 3) {
#pragma unroll 4
        for (int k = 0; k < 16; ++k) { const int i = F.tid + 512 * k, kk = i >> 3, c = i & 7;
            w8[((((2 * (kk >> 9) + ((kk >> 2) & 1)) * 4 + (kk & 3)) * 2 + (c >> 2)) * 64 + ((kk & 511) >> 3)) * 4 + (c & 3)] = W8[(size_t)kk * ldw8 + c]; }
        __syncthreads();
    }
    const int gw = F.vcu * 8 + F.wave, NGW = F.G * 8;
    f32x4 gv[4];
#pragma unroll
    for (int j = 0; j < 4; ++j) gv[j] = *(const f32x4*)(gain + 512 * (j >> 1) + 8 * F.lane + 4 * (j & 1));
    for (int m = gw; m < MTOK; m += 2 * NGW) {
        const int m2 = m + NGW; const bool has2 = m2 < MTOK; const int mb = has2 ? m2 : m;
        f32x4 va[4], vb[4]; float sa = 0.f, sb = 0.f;
        if (xbf) { const u32x4* xa = (const u32x4*)((const bf16_t*)Xv + (size_t)m * DM) + F.lane; const u32x4* xb = (const u32x4*)((const bf16_t*)Xv + (size_t)mb * DM) + F.lane;
            u32x4 ra[2], rb[2];
#pragma unroll
            for (int j = 0; j < 2; ++j) { ra[j] = xa[64 * j]; rb[j] = xb[64 * j]; }
            if (MODE == 2) {
                u32x4* ca = (u32x4*)(F.ws + (m < X3_SPLIT ? WS_X3A + (size_t)m * (DM * 2) : WS_X3B + (size_t)(m - X3_SPLIT) * (DM * 2))) + F.lane;
                u32x4* cb = (u32x4*)(F.ws + (mb < X3_SPLIT ? WS_X3A + (size_t)mb * (DM * 2) : WS_X3B + (size_t)(mb - X3_SPLIT) * (DM * 2))) + F.lane;
#pragma unroll
                for (int j = 0; j < 2; ++j) { ca[64 * j] = ra[j]; if (has2) cb[64 * j] = rb[j]; } }
#pragma unroll
            for (int j = 0; j < 2; ++j) {
                va[2 * j] = (f32x4){bf_lo(ra[j].x), bf_hi(ra[j].x), bf_lo(ra[j].y), bf_hi(ra[j].y)}; va[2 * j + 1] = (f32x4){bf_lo(ra[j].z), bf_hi(ra[j].z), bf_lo(ra[j].w), bf_hi(ra[j].w)};
                vb[2 * j] = (f32x4){bf_lo(rb[j].x), bf_hi(rb[j].x), bf_lo(rb[j].y), bf_hi(rb[j].y)}; vb[2 * j + 1] = (f32x4){bf_lo(rb[j].z), bf_hi(rb[j].z), bf_lo(rb[j].w), bf_hi(rb[j].w)}; }
        } else { const f32x4* xa = (const f32x4*)((const float*)Xv + (size_t)m * DM) + 2 * F.lane; const f32x4* xb = (const f32x4*)((const float*)Xv + (size_t)mb * DM) + 2 * F.lane;
#pragma unroll
            for (int j = 0; j < 4; ++j) { va[j] = xa[128 * (j >> 1) + (j & 1)]; vb[j] = xb[128 * (j >> 1) + (j & 1)]; } }
#pragma unroll
        for (int j = 0; j < 4; ++j) { sa += (va[j].x * va[j].x + va[j].y * va[j].y) + (va[j].z * va[j].z + va[j].w * va[j].w); sb += (vb[j].x * vb[j].x + vb[j].y * vb[j].y) + (vb[j].z * vb[j].z + vb[j].w * vb[j].w); }
        sa = wave_sum_fast(sa); sb = wave_sum_fast(sb);
        norm_rows2<MODE>(F, va, vb, gv, sa, sb, m, mb, has2, w8, bi, bf);
    }
    __syncthreads();
}

__device__ __forceinline__ void moe_place(Frame& F) {
    const unsigned* cnt = (const unsigned*)F.ws + CW_MOE;
    const int mine = ((int)cnt[64 * (F.lane & 15)] + 255) >> 8; int pre = 0, acc_ = 0;
#pragma unroll
    for (int g = 0; g < 16; ++g) { if ((F.lane & 15) == g) pre = acc_; acc_ += __builtin_amdgcn_readlane(mine, g); }
    const int gw = F.vcu * 8 + F.wave, NGW = F.G * 8;
    for (int pr0 = gw; pr0 < 2 * MTOK; pr0 += 4 * NGW) {
        unsigned info[4]; u32x4 v[4];
#pragma unroll
        for (int i = 0; i < 4; ++i) { const int pr = pr0 + i * NGW; info[i] = (pr < 2 * MTOK) ? ((const unsigned*)(F.ws + WS_RINFO))[pr] : 0u; }
#pragma unroll
        for (int i = 0; i < 4; ++i) { const int pr = pr0 + i * NGW; v[i] = *((const u32x4*)(F.ws + WS_XN8 + (size_t)((pr < 2 * MTOK ? pr : gw) >> 1) * DM) + F.lane); }
#pragma unroll
        for (int i = 0; i < 4; ++i) { const int pr = pr0 + i * NGW; const int g = info[i] & 15, pos = (int)(info[i] >> 4);
            const int base = __builtin_amdgcn_readlane(pre, __builtin_amdgcn_readfirstlane(g));
            if (pr < 2 * MTOK) *((u32x4*)(F.ws + WS_XN8S + ((size_t)base * 256 + pos) * DM) + F.lane) = v[i]; }
    }
}

__device__ __forceinline__ void moe_combine(Frame& F, float* X) {
    const unsigned* cnt = (const unsigned*)F.ws + CW_MOE;
    const int mine = ((int)cnt[64 * (F.lane & 15)] + 255) >> 8; int pre = 0, acc_ = 0;
#pragma unroll
    for (int g = 0; g < 16; ++g) { if ((F.lane & 15) == g) pre = acc_; acc_ += __builtin_amdgcn_readlane(mine, g); }
    const int gw = F.vcu * 8 + F.wave, NGW = F.G * 8;
    const unsigned* RI = (const unsigned*)(F.ws + WS_RINFO); const float* WG = (const float*)(F.ws + WS_MWGT); const bf16_t* YP = (const bf16_t*)(F.ws + WS_YP); const bf16_t* YP2 = (const bf16_t*)(F.ws + WS_YP2);
    const bool split = (F.G % 8 == 0); const int ptot = __builtin_amdgcn_readfirstlane(acc_), gq = F.G >> 3;
    for (int tb = gw; tb < MTOK; tb += 2 * NGW) {
        int tt[2]; tt[0] = tb; tt[1] = (tb + NGW < MTOK) ? tb + NGW : tb;
        unsigned ia[2], ib[2];
#pragma unroll
        for (int k = 0; k < 2; ++k) { ia[k] = RI[2 * tt[k]]; ib[k] = RI[2 * tt[k] + 1]; }
        float w0[2], w1[2]; const u32x2* y0[2]; const u32x2* y1[2]; const u32x2* xc[2]; const u32x2* z0[2]; const u32x2* z1[2];
#pragma unroll
        for (int k = 0; k < 2; ++k) { const int t = tt[k];
            const int g0 = __builtin_amdgcn_readfirstlane((int)(ia[k] & 15)), p0 = __builtin_amdgcn_readfirstlane((int)(ia[k] >> 4)), g1 = __builtin_amdgcn_readfirstlane((int)(ib[k] & 15)), p1 = __builtin_amdgcn_readfirstlane((int)(ib[k] >> 4));
            w0[k] = WG[g0 * 32768 + p0]; w1[k] = WG[g1 * 32768 + p1];
            const size_t r0 = (size_t)__builtin_amdgcn_readlane(pre, g0) * 256 + p0, r1 = (size_t)__builtin_amdgcn_readlane(pre, g1) * 256 + p1;
            y0[k] = (const u32x2*)(YP + r0 * DM) + F.lane; y1[k] = (const u32x2*)(YP + r1 * DM) + F.lane;
            z0[k] = nullptr; z1[k] = nullptr;
            if (split) { const int q0 = (int)(r0 >> 8), q1 = (int)(r1 >> 8), x0 = (8 * q0 + 7) / ptot, x1 = (8 * q1 + 7) / ptot, o0 = q0 - ((x0 * ptot) >> 3) - gq, o1 = q1 - ((x1 * ptot) >> 3) - gq;
                if (o0 >= 0) z0[k] = (const u32x2*)(YP2 + ((size_t)(x0 * 4 + o0) * 256 + (r0 & 255)) * DM) + F.lane;
                if (o1 >= 0) z1[k] = (const u32x2*)(YP2 + ((size_t)(x1 * 4 + o1) * 256 + (r1 & 255)) * DM) + F.lane; }
            xc[k] = (const u32x2*)(F.ws + (t < X3_SPLIT ? WS_X3A + (size_t)t * (DM * 2) : WS_X3B + (size_t)(t - X3_SPLIT) * (DM * 2))) + F.lane; }
        u32x2 xv[2][4], a[2][4], b[2][4];
#pragma unroll
        for (int k = 0; k < 2; ++k)
#pragma unroll
            for (int j = 0; j < 4; ++j) { xv[k][j] = xc[k][64 * j]; a[k][j] = y0[k][64 * j]; b[k][j] = y1[k][64 * j]; }
#pragma unroll
        for (int k = 0; k < 2; ++k) {
            if (z0[k] != nullptr) {
#pragma unroll
                for (int j = 0; j < 4; ++j) { const u32x2 z = z0[k][64 * j]; a[k][j].x = cvt_pk_bf16(bf_lo(a[k][j].x) + bf_lo(z.x), bf_hi(a[k][j].x) + bf_hi(z.x)); a[k][j].y = cvt_pk_bf16(bf_lo(a[k][j].y) + bf_lo(z.y), bf_hi(a[k][j].y) + bf_hi(z.y)); } }
            if (z1[k] != nullptr) {
#pragma unroll
                for (int j = 0; j < 4; ++j) { const u32x2 z = z1[k][64 * j]; b[k][j].x = cvt_pk_bf16(bf_lo(b[k][j].x) + bf_lo(z.x), bf_hi(b[k][j].x) + bf_hi(z.x)); b[k][j].y = cvt_pk_bf16(bf_lo(b[k][j].y) + bf_lo(z.y), bf_hi(b[k][j].y) + bf_hi(z.y)); } } }
#pragma unroll
        for (int k = 0; k < 2; ++k) { if (k == 1 && tt[1] == tt[0]) break;
            f32x4* xr = (f32x4*)(X + (size_t)tt[k] * DM) + F.lane;
#pragma unroll
            for (int j = 0; j < 4; ++j) { f32x4 o = {bf_lo(xv[k][j].x), bf_hi(xv[k][j].x), bf_lo(xv[k][j].y), bf_hi(xv[k][j].y)};
                o.x += w0[k] * bf_lo(a[k][j].x) + w1[k] * bf_lo(b[k][j].x); o.y += w0[k] * bf_hi(a[k][j].x) + w1[k] * bf_hi(b[k][j].x); o.z += w0[k] * bf_lo(a[k][j].y) + w1[k] * bf_lo(b[k][j].y); o.w += w0[k] * bf_hi(a[k][j].y) + w1[k] * bf_hi(b[k][j].y);
                xr[64 * j] = o; } }
    }
}

__device__ __forceinline__ void moba_prep_item(const Frame& F0, int it, const float* qg, const float* kg) {
    Frame F = unit_frame(F0);
    const int h = it & 7, blk = (it >> 3) & 15, b = it >> 7;
    const size_t r0 = (size_t)b * SEQ + blk * ABLK;
    const int row = F.tid >> 1, half = F.tid & 1;
    LAS float* part = (LAS float*)F.lds;
    bf16_t* qp = (bf16_t*)(F.ws + WS_AQ) + (r0 + row) * 512 + h * 64 + half * 32;
    bf16_t* kp = (bf16_t*)(F.ws + WS_AK) + (r0 + row) * 512 + h * 64 + half * 32;
    float gq[32], gk[32];
#pragma unroll
    for (int i = 0; i < 32; ++i) { gq[i] = qg[half * 32 + i] * QSCALE; gk[i] = kg[half * 32 + i]; }
    {
        u32x4 w[4]; float x[32]; float ss = 0.f;
#pragma unroll
        for (int i = 0; i < 4; ++i) w[i] = ((const u32x4*)qp)[i];
#pragma unroll
        for (int i = 0; i < 4; ++i) { x[8 * i + 0] = bf_lo(w[i].x); x[8 * i + 1] = bf_hi(w[i].x); x[8 * i + 2] = bf_lo(w[i].y); x[8 * i + 3] = bf_hi(w[i].y); x[8 * i + 4] = bf_lo(w[i].z); x[8 * i + 5] = bf_hi(w[i].z); x[8 * i + 6] = bf_lo(w[i].w); x[8 * i + 7] = bf_hi(w[i].w); }
#pragma unroll
        for (int i = 0; i < 32; ++i) ss += x[i] * x[i];
        ss = shx_sum<1>(ss);
        const float r = 1.0f / sqrtf(ss * (1.f / 64.f) + EPS);
#pragma unroll
        for (int i = 0; i < 4; ++i) { u32x4 o; o.x = cvt_pk_bf16(x[8 * i] * r * gq[8 * i], x[8 * i + 1] * r * gq[8 * i + 1]); o.y = cvt_pk_bf16(x[8 * i + 2] * r * gq[8 * i + 2], x[8 * i + 3] * r * gq[8 * i + 3]);
            o.z = cvt_pk_bf16(x[8 * i + 4] * r * gq[8 * i + 4], x[8 * i + 5] * r * gq[8 * i + 5]); o.w = cvt_pk_bf16(x[8 * i + 6] * r * gq[8 * i + 6], x[8 * i + 7] * r * gq[8 * i + 7]); ((u32x4*)qp)[i] = o; }
    }
    {
        u32x4 w[4]; float x[32]; float ss = 0.f;
#pragma unroll
        for (int i = 0; i < 4; ++i) w[i] = ((const u32x4*)kp)[i];
#pragma unroll
        for (int i = 0; i < 4; ++i) { x[8 * i + 0] = bf_lo(w[i].x); x[8 * i + 1] = bf_hi(w[i].x); x[8 * i + 2] = bf_lo(w[i].y); x[8 * i + 3] = bf_hi(w[i].y); x[8 * i + 4] = bf_lo(w[i].z); x[8 * i + 5] = bf_hi(w[i].z); x[8 * i + 6] = bf_lo(w[i].w); x[8 * i + 7] = bf_hi(w[i].w); }
#pragma unroll
        for (int i = 0; i < 32; ++i) ss += x[i] * x[i];
        ss = shx_sum<1>(ss);
        const float r = 1.0f / sqrtf(ss * (1.f / 64.f) + EPS);
#pragma unroll
        for (int i = 0; i < 32; ++i) x[i] = x[i] * r * gk[i];
#pragma unroll
        for (int i = 0; i < 4; ++i) { u32x4 o; o.x = cvt_pk_bf16(x[8 * i], x[8 * i + 1]); o.y = cvt_pk_bf16(x[8 * i + 2], x[8 * i + 3]); o.z = cvt_pk_bf16(x[8 * i + 4], x[8 * i + 5]); o.w = cvt_pk_bf16(x[8 * i + 6], x[8 * i + 7]); ((u32x4*)kp)[i] = o; }
#pragma unroll
        for (int i = 0; i < 32; ++i) { float s = x[i]; s = shx_sum<2>(s); s = shx_sum<4>(s); s = shx_sum<8>(s); s = shx_sum<16>(s); s = shx_sum<32>(s); x[i] = s; }
        if (F.lane < 2) {
#pragma unroll
            for (int i = 0; i < 32; ++i) part[F.wave * 64 + half * 32 + i] = x[i]; }
    }
    __syncthreads();
    if (F.tid < 64) { float s = 0.f;
#pragma unroll
        for (int w = 0; w < 8; ++w) s += part[w * 64 + F.tid];
        ((float*)(F.ws + WS_KMEAN))[((size_t)(b * 8 + h) * 16 + blk) * 64 + F.tid] = s * (1.f / 256.f); }
    __syncthreads();
}

constexpr int ML_TILE = 128 * 272;
constexpr int ML_Q = 0, ML_K = ML_TILE, ML_VT = 2 * ML_TILE, ML_CT = 3 * ML_TILE, ML_TAB = 4 * ML_TILE;
constexpr int MT_BB = 0, MT_U = 1, MT_M = 2, MT_WST = 3, MT_LIM = 4, MT_N = 5, MT_QN = 6, MT_INV = 7, MT_WS = 8, MT_SC = 9;
static_assert(ML_TAB + 10 * 512 <= MISC_OFF, "mLSTM LDS map");

struct MlGates { float i0, i1, f0, f1; };
__device__ __forceinline__ void ml_gates(const Frame& F, MlGates& g, size_t r0, int h) {
    const float* G = (const float*)(F.ws + WS_GATES); const int l = F.lane;
    g.i0 = G[(r0 + 2 * l) * 8 + h]; g.i1 = G[(r0 + 2 * l + 1) * 8 + h]; g.f0 = G[(r0 + 2 * l) * 8 + 4 + h]; g.f1 = G[(r0 + 2 * l + 1) * 8 + 4 + h];
}
__device__ __forceinline__ void ml_scalars(Frame& F, const MlGates& g, LAS float* tab, float& umax_out, float& blast_out) {
    const int l = F.lane;
    const float i0 = g.i0, i1 = g.i1, f0 = g.f0, f1 = g.f1;
    float ps = f0 + f1, sc = ps;
#pragma unroll
    for (int o = 1; o < 64; o <<= 1) { const float t = bperm(l >= o ? l - o : l, sc); if (l >= o) sc += t; }
    const float ex = sc - ps;
    const float b0 = ex + f0, b1 = ex + ps;
    const float u0 = i0 - b0, u1 = i1 - b1;
    float pm = fmaxf(u0, u1), sm = pm;
#pragma unroll
    for (int o = 1; o < 64; o <<= 1) { const float t = bperm(l >= o ? l - o : l, sm); if (l >= o) sm = fmaxf(sm, t); }
    const float pe = bperm(l >= 1 ? l - 1 : l, sm);
    const float p0 = (l == 0) ? u0 : fmaxf(pe, u0), p1 = fmaxf(p0, u1);
    tab[MT_BB * 128 + 2 * l] = b0; tab[MT_BB * 128 + 2 * l + 1] = b1;
    tab[MT_U * 128 + 2 * l] = u0; tab[MT_U * 128 + 2 * l + 1] = u1;
    tab[MT_M * 128 + 2 * l] = p0; tab[MT_M * 128 + 2 * l + 1] = p1;
    umax_out = __int_as_float(__builtin_amdgcn_readlane(__float_as_int(sm), 63)); blast_out = __int_as_float(__builtin_amdgcn_readlane(__float_as_int(sc), 63));
}
constexpr int ML_CW = ML_TAB + 10 * 512;
static_assert(ML_CW + 5120 <= MISC_OFF, "mLSTM LDS map");
struct MlRaw7 { u32x4 x[7]; };
struct MlRaw4 { u32x4 x[4]; };
__device__ __forceinline__ void ml_load_conv(const Frame& F, MlRaw7& R, size_t r0, int tpos0, int col0) {
    const bf16_t* src = (const bf16_t*)(F.ws + WS_MQK); const int cg = F.tid & 15, rg = F.tid >> 4;
#pragma unroll
    for (int j = 0; j < 7; ++j) { const int rr = 4 * rg - 3 + j;
        R.x[j] = (tpos0 + rr >= 0) ? *(const u32x4*)(src + (size_t)((long)r0 + rr) * 1024 + col0 + cg * 8) : (u32x4){0u, 0u, 0u, 0u}; }
}
__device__ __forceinline__ void ml_load_rows(const Frame& F, MlRaw4& R, const bf16_t* src, size_t r0, int pitch, int col0) {
    const int cg = F.tid & 15, rg = F.tid >> 4;
#pragma unroll
    for (int rr = 0; rr < 4; ++rr) R.x[rr] = *(const u32x4*)(src + (r0 + 4 * rg + rr) * pitch + col0 + cg * 8);
}
__device__ __forceinline__ void ml_store_conv(const Frame& F, const MlRaw7& R, LAS unsigned char* tile, const LAS float* cwt, float scale) {
    const int cg = F.tid & 15, rg = F.tid >> 4;
    float w[5][8];
#pragma unroll
    for (int j = 0; j < 5; ++j) { const f32x4 a = *(const LAS f32x4*)(cwt + j * 128 + cg * 8), b = *(const LAS f32x4*)(cwt + j * 128 + cg * 8 + 4);
        w[j][0] = a.x; w[j][1] = a.y; w[j][2] = a.z; w[j][3] = a.w; w[j][4] = b.x; w[j][5] = b.y; w[j][6] = b.z; w[j][7] = b.w; }
    float x[7][8];
#pragma unroll
    for (int j = 0; j < 7; ++j) { const u32x4 v = R.x[j];
        x[j][0] = bf_lo(v.x); x[j][1] = bf_hi(v.x); x[j][2] = bf_lo(v.y); x[j][3] = bf_hi(v.y); x[j][4] = bf_lo(v.z); x[j][5] = bf_hi(v.z); x[j][6] = bf_lo(v.w); x[j][7] = bf_hi(v.w); }
#pragma unroll
    for (int rr = 0; rr < 4; ++rr) { float y[8];
#pragma unroll
        for (int i = 0; i < 8; i += 2) { f32x2 a;
            a.x = w[4][i] + w[0][i] * x[rr][i] + w[1][i] * x[rr + 1][i] + w[2][i] * x[rr + 2][i] + w[3][i] * x[rr + 3][i];
            a.y = w[4][i + 1] + w[0][i + 1] * x[rr][i + 1] + w[1][i + 1] * x[rr + 1][i + 1] + w[2][i + 1] * x[rr + 2][i + 1] + w[3][i + 1] * x[rr + 3][i + 1];
            f32x2 e = a * (-LOG2E); e.x = __builtin_amdgcn_exp2f(e.x); e.y = __builtin_amdgcn_exp2f(e.y); e = e + 1.0f; e.x = __builtin_amdgcn_rcpf(e.x); e.y = __builtin_amdgcn_rcpf(e.y);
            const f32x2 o2 = (a * scale) * e; y[i] = o2.x; y[i + 1] = o2.y; }
        u32x4 o; o.x = cvt_pk_bf16(y[0], y[1]); o.y = cvt_pk_bf16(y[2], y[3]); o.z = cvt_pk_bf16(y[4], y[5]); o.w = cvt_pk_bf16(y[6], y[7]);
        *(LAS u32x4*)(tile + (4 * rg + rr) * 272 + cg * 16) = o; }
}
__device__ __forceinline__ void ml_store_rows(const Frame& F, const MlRaw4& R, LAS unsigned char* tile, const LAS float* rs) {
    const int cg = F.tid & 15, rg = F.tid >> 4;
#pragma unroll
    for (int rr = 0; rr < 4; ++rr) { const int row = 4 * rg + rr; u32x4 v = R.x[rr];
        if (rs) { const float sc = rs[row];
            v.x = cvt_pk_bf16(bf_lo(v.x) * sc, bf_hi(v.x) * sc); v.y = cvt_pk_bf16(bf_lo(v.y) * sc, bf_hi(v.y) * sc); v.z = cvt_pk_bf16(bf_lo(v.z) * sc, bf_hi(v.z) * sc); v.w = cvt_pk_bf16(bf_lo(v.w) * sc, bf_hi(v.w) * sc); }
        *(LAS u32x4*)(tile + row * 272 + cg * 16) = v; }
}
struct MlCw { float v[3]; };
__device__ __forceinline__ void ml_cw_load(const Frame& F, MlCw& c, const float* cw, const float* cb, int h) {
#pragma unroll
    for (int k = 0; k < 3; ++k) { const int i = F.tid + 512 * k; const int t = i / 640, r = i - t * 640, j = r >> 7, d = r & 127; const int ch = t * 512 + h * 128 + d;
        c.v[k] = (i < 1280) ? ((j < 4) ? cw[j * 1024 + ch] : cb[ch]) : 0.f; }
}
__device__ __forceinline__ void ml_cw_store(const Frame& F, const MlCw& c, LAS float* cwt) {
#pragma unroll
    for (int k = 0; k < 3; ++k) { const int i = F.tid + 512 * k; if (i < 1280) cwt[i] = c.v[k]; }
}
#define SYNC_SB() do { __syncthreads(); __builtin_amdgcn_sched_barrier(0); } while (0)
#define MFMA32(a, b, c) __builtin_amdgcn_mfma_f32_32x32x16_bf16(a, b, c, 0, 0, 0)
typedef short v4i16_ml __attribute__((ext_vector_type(4)));
__device__ __forceinline__ bf16x8 ml_frag_nat(const LAS unsigned char* T, int i0, int k0, int lane) { return *(const LAS bf16x8*)(T + (i0 + (lane & 31)) * 272 + (k0 + 8 * (lane >> 5)) * 2); }
__device__ __forceinline__ bf16x8 ml_frag_tr(const LAS unsigned char* T, int i0, int k0, int lane) {
    const LAS unsigned char* a = T + (k0 + 8 * (lane >> 5) + ((lane & 15) >> 2)) * 272 + (i0 + 16 * ((lane >> 4) & 1) + 4 * (lane & 3)) * 2;
    const s16x4 lo = __builtin_bit_cast(s16x4, __builtin_amdgcn_ds_read_tr16_b64_v4i16((LAS v4i16_ml*)a)), hi = __builtin_bit_cast(s16x4, __builtin_amdgcn_ds_read_tr16_b64_v4i16((LAS v4i16_ml*)(a + 4 * 272)));
    return (bf16x8){lo[0], lo[1], lo[2], lo[3], hi[0], hi[1], hi[2], hi[3]};
}
template <bool TRA, bool TRB>
__device__ __forceinline__ void ml_mma(const LAS unsigned char* TA, const LAS unsigned char* TB, int rb, int cb, int lane, f32x16& c0, f32x16& c1) {
#pragma unroll 2
    for (int k = 0; k < 8; ++k) {
        const bf16x8 a = TRA ? ml_frag_tr(TA, rb, 16 * k, lane) : ml_frag_nat(TA, rb, 16 * k, lane);
        const bf16x8 b0 = TRB ? ml_frag_tr(TB, cb, 16 * k, lane) : ml_frag_nat(TB, cb, 16 * k, lane);
        const bf16x8 b1 = TRB ? ml_frag_tr(TB, cb + 32, 16 * k, lane) : ml_frag_nat(TB, cb + 32, 16 * k, lane);
        c0 = MFMA32(a, b0, c0); c1 = MFMA32(a, b1, c1);
    }
}

__device__ __forceinline__ float ml_dot32(const LAS unsigned char* row, const LAS float* tabv) {
    float s = 0.f;
#pragma unroll 1
    for (int q = 0; q < 4; ++q) { const u32x4 w = *(const LAS u32x4*)(row + q * 16);
        if (tabv) { const f32x4 a = *(const LAS f32x4*)(tabv + q * 8), b = *(const LAS f32x4*)(tabv + q * 8 + 4);
            s += bf_lo(w.x) * a.x + bf_hi(w.x) * a.y + bf_lo(w.y) * a.z + bf_hi(w.y) * a.w + bf_lo(w.z) * b.x + bf_hi(w.z) * b.y + bf_lo(w.w) * b.z + bf_hi(w.w) * b.w; }
        else s += (bf_lo(w.x) + bf_hi(w.x)) + (bf_lo(w.y) + bf_hi(w.y)) + (bf_lo(w.z) + bf_hi(w.z)) + (bf_lo(w.w) + bf_hi(w.w)); }
    return s;
}
struct MlPre1 { MlRaw7 kx; MlRaw4 vx; MlCw cw; MlGates g; };
__device__ __forceinline__ void ml1_issue(const Frame& F, MlPre1& P, int unit, const float* cw, const float* cb) {
    const int c = unit & 31, h = (unit >> 5) & 3, b = unit >> 7; const size_t r0 = (size_t)b * SEQ + c * MCH;
    ml_load_conv(F, P.kx, r0, c * MCH, 512 + h * 128);
    ml_load_rows(F, P.vx, (const bf16_t*)(F.ws + WS_MV), r0, 512, h * 128);
    ml_cw_load(F, P.cw, cw, cb, h); ml_gates(F, P.g, r0, h);
}
__device__ __forceinline__ void mlstm_local_phase(const Frame& F0, int G, const float* cw, const float* cb) {
    MlPre1 P; int unit = F0.vcu;
    if (unit < 1024) ml1_issue(F0, P, unit, cw, cb);
#pragma unroll 1
    for (; unit < 1024; unit += G) {
    Frame F = unit_frame(F0);
    LAS float* tab = (LAS float*)(F.lds + ML_TAB); LAS float* cwt = (LAS float*)(F.lds + ML_CW);
    ml_cw_store(F, P.cw, cwt);
    if (F.wave == 0) { float umax, blast; ml_scalars(F, P.g, tab, umax, blast);
        tab[MT_WS * 128 + 2 * F.lane] = __expf(tab[MT_U * 128 + 2 * F.lane] - umax); tab[MT_WS * 128 + 2 * F.lane + 1] = __expf(tab[MT_U * 128 + 2 * F.lane + 1] - umax);
        if (F.lane == 0) { float* sc = (float*)(F.ws + WS_MSC); sc[unit] = umax; sc[1024 + unit] = blast; } }
    SYNC_SB();
    ml_store_conv(F, P.kx, F.lds + ML_K, cwt + 640, 0.08838834764831845f);
    ml_store_rows(F, P.vx, F.lds + ML_VT, tab + MT_WS * 128);
    SYNC_SB();
    if (unit + G < 1024) ml1_issue(F, P, unit + G, cw, cb);
    __builtin_amdgcn_sched_barrier(0);
    {
        f32x16 c0 = {}, c1 = {}; const int rb = 32 * (F.wave & 3), cbk = 64 * (F.wave >> 2);
        ml_mma<true, true>(F.lds + ML_VT, F.lds + ML_K, rb, cbk, F.lane, c0, c1);
        float* U = (float*)(F.ws + WS_XN) + (size_t)unit * 16384; const int r32 = F.lane & 31, hi = F.lane >> 5;
#pragma unroll
        for (int r = 0; r < 16; ++r) { const int e = rb + crow(r, hi); U[e * 128 + cbk + r32] = c0[r]; U[e * 128 + cbk + 32 + r32] = c1[r]; }
    }
    {
        const int dg = F.tid & 63, part = F.tid >> 6; float s0 = 0.f, s1 = 0.f;
#pragma unroll 4
        for (int i = 0; i < 16; ++i) { const int sr = part * 16 + i; const unsigned w = *(const LAS unsigned*)(F.lds + ML_K + sr * 272 + dg * 4); const float ws = tab[MT_WS * 128 + sr]; s0 += bf_lo(w) * ws; s1 += bf_hi(w) * ws; }
        LAS float* pp = (LAS float*)(F.lds + ML_Q);
        pp[part * 128 + 2 * dg] = s0; pp[part * 128 + 2 * dg + 1] = s1;
        SYNC_SB();
        if (F.tid < 128) { float s = 0.f;
#pragma unroll
            for (int p = 0; p < 8; ++p) s += pp[p * 128 + F.tid];
            ((float*)(F.ws + WS_UN))[(size_t)unit * 128 + F.tid] = s; }
    }
    SYNC_SB();
    }
}
__device__ __forceinline__ void mlstm_scan(const Frame& F0, int bh, int slice) {
    Frame F = unit_frame(F0);
    const float* sc = (const float*)(F.ws + WS_MSC);
    const float* U = (const float*)(F.ws + WS_XN); bf16_t* C = (bf16_t*)(F.ws + WS_CST);
    const int eoff = slice * 2048 + F.tid * 4;
    f32x4 cst = {0.f, 0.f, 0.f, 0.f}; float nst = 0.f; float m = 0.f;
    const bool don = (slice == 0) && (F.tid < 128);
    static_assert(NCH % 8 == 0, "scan batches");
#pragma unroll 1
    for (int c0 = 0; c0 < NCH; c0 += 8) {
        f32x4 u[8]; float un[8], umx[8], bl[8];
#pragma unroll
        for (int i = 0; i < 8; ++i) { const int unit = bh * 32 + c0 + i;
            u[i] = *(const f32x4*)(U + (size_t)unit * 16384 + eoff); umx[i] = sc[unit]; bl[i] = sc[1024 + unit];
            un[i] = don ? ((const float*)(F.ws + WS_UN))[(size_t)unit * 128 + F.tid] : 0.f; }
#pragma unroll
        for (int i = 0; i < 8; ++i) { const int unit = bh * 32 + c0 + i;
            *(u32x2*)(C + (size_t)unit * 16384 + eoff) = (u32x2){cvt_pk_bf16(cst.x, cst.y), cvt_pk_bf16(cst.z, cst.w)};
            if (don) ((float*)(F.ws + WS_NST))[(size_t)unit * 128 + F.tid] = nst;
            if (slice == 0 && F.tid == 0) ((float*)(F.ws + WS_MSC))[2048 + unit] = m;
            const float umax = umx[i], blast = bl[i];
            const float Mx = fmaxf(m, umax); const float dc = __expf(m - Mx), du = __expf(umax - Mx);
            cst = cst * dc + u[i] * du;
            nst = nst * dc + un[i] * du;
            m = blast + Mx; }
    }
}
#if defined(PROBE_A)
#define MLTICK(k) do { if (blockIdx.x == 0 && F.tid == 0) { const unsigned now_ = (unsigned)__builtin_amdgcn_s_memrealtime(); unsigned* g_ = (unsigned*)F.ws + 12400; g_[(k)] += now_ - g_[31]; g_[31] = now_; } } while (0)
#else
#define MLTICK(k) do { } while (0)
#endif
struct MlPre3 { MlRaw7 qx, kx; MlRaw4 vx, cx; MlCw cw; MlGates g; float nst, m; };
__device__ __forceinline__ void ml3_issue(const Frame& F, MlPre3& P, int unit, const float* cw, const float* cb) {
    const int c = unit & 31, h = (unit >> 5) & 3, b = unit >> 7; const size_t r0 = (size_t)b * SEQ + c * MCH;
    ml_load_conv(F, P.qx, r0, c * MCH, h * 128);
    ml_load_conv(F, P.kx, r0, c * MCH, 512 + h * 128);
    ml_load_rows(F, P.vx, (const bf16_t*)(F.ws + WS_MV), r0, 512, h * 128);
    ml_load_rows(F, P.cx, (const bf16_t*)(F.ws + WS_CST) + (size_t)unit * 16384, 0, 128, 0);
    ml_cw_load(F, P.cw, cw, cb, h); ml_gates(F, P.g, r0, h);
    P.m = ((const float*)(F.ws + WS_MSC))[2048 + unit];
    P.nst = ((const float*)(F.ws + WS_NST))[(size_t)unit * 128 + (F.tid & 127)];
}
__device__ __forceinline__ void mlstm_out_phase(const Frame& F0, int G, const float* cw, const float* cb, const float* ng) {
    MlPre3 P; int unit = F0.vcu;
    if (unit < 1024) ml3_issue(F0, P, unit, cw, cb);
#pragma unroll 1
    for (; unit < 1024; unit += G) {
    Frame F = unit_frame(F0);
#if defined(PROBE_A)
    if (blockIdx.x == 0 && F.tid == 0) ((unsigned*)F.ws + 12400)[31] = (unsigned)__builtin_amdgcn_s_memrealtime();
#endif
    const int c = unit & 31, h = (unit >> 5) & 3, b = unit >> 7;
    const size_t r0 = (size_t)b * SEQ + c * MCH;
    LAS float* tab = (LAS float*)(F.lds + ML_TAB); LAS float* cwt = (LAS float*)(F.lds + ML_CW);
    u32x4 mo[4];
    { const u32x4* op = (const u32x4*)((const bf16_t*)(F.ws + WS_MO) + (r0 + (F.tid >> 2)) * 512 + h * 128 + (F.tid & 3) * 32);
#pragma unroll
      for (int i = 0; i < 4; ++i) mo[i] = op[i]; }
    ml_cw_store(F, P.cw, cwt);
    const float m = P.m;
    if (F.wave == 0) { float umax, blast; ml_scalars(F, P.g, tab, umax, blast);
#pragma unroll
        for (int q = 0; q < 2; ++q) { const int t = 2 * F.lane + q; const float Mt = fmaxf(m, tab[MT_M * 128 + t]);
            tab[MT_M * 128 + t] = Mt; tab[MT_WST * 128 + t] = __expf(m - Mt); tab[MT_LIM * 128 + t] = __expf(-tab[MT_BB * 128 + t] - Mt); } }
    if (F.tid >= 128 && F.tid < 256) tab[MT_N * 128 + F.tid - 128] = P.nst;
    SYNC_SB(); MLTICK(0);
    ml_store_conv(F, P.qx, F.lds + ML_Q, cwt, 1.0f);
    __builtin_amdgcn_sched_barrier(0);
    ml_store_conv(F, P.kx, F.lds + ML_K, cwt + 640, 0.08838834764831845f);
    __builtin_amdgcn_sched_barrier(0);
    ml_store_rows(F, P.vx, F.lds + ML_VT, nullptr);
    ml_store_rows(F, P.cx, F.lds + ML_CT, nullptr);
    SYNC_SB(); MLTICK(1);
    if (unit + G < 1024) ml3_issue(F, P, unit + G, cw, cb);
    __builtin_amdgcn_sched_barrier(0);
    const int rb = 32 * (F.wave & 3), cbk = 64 * (F.wave >> 2), r32 = F.lane & 31, hi = F.lane >> 5;
    f32x16 s0 = {}, s1 = {};
    ml_mma<false, false>(F.lds + ML_Q, F.lds + ML_K, rb, cbk, F.lane, s0, s1);
    {
        const float u0 = tab[MT_U * 128 + cbk + r32], u1 = tab[MT_U * 128 + cbk + 32 + r32];
#pragma unroll
        for (int r = 0; r < 16; ++r) { const int t = rb + crow(r, hi); const float Mt = tab[MT_M * 128 + t];
            s0[r] = (cbk + r32 <= t) ? s0[r] * __expf(u0 - Mt) : 0.f; s1[r] = (cbk + 32 + r32 <= t) ? s1[r] * __expf(u1 - Mt) : 0.f; }
    }
    {
        const int t = F.tid >> 2, part = F.tid & 3; float s = ml_dot32(F.lds + ML_Q + t * 272 + part * 64, tab + MT_N * 128 + part * 32);
        s = shx_sum<1>(s); s = shx_sum<2>(s);
        if (part == 0) tab[MT_QN * 128 + t] = s;
    }
    SYNC_SB(); MLTICK(2);
#pragma unroll
    for (int r = 0; r < 16; r += 2) {
        const unsigned pa = cvt_pk_bf16(s0[r], s0[r + 1]), pb = cvt_pk_bf16(s1[r], s1[r + 1]);
        const int t0 = rb + crow(r, hi), t1 = rb + crow(r + 1, hi);
        *(LAS bf16_t*)(F.lds + ML_K + t0 * 272 + (cbk + r32) * 2) = (bf16_t)(pa & 0xffffu); *(LAS bf16_t*)(F.lds + ML_K + t1 * 272 + (cbk + r32) * 2) = (bf16_t)(pa >> 16);
        *(LAS bf16_t*)(F.lds + ML_K + t0 * 272 + (cbk + 32 + r32) * 2) = (bf16_t)(pb & 0xffffu); *(LAS bf16_t*)(F.lds + ML_K + t1 * 272 + (cbk + 32 + r32) * 2) = (bf16_t)(pb >> 16);
    }
    SYNC_SB(); MLTICK(3);
    f32x16 p0 = {}, p1 = {}, q0 = {}, q1 = {};
    ml_mma<false, true>(F.lds + ML_K, F.lds + ML_VT, rb, cbk, F.lane, p0, p1);
    __builtin_amdgcn_sched_barrier(0);
    ml_mma<false, false>(F.lds + ML_Q, F.lds + ML_CT, rb, cbk, F.lane, q0, q1);
    {
        const int t = F.tid >> 2, part = F.tid & 3; float s = ml_dot32(F.lds + ML_K + t * 272 + part * 64, nullptr);
        s = shx_sum<1>(s); s = shx_sum<2>(s);
        if (part == 0) { const float den = s + tab[MT_WST * 128 + t] * tab[MT_QN * 128 + t]; tab[MT_INV * 128 + t] = 1.0f / fmaxf(fabsf(den), tab[MT_LIM * 128 + t]); }
    }
    SYNC_SB(); MLTICK(4);
    LAS float* H = (LAS float*)(F.lds + ML_Q);
#pragma unroll
    for (int r = 0; r < 16; ++r) { const int t = rb + crow(r, hi); const float w = tab[MT_WST * 128 + t], iv = tab[MT_INV * 128 + t];
        H[t * 132 + cbk + r32] = (p0[r] + w * q0[r]) * iv; H[t * 132 + cbk + 32 + r32] = (p1[r] + w * q1[r]) * iv; }
    SYNC_SB(); MLTICK(5);
    {
        const int t = F.tid >> 2, part = F.tid & 3;
        bf16_t* op = (bf16_t*)(F.ws + WS_MO) + (r0 + t) * 512 + h * 128 + part * 32;
        float x[32]; float ss = 0.f;
#pragma unroll
        for (int i = 0; i < 4; ++i) { const u32x4 g = mo[i]; const LAS float* hp = H + t * 132 + part * 32 + 8 * i;
            x[8 * i] = hp[0] * bf_lo(g.x); x[8 * i + 1] = hp[1] * bf_hi(g.x); x[8 * i + 2] = hp[2] * bf_lo(g.y); x[8 * i + 3] = hp[3] * bf_hi(g.y);
            x[8 * i + 4] = hp[4] * bf_lo(g.z); x[8 * i + 5] = hp[5] * bf_hi(g.z); x[8 * i + 6] = hp[6] * bf_lo(g.w); x[8 * i + 7] = hp[7] * bf_hi(g.w); }
#pragma unroll
        for (int i = 0; i < 32; ++i) ss += x[i] * x[i];
        ss = shx_sum<1>(ss); ss = shx_sum<2>(ss);
        const float r = 1.0f / sqrtf(ss * (1.f / 128.f) + EPS);
        const float* gp = ng + h * 128 + part * 32;
#pragma unroll
        for (int i = 0; i < 4; ++i) { u32x4 o; o.x = cvt_pk_bf16(x[8 * i] * r * gp[8 * i], x[8 * i + 1] * r * gp[8 * i + 1]); o.y = cvt_pk_bf16(x[8 * i + 2] * r * gp[8 * i + 2], x[8 * i + 3] * r * gp[8 * i + 3]);
            o.z = cvt_pk_bf16(x[8 * i + 4] * r * gp[8 * i + 4], x[8 * i + 5] * r * gp[8 * i + 5]); o.w = cvt_pk_bf16(x[8 * i + 6] * r * gp[8 * i + 6], x[8 * i + 7] * r * gp[8 * i + 7]); ((u32x4*)op)[i] = o; }
    }
    SYNC_SB(); MLTICK(6);
    }
}

namespace attn {
constexpr int DMP = 512;
constexpr int NW = 8, QBLK = 32, QB = 256, KVBLK = 64;
#define SBAR() __builtin_amdgcn_sched_barrier(0)
constexpr int NSLOT = 3, SLOTB = 8192;
constexpr int LDS_K = 0, LDS_V = NSLOT * SLOTB, LDS_WS = 2 * NSLOT * SLOTB, LDS_OST = LDS_WS + NW * 64 * 4, LDS_END = LDS_OST + NW * 4096;
constexpr int TB_N = 1536, TB_COPY = TB_N * 4, LDS_TB = LDS_END;
constexpr int LDS_KM = LDS_TB + 4 * TB_COPY;
constexpr int LDS_ZERO = LDS_KM + 4096;
constexpr int LDS_ATT_END = LDS_ZERO + 512;
static_assert(LDS_ATT_END <= MISC_OFF, "attention LDS map");
typedef LAS const char* lds_cptr;
typedef short v4i16_t __attribute__((ext_vector_type(4)));
__device__ __forceinline__ void glds16(const void* gsrc, unsigned lds_dst) { unsigned keep;
  asm volatile("s_mov_b32 %0, m0\n\ts_mov_b32 m0, %2\n\ts_nop 0\n\tglobal_load_lds_dwordx4 %1, off\n\ts_mov_b32 m0, %0" : "=&s"(keep) : "v"(gsrc), "s"(lds_dst) : "memory"); }
__device__ __forceinline__ float max3f(float a, float b, float c) { float r; asm("v_max3_f32 %0, %1, %2, %3" : "=v"(r) : "v"(a), "v"(b), "v"(c)); return r; }
__device__ __forceinline__ float max2f(float a, float b) { float r; asm("v_max_f32_e32 %0, %1, %2" : "=v"(r) : "v"(a), "v"(b)); return r; }
__device__ __forceinline__ float fadd_s(float a, float b) { float r; asm("v_add_f32_e32 %0, %1, %2" : "=v"(r) : "v"(a), "v"(b)); return r; }
__device__ __forceinline__ float fsub_s(float a, float b) { float r; asm("v_sub_f32_e32 %0, %1, %2" : "=v"(r) : "v"(a), "v"(b)); return r; }
typedef __bf16 bf16x2_t __attribute__((ext_vector_type(2)));
__device__ __forceinline__ unsigned cvtpk_s(float lo, float hi) { f32x2 v = {lo, hi}; bf16x2_t b = __builtin_convertvector(v, bf16x2_t); return __builtin_bit_cast(unsigned, b); }
#define WAIT_BAR(N) asm volatile("s_waitcnt vmcnt(" #N ") lgkmcnt(0)\n\ts_barrier" ::: "memory")
__device__ __forceinline__ void kload8(bf16x8* kf, lds_cptr kp) {
  kf[0] = *(const LAS bf16x8*)(kp);        kf[1] = *(const LAS bf16x8*)(kp + 512);
  kf[2] = *(const LAS bf16x8*)(kp + 2048); kf[3] = *(const LAS bf16x8*)(kp + 2560);
  kf[4] = *(const LAS bf16x8*)(kp + 4096); kf[5] = *(const LAS bf16x8*)(kp + 4608);
  kf[6] = *(const LAS bf16x8*)(kp + 6144); kf[7] = *(const LAS bf16x8*)(kp + 6656);
}
__device__ __forceinline__ void kload2(bf16x8* kf, lds_cptr kp, int j) { kf[2 * j] = *(const LAS bf16x8*)(kp + j * 2048); kf[2 * j + 1] = *(const LAS bf16x8*)(kp + j * 2048 + 512); }
__device__ __forceinline__ s16x4 vtr(lds_cptr p) { return __builtin_bit_cast(s16x4, __builtin_amdgcn_ds_read_tr16_b64_v4i16((LAS v4i16_t*)p)); }
__device__ __forceinline__ float rowmax(const f32x16& p0, const f32x16& p1) {
  float a = max3f(p0[0], p0[1], p1[0]), b = max3f(p0[2], p0[3], p1[1]); a = max3f(a, p1[2], p1[3]);
#pragma unroll
  for (int r = 4; r < 16; r += 4) { a = max3f(a, p0[r], p0[r + 1]); b = max3f(b, p0[r + 2], p0[r + 3]); a = max3f(a, p1[r], p1[r + 1]); b = max3f(b, p1[r + 2], p1[r + 3]); }
  const float m = max2f(a, b);
  auto rr = __builtin_amdgcn_permlane32_swap(__float_as_uint(m), __float_as_uint(m), false, false);
  return max2f(__uint_as_float(rr[0]), __uint_as_float(rr[1]));
}
__device__ __forceinline__ void pv(f32x16* o, int vb, bf16x8 pa0, bf16x8 pa1, bf16x8 pa2, bf16x8 pa3) {
#pragma unroll
  for (int d0 = 0; d0 < 2; ++d0) { s16x4 lo[4], hi[4];
#pragma unroll
    for (int ks = 0; ks < 4; ++ks) {
      asm volatile("ds_read_b64_tr_b16 %0,%1 offset:%c2" : "=&v"(lo[ks]) : "v"(vb), "i"(d0 * 4096 + ks * 1024) : "memory");
      asm volatile("ds_read_b64_tr_b16 %0,%1 offset:%c2" : "=&v"(hi[ks]) : "v"(vb), "i"(d0 * 4096 + ks * 1024 + 512) : "memory"); }
    asm volatile("s_waitcnt lgkmcnt(0)" ::: "memory"); SBAR();
#define PK(k) (bf16x8){lo[k][0], lo[k][1], lo[k][2], lo[k][3], hi[k][0], hi[k][1], hi[k][2], hi[k][3]}
    o[d0] = MFMA32(pa0, PK(0), o[d0]); o[d0] = MFMA32(pa1, PK(1), o[d0]); o[d0] = MFMA32(pa2, PK(2), o[d0]); o[d0] = MFMA32(pa3, PK(3), o[d0]);
#undef PK
  }
}
template <int THRL> __device__ __forceinline__ void attn_unit(int b, int h, int qb, const bf16_t* Q, const bf16_t* __restrict__ K, const bf16_t* __restrict__ V, bf16_t* O, LAS unsigned char* shm, int wid, int lane, float b31) {
  const int r32 = lane & 31, hi = lane >> 5;
  const long rowbase = (long)b * SEQ; const int q0 = qb * QB;
  const bf16_t* Qw = Q + (rowbase + q0 + wid * QBLK) * DMP + h * ADH;
  const bf16_t* Kh = K + rowbase * DMP + h * ADH; const bf16_t* Vh = V + rowbase * DMP + h * ADH;
  const unsigned lds0 = (unsigned)(uintptr_t)shm;
  LAS float* wsf = (LAS float*)(shm + LDS_WS) + wid * 64;
  const bf16_t* ksrc = Kh + (long)lane * DMP + wid * 8;
  const bf16_t* vsrc = Vh + (long)(16 * (wid & 3) + (lane >> 2)) * DMP + (wid >> 2) * 32 + (lane & 3) * 8;
  const unsigned kdst = lds0 + LDS_K + wid * 1024, vdst = lds0 + LDS_V + wid * 1024;
#define PT(t) (4 * (qb - ((t) >> 2)) + ((t) & 3))
#define DMA_K(t, slot) glds16(ksrc + (long)PT(t) * KVBLK * DMP, (unsigned)__builtin_amdgcn_readfirstlane(kdst + (slot)))
#define DMA_V(t, slot) glds16(vsrc + (long)PT(t) * KVBLK * DMP, (unsigned)__builtin_amdgcn_readfirstlane(vdst + (slot)))
  const int vb0 = (int)(lds0 + LDS_V) + ((lane >> 4) & 1) * 32 + (lane & 3) * 8 + (4 * hi + ((lane & 15) >> 2)) * 64;
  const lds_cptr shm3 = (lds_cptr)shm; const lds_cptr Kbase = shm3 + LDS_K; bf16x8 kf[8];
  const lds_cptr kp0 = shm3 + LDS_K + hi * 1024 + r32 * 16; const lds_cptr vp0 = shm3 + LDS_V + ((lane >> 4) & 1) * 32 + (lane & 3) * 8 + (4 * hi + ((lane & 15) >> 2)) * 64;
  const int NT = 4 * (qb + 1);
  DMA_K(0, 0); DMA_V(0, 0); DMA_K(1, SLOTB);
  bf16x8 qr[4];
#pragma unroll
  for (int d0 = 0; d0 < 4; ++d0) qr[d0] = *reinterpret_cast<const bf16x8*>(&Qw[(long)r32 * DMP + d0 * 16 + hi * 8]);
  DMA_K(2, 2 * SLOTB);
  const int ta = (3 - (r32 & 3)) & 3;
  const lds_cptr tb0 = shm3 + LDS_TB + ta * TB_COPY + 4 * (1279 - 32 * wid - r32 - ta) + 16 * hi;
#define TBP(t) (tb0 - 1024 * ((t) >> 2) + 256 * ((t) & 3))
  const lds_cptr zb_ = shm3 + LDS_ZERO + 16 * hi;
#define BLD(X, sw, p, off) X.sw = *(const LAS f32x4*)((p) + (off))
  f32x16 pA0, pA1, pB0, pB1;
  { const lds_cptr p = TBP(0); BLD(pA0, s0123, p, 0); BLD(pA0, s4567, p, 32); BLD(pA0, s89ab, p, 64); BLD(pA0, scdef, p, 96); BLD(pA1, s0123, p, 128); BLD(pA1, s4567, p, 160); BLD(pA1, s89ab, p, 192); BLD(pA1, scdef, p, 224); }
  unsigned selmask = 0u;
  { float v1 = -INFINITY, v2 = -INFINITY, v3 = -INFINITY; int i1 = -1, i2 = -1, i3 = -1;
    const LAS float* KM = (const LAS float*)(shm + LDS_KM);
#pragma unroll 1
    for (int j = 0; j < qb; ++j) { float s = 0.f;
#pragma unroll
      for (int d0 = 0; d0 < 4; ++d0) { const f32x4 ka = *(const LAS f32x4*)(KM + j * 64 + d0 * 16 + hi * 8), kb = *(const LAS f32x4*)(KM + j * 64 + d0 * 16 + hi * 8 + 4);
        s += bf2f((bf16_t)qr[d0][0]) * ka.x + bf2f((bf16_t)qr[d0][1]) * ka.y + bf2f((bf16_t)qr[d0][2]) * ka.z + bf2f((bf16_t)qr[d0][3]) * ka.w
           + bf2f((bf16_t)qr[d0][4]) * kb.x + bf2f((bf16_t)qr[d0][5]) * kb.y + bf2f((bf16_t)qr[d0][6]) * kb.z + bf2f((bf16_t)qr[d0][7]) * kb.w; }
      s = shx_sum<32>(s);
      if (s > v1) { v3 = v2; i3 = i2; v2 = v1; i2 = i1; v1 = s; i1 = j; } else if (s > v2) { v3 = v2; i3 = i2; v2 = s; i2 = j; } else if (s > v3) { v3 = s; i3 = j; } }
    if (i1 >= 0) selmask |= 1u << i1; if (i2 >= 0) selmask |= 1u << i2; if (i3 >= 0) selmask |= 1u << i3; }
  float mhat = 0.f, l_reg = 0.f; f32x16 o[2]; o[0] = f32x16{}; o[1] = f32x16{};
  float selneg = 0.f, msel = 0.f;
  const bf16x8 kone = (hi == 0) ? (bf16x8){0x3f80, 0x3f80, 0, 0, 0, 0, 0, 0} : (bf16x8){0, 0, 0, 0, 0, 0, 0, 0};
  bf16x8 qx = (bf16x8){0, 0, 0, 0, 0, 0, 0, 0};
#define SETQX() do { const unsigned hb_ = cvtpk_s(msel, 0.f) & 0xffffu; const float hf_ = __uint_as_float(hb_ << 16); const float lf_ = (msel == -INFINITY) ? 0.f : (msel - hf_); \
    const unsigned w_ = (hi == 0) ? (hb_ | (cvtpk_s(lf_, 0.f) << 16)) : 0u; qx = __builtin_bit_cast(bf16x8, (u32x4){w_, 0u, 0u, 0u}); } while (0)
#define BLOCKSEL(t, MODE) do { if ((t) >= 4) selneg = ((selmask >> (qb - ((t) >> 2))) & 1u) ? 0.f : -INFINITY; \
    msel = (MODE) ? (selneg - mhat) : (selneg + (b31 - mhat)); SETQX(); } while (0)
  bool resc = false;
#define RESC() do { if (resc) { asm volatile("s_waitcnt lgkmcnt(0)" ::: "memory"); \
      _Pragma("unroll") for (int d_ = 0; d_ < 2; ++d_) _Pragma("unroll") for (int r = 0; r < 16; ++r) o[d_][r] *= wsf[crow(r, hi)]; } } while (0)
  int sl_prev = 0, sl_cur = 0, sl_next = SLOTB;
#define ROT() do { sl_prev = sl_cur; sl_cur = sl_next; sl_next = (sl_next == (NSLOT - 1) * SLOTB) ? 0 : sl_next + SLOTB; } while (0)
  WAIT_BAR(3);
  { const lds_cptr kb = Kbase + hi * 1024 + r32 * 16;
#pragma unroll
    for (int d0 = 0; d0 < 4; ++d0) { const bf16x8 b0 = *(const LAS bf16x8*)(kb + d0 * 2048), b1 = *(const LAS bf16x8*)(kb + d0 * 2048 + 512); pA0 = MFMA32(b0, qr[d0], pA0); pA1 = MFMA32(b1, qr[d0], pA1); } }
  asm volatile("s_nop 15\n\ts_nop 7" : "+v"(pA0), "+v"(pA1));
  { const float rm = rowmax(pA0, pA1); mhat = fadd_s(mhat, rm);
#pragma unroll
    for (int r = 0; r < 16; ++r) { pA0[r] = fsub_s(pA0[r], rm); pA1[r] = fsub_s(pA1[r], rm); }
    msel = selneg - mhat; SETQX();
#pragma unroll
    for (int r = 0; r < 16; ++r) pA0[r] = __builtin_amdgcn_exp2f(pA0[r]);
#pragma unroll
    for (int r = 0; r < 16; ++r) pA1[r] = __builtin_amdgcn_exp2f(pA1[r]); }
  { const lds_cptr p = TBP(1); BLD(pB0, s0123, p, 0); BLD(pB0, s4567, p, 32); BLD(pB0, s89ab, p, 64); BLD(pB0, scdef, p, 96); BLD(pB1, s0123, p, 128); BLD(pB1, s4567, p, 160); BLD(pB1, s89ab, p, 192); BLD(pB1, scdef, p, 224); }
  WAIT_BAR(0);
  DMA_K(3, 0); DMA_V(1, SLOTB);
  ROT();
  kload8(kf, kp0 + sl_cur);
  WAIT_BAR(2);
  s16x4 vlo[8], vhi[8]; u32x4 pw0, pw1, pw2, pw3;
#define PKW(P, B) cvtpk_s(P[B], P[B + 1])
#define PAF(k) __builtin_bit_cast(bf16x8, pw##k)
#define VFR(i) (bf16x8){vlo[i][0], vlo[i][1], vlo[i][2], vlo[i][3], vhi[i][0], vhi[i][1], vhi[i][2], vhi[i][3]}
#define PIN(x) asm volatile("" : "+v"(x))
#define MX3(a, b, c) __builtin_fmaxf(__builtin_fmaxf((a), (b)), (c))
#define GAPA(MF, A0, A1, A2, A3, W0, W1, PW) do { MF; sacc += A0; sacc += A1; sacc += A2; sacc += A3; PIN(sacc); W0; W1; PIN(PW); SBAR(); } while (0)
#define EX(v) __builtin_amdgcn_exp2f(v)
#define GAPB(MF, X, B, BR) do { MF; X[B] = EX(X[B]); X[B + 1] = EX(X[B + 1]); X[B + 2] = EX(X[B + 2]); X[B + 3] = EX(X[B + 3]); PIN(X); BR; SBAR(); } while (0)
#define VRD(i) do { vlo[i] = vtr(vp_ + (((i) >> 2) * 4096 + ((i) & 3) * 1024)); vhi[i] = vtr(vp_ + (((i) >> 2) * 4096 + ((i) & 3) * 1024 + 512)); } while (0)
#define KRD(G, j) do { if (G) { kload2(kf, kp0 + sl_next, j); SBAR(); } } while (0)
#define NB(X, sw, off) BLD(X, sw, tbn_, off)
#define STEP(C0, C1, P0, P1, t, GK, GV, GL, BS) do { SBAR(); \
    const bool tab_ = ((t) < 20); \
    if (BS) { if ((((t)) & 3) == 0) BLOCKSEL(t, tab_); } \
    C0 = MFMA32(kone, qx, C0); C1 = MFMA32(kone, qx, C1); \
    const lds_cptr vp_ = vp0 + sl_prev; const lds_cptr tbn_ = ((t) + 1 < 20) ? TBP((t) + 1) : zb_; \
    VRD(0); SBAR(); float sacc = (P0[0] + P0[1]); \
    GAPA(C0 = MFMA32(kf[0], qr[0], C0), P0[2], P0[3], P0[4], P0[5],     pw0[0] = PKW(P0, 0), pw0[1] = PKW(P0, 2), pw0); \
    VRD(4); SBAR(); GAPA(C1 = MFMA32(kf[1], qr[0], C1), P0[6], P0[7], P0[8], P0[9],     pw0[2] = PKW(P0, 4), pw0[3] = PKW(P0, 6), pw0); \
    VRD(1); SBAR(); GAPA(C0 = MFMA32(kf[2], qr[1], C0),   P0[10], P0[11], P0[12], P0[13], pw1[0] = PKW(P0, 8), pw1[1] = PKW(P0, 10), pw1); \
    VRD(5); SBAR(); GAPA(C1 = MFMA32(kf[3], qr[1], C1),   P0[14], P0[15], P1[0], P1[1],   pw1[2] = PKW(P0, 12), pw1[3] = PKW(P0, 14), pw1); \
    VRD(2); SBAR(); GAPA(C0 = MFMA32(kf[4], qr[2], C0),   P1[2], P1[3], P1[4], P1[5],     pw2[0] = PKW(P1, 0), pw2[1] = PKW(P1, 2), pw2); \
    VRD(6); SBAR(); GAPA(C1 = MFMA32(kf[5], qr[2], C1),   P1[6], P1[7], P1[8], P1[9],     pw2[2] = PKW(P1, 4), pw2[3] = PKW(P1, 6), pw2); \
    VRD(3); SBAR(); GAPA(C0 = MFMA32(kf[6], qr[3], C0),   P1[10], P1[11], P1[12], P1[13], pw3[0] = PKW(P1, 8), pw3[1] = PKW(P1, 10), pw3); \
    VRD(7); SBAR(); GAPA(C1 = MFMA32(kf[7], qr[3], C1),   P1[14], P1[15], 0.f, 0.f,       pw3[2] = PKW(P1, 12), pw3[3] = PKW(P1, 14), pw3); \
    l_reg += sacc; \
    if (GK) { DMA_K((t) + 3, sl_cur); } if (GV) { DMA_V((t) + 1, sl_next); } \
    { float a = MX3(C0[0], C0[1], C1[0]), b = MX3(C0[2], C0[3], C1[1]); a = MX3(a, C1[2], C1[3]); \
      _Pragma("unroll") for (int r = 4; r < 16; r += 4) { a = MX3(a, C0[r], C0[r + 1]); b = MX3(b, C0[r + 2], C0[r + 3]); a = MX3(a, C1[r], C1[r + 1]); b = MX3(b, C1[r + 2], C1[r + 3]); } \
      float rm = __builtin_fmaxf(a, b); { auto rr = __builtin_amdgcn_permlane32_swap(__float_as_uint(rm), __float_as_uint(rm), false, false); rm = __builtin_fmaxf(__uint_as_float(rr[0]), __uint_as_float(rr[1])); } \
      resc = false; \
      if (__builtin_expect(__any(rm > (float)THRL), 0)) { const float dl = __builtin_fmaxf(rm, 0.f); mhat += dl; \
        _Pragma("unroll") for (int r = 0; r < 16; ++r) { C0[r] -= dl; C1[r] -= dl; } \
        msel -= dl; SETQX(); \
        const float f = __builtin_amdgcn_exp2f(-dl); l_reg *= f; if (hi == 0) wsf[r32] = f; resc = true; } } \
    SBAR(); \
    GAPB(o[0] = MFMA32(PAF(0), VFR(0), o[0]), C0, 0, NB(P0, s0123, 0)); \
    GAPB(o[1] = MFMA32(PAF(0), VFR(4), o[1]), C0, 4, NB(P0, s4567, 32)); \
    KRD(GL, 0); GAPB(o[0] = MFMA32(PAF(1), VFR(1), o[0]), C0, 8, NB(P0, s89ab, 64)); \
    KRD(GL, 1); GAPB(o[1] = MFMA32(PAF(1), VFR(5), o[1]), C0, 12, NB(P0, scdef, 96)); \
    KRD(GL, 2); GAPB(o[0] = MFMA32(PAF(2), VFR(2), o[0]), C1, 0, NB(P1, s0123, 128)); \
    KRD(GL, 3); GAPB(o[1] = MFMA32(PAF(2), VFR(6), o[1]), C1, 4, NB(P1, s4567, 160)); \
    GAPB(o[0] = MFMA32(PAF(3), VFR(3), o[0]), C1, 8, NB(P1, s89ab, 192)); \
    GAPB(o[1] = MFMA32(PAF(3), VFR(7), o[1]), C1, 12, NB(P1, scdef, 224)); \
    } while (0)
#define ENDW(tt) do { if ((tt) + 3 < NT) { WAIT_BAR(2); } else if ((tt) + 2 < NT) { WAIT_BAR(1); } else { WAIT_BAR(0); } } while (0)
  int t = 1;
  for (; t + 5 < NT; t += 2) {
    STEP(pB0, pB1, pA0, pA1, t, true, true, true, 0);     WAIT_BAR(2); RESC(); ROT();
    STEP(pA0, pA1, pB0, pB1, t + 1, true, true, true, 1); WAIT_BAR(2); RESC(); ROT(); }
  for (; t + 1 < NT; t += 2) {
    STEP(pB0, pB1, pA0, pA1, t, (t + 3 < NT), (t + 1 < NT), (t + 1 < NT), 0);     ENDW(t);     RESC(); ROT();
    STEP(pA0, pA1, pB0, pB1, t + 1, (t + 4 < NT), (t + 2 < NT), (t + 2 < NT), 1); ENDW(t + 1); RESC(); ROT(); }
  STEP(pB0, pB1, pA0, pA1, NT - 1, false, false, false, 0); RESC();
  { float sacc = pB0[0] + pB0[1];
#pragma unroll
    for (int r = 2; r < 16; ++r) sacc += pB0[r];
#pragma unroll
    for (int r = 0; r < 16; ++r) sacc += pB1[r];
    l_reg += sacc;
    pw0 = (u32x4){PKW(pB0, 0), PKW(pB0, 2), PKW(pB0, 4), PKW(pB0, 6)}; pw1 = (u32x4){PKW(pB0, 8), PKW(pB0, 10), PKW(pB0, 12), PKW(pB0, 14)}; pw2 = (u32x4){PKW(pB1, 0), PKW(pB1, 2), PKW(pB1, 4), PKW(pB1, 6)}; pw3 = (u32x4){PKW(pB1, 8), PKW(pB1, 10), PKW(pB1, 12), PKW(pB1, 14)};
    SBAR(); pv(o, vb0 + sl_cur, PAF(0), PAF(1), PAF(2), PAF(3)); }
  { auto rr = __builtin_amdgcn_permlane32_swap(__float_as_uint(l_reg), __float_as_uint(l_reg), false, false); l_reg = __uint_as_float(rr[0]) + __uint_as_float(rr[1]); }
  if (hi == 0) wsf[32 + r32] = l_reg; asm volatile("s_waitcnt lgkmcnt(0)" ::: "memory");
  float rli[16];
#pragma unroll
  for (int r = 0; r < 16; ++r) rli[r] = __builtin_amdgcn_rcpf(wsf[32 + crow(r, hi)]);
  bf16_t* Ow = O + (rowbase + q0 + wid * QBLK) * DMP + h * ADH;
  { LAS bf16_t* stg = (LAS bf16_t*)(shm + LDS_OST) + wid * 2048;
#pragma unroll
    for (int r = 0; r < 16; ++r) { const int orow = crow(r, hi);
#pragma unroll
      for (int d0 = 0; d0 < 2; ++d0) stg[orow * 64 + d0 * 32 + r32] = (bf16_t)(cvtpk_s(o[d0][r] * rli[r], 0.f) & 0xffffu); }
    asm volatile("s_waitcnt lgkmcnt(0)" ::: "memory");
#pragma unroll
    for (int i = 0; i < 4; ++i) { const int row = i * 8 + (lane >> 3), ch = lane & 7; const u32x4 v = *(const LAS u32x4*)(stg + row * 64 + ch * 8); *(u32x4*)(Ow + (long)row * DMP + ch * 8) = v; } }
  asm volatile("s_waitcnt lgkmcnt(0)\n\ts_barrier" ::: "memory");
#undef PT
#undef DMA_K
#undef DMA_V
#undef TBP
#undef BLD
#undef BLOCKSEL
#undef SETQX
#undef RESC
#undef ROT
#undef PKW
#undef PAF
#undef VFR
#undef PIN
#undef MX3
#undef GAPA
#undef EX
#undef GAPB
#undef VRD
#undef KRD
#undef NB
#undef STEP
#undef ENDW
}
#undef SBAR
#undef WAIT_BAR
}

__device__ __forceinline__ void moba_tables(const Frame& F, int bh, const float* rel_bias) {
    const int h = bh & 7;
    LAS float* TB = (LAS float*)(F.lds + attn::LDS_TB); LAS float* KM = (LAS float*)(F.lds + attn::LDS_KM);
    for (int i = F.tid; i < 4 * attn::TB_N; i += 512) { const int a = i / attn::TB_N, k = i - a * attn::TB_N; const int d = 1279 - (k + a); float v;
        if (d < 0) v = -INFINITY;
        else { int bk; if (d < 16) bk = d; else bk = 16 + (d >= 21) + (d >= 27) + (d >= 35) + (d >= 46) + (d >= 59) + (d >= 77) + (d >= 99) + (d >= 128) + (d >= 166) + (d >= 216) + (d >= 280) + (d >= 363) + (d >= 470) + (d >= 609) + (d >= 790);
            v = rel_bias[bk * 8 + h] * LOG2E; }
        TB[i] = v; }
    for (int i = F.tid; i < 1024; i += 512) { const float* km = (const float*)(F.ws + WS_KMEAN) + (size_t)bh * 1024 + i; KM[i] = (km[0] + km[65536]) * (1.f / 256.f); }
    if (F.tid < 128) ((LAS float*)(F.lds + attn::LDS_ZERO))[F.tid] = 0.f;
    __syncthreads();
}

__global__ void __launch_bounds__(512, 2) hybrid_fwd(Args args) {
    extern __shared__ __attribute__((aligned(16))) unsigned char lds[];
    Frame F;
    F.lds = (LAS unsigned char*)lds; F.ws = AWS();
    F.wave = __builtin_amdgcn_readfirstlane((int)threadIdx.x >> 6); F.lane = fresh_lane(); F.tid = F.wave * 64 + F.lane;
    F.G = gridDim.x; { const int bx = blockIdx.x; F.vcu = (F.G % 8 == 0) ? (bx % 8) * (F.G / 8) + bx / 8 : bx; }
    volatile LAS unsigned* MISC = (volatile LAS unsigned*)(F.lds + MISC_OFF);
    if (F.tid < 64) MISC[F.tid] = 0u;
    __syncthreads();
    XcdBarrier bar = xcd_barrier_post(((unsigned*)F.ws + CW_BAR), MISC + 8, F.tid);
#define RELOAD() do { int l_ = fresh_lane(); int w_ = F.wave; asm volatile("" : "+s"(w_)); F.wave = w_; F.lane = l_; F.tid = w_ * 64 + l_; \
        int g_ = gridDim.x, b_ = blockIdx.x; asm volatile("" : "+s"(g_), "+s"(b_)); F.G = g_; F.vcu = (g_ % 8 == 0) ? (b_ % 8) * (g_ / 8) + b_ / 8 : b_; F.ws = AWS(); ws = F.ws; G = g_; bx = b_; } while (0)
#if defined(PROBE_A)
#define STAMP(slot) do { if (blockIdx.x == 0 && F.tid == 0) { const unsigned long long now_ = __builtin_amdgcn_s_memrealtime(); const unsigned long long prev_ = ((unsigned long long)MISC[33] << 32) | MISC[32]; \
        MISC[34 + (slot)] += (unsigned)(now_ - prev_); MISC[32] = (unsigned)now_; MISC[33] = (unsigned)(now_ >> 32); } } while (0)
#else
#define STAMP(slot) do { } while (0)
#endif
#if defined(PROBE_A)
#define WGT0() const unsigned long long wgt0_ = __builtin_amdgcn_s_memrealtime()
#define WGT1(ph) do { if (F.tid == 0) { const unsigned d_ = (unsigned)(__builtin_amdgcn_s_memrealtime() - wgt0_); unsigned* g_ = (unsigned*)F.ws + 12000; \
        atomicMax(g_ + 4 * (ph) + 3, d_); atomicMin(g_ + 200 + (ph), d_ ^ 0u); atomicMax(g_ + 300 + 16 * (ph) + (int)xb_xcc_id(), d_); } } while (0)
#define SNAP(ph) do { if (blockIdx.x == 0 && F.tid == 0) { unsigned* g_ = (unsigned*)F.ws + 12000 + 4 * (ph); g_[0] += MISC[54]; g_[1] += MISC[55]; g_[2] += MISC[56]; MISC[54] = 0u; MISC[55] = 0u; MISC[56] = 0u; } } while (0)
#else
#define SNAP(ph) do { } while (0)
#define WGT0() do { } while (0)
#define WGT1(ph) do { } while (0)
#endif
#define GRID_BARS(slot) do { xcd_barrier(bar, F.tid); STAMP(slot); RELOAD(); } while (0)
#define GRID_BAR() GRID_BARS(15)
    unsigned char* ws = F.ws;
    int G = F.G, bx = (int)blockIdx.x;

#if defined(PROBE_A) && defined(MB_KIND)
    if (blockIdx.x == 0) {
        typedef int v8i_ __attribute__((ext_vector_type(8)));
        v8i_ a_ = {0x38383838, 0x38383838, 0x38383838, 0x38383838, 0x38383838, 0x38383838, 0x38383838, 0x38383838}, b_ = a_; asm volatile("" : "+v"(a_), "+v"(b_));
        bf16x8 ha_ = {0x3f80, 0x3f80, 0x3f80, 0x3f80, 0x3f80, 0x3f80, 0x3f80, 0x3f80}, hb_ = ha_; asm volatile("" : "+v"(ha_), "+v"(hb_));
        f32x4 c_[8]; f32x16 d_[4];
#pragma unroll
        for (int i = 0; i < 8; ++i) c_[i] = (f32x4){0.f, 0.f, 0.f, 0.f};
#pragma unroll
        for (int i = 0; i < 4; ++i) d_[i] = f32x16{};
        __syncthreads();
        const unsigned long long t0_ = __builtin_amdgcn_s_memrealtime();
        if (F.wave < MB_WAVES) {
#pragma unroll 1
            for (int it = 0; it < 2000; ++it) {
#if MB_KIND == 0
#pragma unroll
                for (int i = 0; i < 8; ++i) asm volatile("v_mfma_f32_16x16x128_f8f6f4 %0, %1, %2, %0" : "+v"(c_[i]) : "v"(a_), "v"(b_));
#elif MB_KIND == 1
#pragma unroll
                for (int i = 0; i < 8; ++i) asm volatile("v_mfma_f32_16x16x32_bf16 %0, %1, %2, %0" : "+v"(c_[i]) : "v"(ha_), "v"(hb_));
#elif MB_KIND == 2
#pragma unroll
                for (int i = 0; i < 4; ++i) asm volatile("v_mfma_f32_32x32x64_f8f6f4 %0, %1, %2, %0" : "+v"(d_[i]) : "v"(a_), "v"(b_));
#pragma unroll
                for (int i = 0; i < 4; ++i) asm volatile("v_mfma_f32_32x32x64_f8f6f4 %0, %1, %2, %0" : "+v"(d_[i]) : "v"(a_), "v"(b_));
#endif
            }
        }
#pragma unroll
        for (int i = 0; i < 8; ++i) asm volatile("" :: "v"(c_[i]));
#pragma unroll
        for (int i = 0; i < 4; ++i) asm volatile("" :: "v"(d_[i]));
        const unsigned long long t1_ = __builtin_amdgcn_s_memrealtime();
        if (F.tid == 0) MISC[34 + 26] = (unsigned)(t1_ - t0_);
        __syncthreads();
    }
#endif
#if defined(PROBE_A)
    if (blockIdx.x == 0 && F.tid == 0) { const unsigned long long now_ = __builtin_amdgcn_s_memrealtime(); MISC[32] = (unsigned)now_; MISC[33] = (unsigned)(now_ >> 32); }
#endif
    p0_convert(F);
    __syncthreads();
    STAMP(17);

#pragma unroll 1
    for (int layer = 0; layer < 2; ++layer) {
        RELOAD();
        bf16_t* X = (bf16_t*)((unsigned char*)AOUT() + XB_OFF); const void* xin = (layer == 0) ? (const void*)AIN(0) : (const void*)X; const bool xbf = layer != 0;
        norm_pass<0>(F, xin, xbf, AIN(2) + layer * DM, AIN(3) + (size_t)layer * DM * INW + 2048, INW, AIN(6) + layer * 4, AIN(7) + layer * 4);
        GRID_BARS(0);
#if IN8 == 1
        { pg8::StaticOrder S; S.init(ws + WS_XN8IN, ws + 541 * MiB + (size_t)layer * NIN * DM, MTOK, NIN, DM, G, bx, F.tid, F.lds);
          pg8::EpiIn E{ws, 1.0f / 64.0f, 0, AIN(9) + layer * 64, AIN(10) + layer * 64}; pg8::gemm_phase<pg8::EpiIn, pg8::StaticOrder, true, true, 121>(F.lds, DM, S, E, F.wave); }
#elif IN8 == 2
        { pg8::StaticOrder S; S.init(ws + WS_XN, ws + WS_WIN + (size_t)layer * NIN * DM * 2, MTOK, 2048, 2 * DM, G, bx, F.tid, F.lds);
          pg8::EpiIn E{ws, 1.0f, 0, AIN(9) + layer * 64, AIN(10) + layer * 64}; pg8::gemm_phase<pg8::EpiIn, pg8::StaticOrder, true>(F.lds, 2 * DM, S, E, F.wave); }
        { pg8::StaticOrder S; S.init(ws + WS_XN8IN, ws + 541 * MiB + (size_t)layer * NIN * DM + (size_t)2048 * DM, MTOK, NIN - 2048, DM, G, bx, F.tid, F.lds);
          pg8::EpiIn E{ws, 1.0f / 64.0f, 8, AIN(9) + layer * 64, AIN(10) + layer * 64}; pg8::gemm_phase<pg8::EpiIn, pg8::StaticOrder, true, true, 121>(F.lds, DM, S, E, F.wave); }
#else
        { pg8::StaticOrder S; S.init(ws + WS_XN, ws + WS_WIN + (size_t)layer * NIN * DM * 2, MTOK, NIN, 2 * DM, G, bx, F.tid, F.lds);
          pg8::EpiIn E{ws, 1.0f, 0, AIN(9) + layer * 64, AIN(10) + layer * 64}; pg8::gemm_phase<pg8::EpiIn, pg8::StaticOrder, true>(F.lds, 2 * DM, S, E, F.wave); }
#endif
        SNAP(0);
        GRID_BARS(1);
#if !defined(NO_MIX)
        mlstm_local_phase(F, G, AIN(4) + layer * 4096, AIN(5) + layer * 1024);
        GRID_BARS(2);
        for (int it = F.vcu; it < 256; it += G) mlstm_scan(F, it >> 3, it & 7);
        GRID_BARS(3);
#pragma unroll 1
        for (int ph = 0; ph < 2; ++ph) {
            RELOAD();
            if (((ph ^ F.vcu) & 1) == 0) {
                mlstm_out_phase(F, G, AIN(4) + layer * 4096, AIN(5) + layer * 1024, AIN(8) + layer * 512);
            } else {
                for (int v = F.vcu; v < 256; v += G) { const int bh = v >> 2, s = v & 3;
                    moba_tables(F, bh, AIN(1));
                    const float b31 = AIN(1)[31 * 8 + (bh & 7)] * LOG2E;
#pragma unroll 1
                    for (int i = 0; i < 4; ++i) { const int qb = (i == 0) ? s : (i == 1) ? 7 - s : (i == 2) ? 8 + s : 15 - s;
                        Frame f = unit_frame(F);
                        attn::attn_unit<8>(bh >> 3, bh & 7, qb, (const bf16_t*)(f.ws + WS_AQ), (const bf16_t*)(f.ws + WS_AK), (const bf16_t*)(f.ws + WS_AV), (bf16_t*)(f.ws + WS_AQ), f.lds, f.wave, f.lane, b31); }
                    __syncthreads(); }
            }
            __syncthreads();
        }
        GRID_BARS(4);
#endif
        { pg8::MergeOrder S; S.so.init(ws + WS_MO, ws + WS_WA + (size_t)layer * DM * 512 * 2, MTOK, DM, 1024, G, bx, F.tid, F.lds); S.A1 = (const char*)(ws + WS_AQ); S.B1 = (const char*)(ws + WS_WB + (size_t)layer * DM * 512 * 2);
          pg8::EpiMerge E{(bf16_t*)(ws + WS_Y), (const bf16_t*)(ws + WS_GAB), (OUT8 == 1 || (OUT8 == 2 && layer == 1)) ? ws + WS_Y8 : nullptr}; pg8::gemm_phase<pg8::EpiMerge, pg8::MergeOrder, AEPI_LD>(F.lds, 1024, S, E, F.wave); }
        GRID_BARS(5);
#if OUT8
        if (OUT8 == 2 && layer == 0) { pg8::StaticOrder S; S.init(ws + WS_Y, ws + WS_WOUT + (size_t)layer * DM * DM * 2, MTOK, DM, 2 * DM, G, bx, F.tid, F.lds);
          pg8::EpiResid E{xin, X, 1.0f, xbf}; pg8::gemm_phase<pg8::EpiResid, pg8::StaticOrder, true>(F.lds, 2 * DM, S, E, F.wave); }
        else
        { WGT0(); pg8::StaticOrder S; S.init(ws + WS_Y8, ws + WS_WOUT8 + (size_t)layer * DM * DM, MTOK, DM, DM, G, bx, F.tid, F.lds);
          pg8::EpiResid E{xin, X, 1.0f / 1024.0f, xbf}; pg8::gemm_phase<pg8::EpiResid, pg8::StaticOrder, true, true, 121>(F.lds, DM, S, E, F.wave); WGT1(3); }
#else
        { WGT0(); pg8::StaticOrder S; S.init(ws + WS_Y, ws + WS_WOUT + (size_t)layer * DM * DM * 2, MTOK, DM, 2 * DM, G, bx, F.tid, F.lds);
          pg8::EpiResid E{xin, X, 1.0f, xbf}; pg8::gemm_phase<pg8::EpiResid, pg8::StaticOrder, AEPI_LD>(F.lds, 2 * DM, S, E, F.wave); WGT1(3); }
#endif
        SNAP(3);
        GRID_BARS(6);
        if (layer == 0) {
            norm_pass<(DUP8 ? 3 : 1)>(F, X, true, AIN(14), nullptr, 0, nullptr, nullptr);
            GRID_BARS(7);
#if DUP8
            { pg8::StaticOrder S; S.init(ws + WS_XN8, ws + WS_WGU, MTOK, 2 * DFF, DM, G, bx, F.tid, F.lds);
              pg8::EpiSwiGLU<false, (DDN8 != 0)> E{(void*)(ws + WS_ACT), DFF, 1.0f / 64.0f}; pg8::gemm_phase<pg8::EpiSwiGLU<false, (DDN8 != 0)>, pg8::StaticOrder, true, true, 121>(F.lds, DM, S, E, F.wave); }
#else
            { pg8::StaticOrder S; S.init(ws + WS_XN, ws + WS_WGU, MTOK, 2 * DFF, 2 * DM, G, bx, F.tid, F.lds);
              pg8::EpiSwiGLU<false, (DDN8 != 0)> E{(void*)(ws + WS_ACT), DFF, 1.0f}; pg8::gemm_phase<pg8::EpiSwiGLU<false, (DDN8 != 0)>, pg8::StaticOrder, true>(F.lds, 2 * DM, S, E, F.wave); }
#endif
            GRID_BARS(8);
#if DDN8
            { pg8::StaticOrder S; S.init(ws + WS_ACT, ws + WS_WD, MTOK, DM, DFF, G, bx, F.tid, F.lds);
              pg8::EpiResid E{X, X, 1.0f / 128.0f, true}; pg8::gemm_phase<pg8::EpiResid, pg8::StaticOrder, true, true, 120>(F.lds, DFF, S, E, F.wave); }
#else
            { pg8::StaticOrder S; S.init(ws + WS_ACT, ws + WS_WD, MTOK, DM, 2 * DFF, G, bx, F.tid, F.lds);
              pg8::EpiResid E{X, X, 1.0f, true}; pg8::gemm_phase<pg8::EpiResid, pg8::StaticOrder, AEPI_LD>(F.lds, 2 * DFF, S, E, F.wave); }
#endif
            GRID_BARS(9);
        } else {
#if !defined(NO_MOE)
            norm_pass<2>(F, X, true, AIN(14) + DM, AIN(18), 8, nullptr, nullptr);
            STAMP(18);
            p_convert_experts(F);
            GRID_BARS(10);
            moe_place(F);
            GRID_BARS(15);
            {
                const int* idx = (const int*)(ws + WS_MIDX); const float* wgt = (const float*)(ws + WS_MWGT); const unsigned* cnt = (const unsigned*)(ws + WS_CTL) + CW_MOE;
#if defined(PROBE_A)
                if (blockIdx.x == 0 && F.tid == 0) { MISC[54] = 0u; MISC[55] = 0u; MISC[56] = 0u; }
#endif
                { pg8::MoeOrder<true> S; S.init(ws + WS_XN8S, ws + WS_WGUE, DM, idx, cnt, EFF / 128, G, bx, 0, 16, F.tid, F.lds);
                  pg8::EpiSwiGLU<true, true> E{(void*)(ws + WS_EACT), EFF, 1.0f / 64.0f}; pg8::gemm_phase<pg8::EpiSwiGLU<true, true>, pg8::MoeOrder<true>, true, true, 121>(F.lds, DM, S, E, F.wave); }
#if defined(PROBE_A)
                if (blockIdx.x == 0 && F.tid == 0) { MISC[57] = MISC[54]; MISC[58] = MISC[55]; MISC[59] = MISC[56]; }
#endif
                GRID_BARS(11);
#if defined(PROBE_A) && defined(FAKE_UP)
                if (blockIdx.x == 0 && F.tid == 0) { MISC[54] = 0u; MISC[55] = 0u; MISC[56] = 0u; }
                { pg8::MoeOrder<true> S; S.init(ws + WS_XN8, ws + WS_WGUE, DM, idx, cnt, EFF / 128, G, bx, 0, 16, F.tid, F.lds); S.fake = 1;
                  pg8::EpiSwiGLU<true, true> E{(void*)(ws + 244 * MiB), EFF, 1.0f / 64.0f}; pg8::gemm_phase<pg8::EpiSwiGLU<true, true>, pg8::MoeOrder<true>, true, true, 121>(F.lds, DM, S, E, F.wave); }
                if (blockIdx.x == 0 && F.tid == 0) { MISC[61] = MISC[54]; MISC[62] = MISC[55]; MISC[63] = MISC[56]; }
                GRID_BARS(15);
                idx = (const int*)(ws + WS_MIDX); wgt = (const float*)(ws + WS_MWGT); cnt = (const unsigned*)(ws + WS_CTL) + CW_MOE;
#endif
                idx = (const int*)(ws + WS_MIDX); wgt = (const float*)(ws + WS_MWGT); cnt = (const unsigned*)(ws + WS_CTL) + CW_MOE;
#pragma unroll 1
                for (int md = 1; md <= 2; ++md) { RELOAD(); idx = (const int*)(ws + WS_MIDX); cnt = (const unsigned*)(ws + WS_CTL) + CW_MOE;
                  const bool split = (G % 8 == 0);
                  if (!split && md == 2) break;
                  pg8::MoeOrder<false> S; S.mode = split ? md : 0; S.khalf = EFF / 2; S.init(ws + WS_EACT, ws + WS_WDE, EFF, idx, cnt, 4, G, bx, 0, 16, F.tid, F.lds);
                  pg8::EpiMoeStore E{(bf16_t*)(ws + WS_YP), 1.0f / 128.0f, (bf16_t*)(ws + WS_YP2)}; pg8::gemm_phase<pg8::EpiMoeStore, pg8::MoeOrder<false>, true, true, 120>(F.lds, EFF, S, E, F.wave, (split && md == 2) ? EFF / 256 : 0); }
                SNAP(7);
                GRID_BARS(12);
                moe_combine(F, AOUT());
            }
#endif
        }
    }
#if defined(EXTRA_BARS)
#pragma unroll 1
    for (int eb_ = 0; eb_ < EXTRA_BARS; ++eb_) { GRID_BAR(); }
#endif
#if defined(PROBE_A)
    STAMP(14);
    if (blockIdx.x == 0 && F.tid == 0) { unsigned a_ = MISC[34 + PROBE_A] / 1000u, b_ = (PROBE_B >= 500 ? (((unsigned*)F.ws + 12400)[((PROBE_B - 500) >> 4) & 15] + ((((PROBE_B - 500) & 15) == 15) ? 0u : ((unsigned*)F.ws + 12400)[(PROBE_B - 500) & 15])) : PROBE_B >= 100 ? ((unsigned*)F.ws + 12000)[PROBE_B - 100] : MISC[34 + (PROBE_B < 100 ? PROBE_B : 0)]) / 1000u; a_ = a_ > 127u ? 127u : a_; b_ = b_ > 127u ? 127u : b_;
        const unsigned long long t0_ = __builtin_amdgcn_s_memrealtime(), dl_ = (unsigned long long)(a_ + 128u * b_) * 1000ull;
        while (__builtin_amdgcn_s_memrealtime() - t0_ < dl_) __builtin_amdgcn_s_sleep(32); }
#endif
}

extern "C" void kernel_launch(void* const* d_in, const int* in_sizes, int n_in, void* d_out, int out_size, void* d_ws, size_t ws_size, hipStream_t stream) {
    static int grid = 0;
    if (grid == 0) {
        if (n_in != 22 || out_size != MTOK * DM || ws_size < WS_END) { fprintf(stderr, "kernel_launch: unexpected shapes (n_in %d, out %d, ws %zu)\n", n_in, out_size, ws_size); grid = -1; return; }
        int dev = 0, cus = 0, per_cu = 0;
        if (hipGetDevice(&dev) != hipSuccess || hipDeviceGetAttribute(&cus, hipDeviceAttributeMultiprocessorCount, dev) != hipSuccess) { grid = -1; return; }
        if (hipFuncSetAttribute((const void*)hybrid_fwd, hipFuncAttributeMaxDynamicSharedMemorySize, LDS_BYTES) != hipSuccess) { fprintf(stderr, "kernel_launch: hipFuncSetAttribute failed\n"); grid = -1; return; }
        if (hipOccupancyMaxActiveBlocksPerMultiprocessor(&per_cu, (const void*)hybrid_fwd, 512, LDS_BYTES) != hipSuccess || per_cu < 1) fprintf(stderr, "kernel_launch: occupancy query reports %d\n", per_cu);
        (void)hipGetLastError();
        grid = cus;
    }
    if (grid < 0) return;
    if (hipMemsetAsync((char*)d_ws + WS_CTL, 0, CTL_ZERO_BYTES, stream) != hipSuccess) return;
    Args a{};
    for (int i = 0; i < 22; ++i) a.in[i] = (const float*)d_in[i];
    a.out = (float*)d_out; a.ws = (unsigned char*)d_ws;
    hipLaunchKernelGGL(hybrid_fwd, dim3(grid), dim3(512), LDS_BYTES, stream, a);
}
```

```cpp
#include <hip/hip_runtime.h>
#ifndef OUT8
#define OUT8 0
#endif
#ifndef DUP8
#define DUP8 1
#endif
#ifndef DDN8
#define DDN8 1
#endif
#ifndef AEPI_LD
#define AEPI_LD true
#endif
#ifndef IN8
#define IN8 2
#endif
#include <cstdio>
#include <cstdint>

#define LAS __attribute__((address_space(3)))
#define GAS __attribute__((address_space(1)))
typedef unsigned short bf16_t;
typedef short bf16x8 __attribute__((ext_vector_type(8)));
typedef short s16x4 __attribute__((ext_vector_type(4)));
typedef float f32x2 __attribute__((ext_vector_type(2)));
typedef float f32x4 __attribute__((ext_vector_type(4)));
typedef float f32x16 __attribute__((ext_vector_type(16)));
typedef unsigned u32x4 __attribute__((ext_vector_type(4)));
typedef unsigned u32x2 __attribute__((ext_vector_type(2)));
typedef GAS unsigned gu32;

constexpr int NBATCH = 8, SEQ = 4096, DM = 1024, MTOK = NBATCH * SEQ;
constexpr int INW = 5640, NIN = 5632;
constexpr int MH = 4, MDH = 128, MCH = 128, NCH = SEQ / MCH;
constexpr int AH = 8, ADH = 64, ABLK = 256, NAB = SEQ / ABLK;
constexpr int DFF = 2816, NEXP = 8, EFF = 3584;
constexpr float EPS = 1e-6f;
constexpr float LOG2E = 1.4426950408889634f;
constexpr float QSCALE = 0.125f * LOG2E;

constexpr size_t MiB = 1u << 20;
constexpr size_t WS_CTL = 0, CTL_ZERO_BYTES = 1 * MiB;
constexpr size_t WS_GATES = 1 * MiB;
constexpr size_t WS_KMEAN = 2 * MiB;
constexpr size_t WS_MSC = 2 * MiB + 512 * 1024;
constexpr size_t WS_UN = 3 * MiB;
constexpr size_t WS_NST = 3 * MiB + 512 * 1024;
constexpr size_t WS_MIDX = 4 * MiB;
constexpr size_t WS_MWGT = 6 * MiB;
constexpr size_t WS_WIN = 12 * MiB;
constexpr size_t WS_WA = 34 * MiB;
constexpr size_t WS_WB = 36 * MiB;
constexpr size_t WS_WOUT = 38 * MiB;
constexpr size_t WS_WGU = 42 * MiB;
constexpr size_t WS_WD = 53 * MiB;
constexpr size_t WS_XN = 60 * MiB;
constexpr size_t WS_MQK = 124 * MiB;
constexpr size_t WS_MV = 188 * MiB;
constexpr size_t WS_MO = 220 * MiB, WS_AQ = 252 * MiB, WS_AK = 284 * MiB, WS_AV = 316 * MiB;
constexpr size_t WS_GAB = 348 * MiB;
constexpr size_t WS_CST = 476 * MiB;
constexpr size_t WS_Y = 476 * MiB;
constexpr size_t WS_ACT = 124 * MiB;
constexpr size_t WS_XN8 = WS_XN;
constexpr size_t WS_XN8S = 92 * MiB;
constexpr size_t WS_WGUE = 160 * MiB;
constexpr size_t WS_WDE = 482 * MiB;
constexpr size_t WS_YP = 92 * MiB;
constexpr size_t WS_YP2 = 228 * MiB;
constexpr size_t WS_EACT = 244 * MiB;
constexpr size_t WS_XN8IN = 476 * MiB;
constexpr size_t WS_RINFO = 8 * MiB;
constexpr int XBP = 2 * DM;
__device__ __forceinline__ int xb_col(int col) { return (col & 63) + 128 * (col >> 6); }
constexpr size_t WS_Y8 = WS_XN;
constexpr size_t WS_WOUT8 = 553 * MiB;
constexpr size_t WS_END = 555 * MiB;
constexpr int CW_BAR = 4096;
constexpr int CW_MOE = 8192;

constexpr int LDS_BYTES = 163840;
constexpr int LDS_UNITS = LDS_BYTES - 2560;
constexpr int MISC_OFF = LDS_BYTES - 256;

__device__ __forceinline__ unsigned cvt_pk_bf16(float lo, float hi) { unsigned r; asm volatile("v_cvt_pk_bf16_f32 %0, %1, %2" : "=v"(r) : "v"(lo), "v"(hi)); return r; }
__device__ __forceinline__ float clamp_e4m3(float x) { return __builtin_amdgcn_fmed3f(x, -448.0f, 448.0f); }
__device__ __forceinline__ unsigned cvt_pk4_fp8(float a, float b, float c, float d) { int w = __builtin_amdgcn_cvt_pk_fp8_f32(clamp_e4m3(a), clamp_e4m3(b), 0, false); w = __builtin_amdgcn_cvt_pk_fp8_f32(clamp_e4m3(c), clamp_e4m3(d), w, true); return (unsigned)w; }
__device__ __forceinline__ float bf_lo(unsigned w) { return __uint_as_float(w << 16); }
__device__ __forceinline__ float bf_hi(unsigned w) { return __uint_as_float(w & 0xffff0000u); }
__device__ __forceinline__ float bf2f(bf16_t b) { return __uint_as_float((unsigned)b << 16); }
__device__ __forceinline__ float sigmoidf_(float x) { return __builtin_amdgcn_rcpf(1.0f + __builtin_amdgcn_exp2f(-x * LOG2E)); }
__device__ __forceinline__ int fresh_lane() { unsigned m = ~0u; asm volatile("" : "+s"(m)); return (int)__builtin_amdgcn_mbcnt_hi(m, __builtin_amdgcn_mbcnt_lo(m, 0u)); }
__device__ __forceinline__ int crow(int r, int hi) { return (r & 3) + 8 * (r >> 2) + 4 * hi; }
#define LDS_WAIT() asm volatile("s_waitcnt lgkmcnt(0)" ::: "memory")
#define VM_WAIT() asm volatile("s_waitcnt vmcnt(0)" ::: "memory")

template <int CTRL> __device__ __forceinline__ float dppf(float v) { return __int_as_float(__builtin_amdgcn_update_dpp(0, __float_as_int(v), CTRL, 0xf, 0xf, true)); }
template <int O> __device__ __forceinline__ float shx_sum(float v);
namespace pg8 {
constexpr int BM = 256, BK = 64, HALF = 128, HTB = HALF * BK * 2, STAGE_BYTES = 8 * HTB, NXCD = 8, WGM = 8;
__host__ __device__ __forceinline__ int lds_byte(int r, int c) { const int st = (r >> 4) * 2 + (c >> 5), rr = r & 15, cc = c & 31, ob = rr * 64 + cc * 2; return st * 1024 + (ob ^ (((ob >> 9) & 1) << 5)); }
__host__ __device__ __forceinline__ void stage_rc(int b, int& R, int& C) { const int st = b / 1024, sb = b % 1024, swz = sb ^ (((sb >> 9) & 1) << 5); R = (st >> 1) * 16 + swz / 64; C = (st & 1) * 32 + (swz % 64) / 2; }
__host__ __device__ __forceinline__ int perm32(int rho) { const int n = rho >> 4, i = rho & 15; return 8 * (i >> 2) + 4 * n + (i & 3); }

struct Unit { int pm, pn, e, lp; };

struct StaticOrder {
    static constexpr bool GATHER = false;
    const char* A; const char* Bt; size_t tstep;
    int nM, nN, nwg, G, c; LAS int* tbl; int wgm = WGM;
    __device__ __forceinline__ void init(const void* A_, const void* Bt_, int M, int N, int Kb, int G_, int c_, int tid, LAS unsigned char* ldsb) { A = (const char*)A_; Bt = (const char*)Bt_; tstep = (size_t)BM * Kb; nM = M / BM; nN = N / BM; nwg = nM * nN; G = G_; c = c_;
        tbl = (LAS int*)(ldsb + LDS_UNITS);
        if (tid < 64) { Unit u; u.pm = 0; u.pn = 0; u.e = 0; u.lp = 0; const bool ok = compute(tid, u); tbl[2 * tid] = ok ? u.pm : -1; tbl[2 * tid + 1] = u.pn; }
        __syncthreads();
    }
    __device__ __forceinline__ bool next(int i, Unit& u) const {
        if (i >= 64) return false;
        const int pm = __builtin_amdgcn_readfirstlane(tbl[2 * i]); if (pm < 0) return false;
        u.pm = pm; u.pn = __builtin_amdgcn_readfirstlane(tbl[2 * i + 1]); u.e = 0; u.lp = 0; return true;
    }
    __device__ __forceinline__ bool compute(int i, Unit& u) const {
        const long L = (long)i * G + c; if (L >= nwg) return false;
        int wgid = (int)L; { const int q = nwg / NXCD, r = nwg % NXCD, xcd = wgid % NXCD, off = wgid / NXCD; wgid = (xcd < r ? xcd * (q + 1) : r * (q + 1) + (xcd - r) * q) + off; }
        const int nig = wgm * nN, gid = wgid / nig, fm = gid * wgm, gsz = (nM - fm) < wgm ? (nM - fm) : wgm;
        u.pm = fm + ((wgid % nig) % gsz); u.pn = (wgid % nig) / gsz; u.e = 0; u.lp = 0; return true;
    }
    __device__ __forceinline__ const char* abase(const Unit& u) const { return A + (size_t)u.pm * tstep; }
    __device__ __forceinline__ const char* bbase(const Unit& u) const { return Bt + (size_t)u.pn * tstep; }
    __device__ __forceinline__ unsigned tok(const Unit&, int) const { return 0u; }
};

typedef int v8i32 __attribute__((ext_vector_type(8)));
template <class T, class = void> struct HasChain { static constexpr bool value = false; };
template <class T> struct HasChain<T, decltype((void)T::CHAIN, void())> { static constexpr bool value = true; };
template <class Epi, class Sched, bool ALIGN_EPI, bool F8 = false, int SCW = 127>
__device__ __forceinline__ void gemm_phase(LAS unsigned char* lds, const int Kb, const Sched& S, const Epi& E, const int wave_id, const int nt_ov = 0) {
    const int lane_ = fresh_lane();
    const int wid = __builtin_amdgcn_readfirstlane(wave_id), lane = lane_, tid = wid * 64 + lane, wr = wid >> 2, wc = wid & 3, fr = lane & 15, fq = lane >> 4;
    const int nt = nt_ov ? nt_ov : Kb / 128;
    unsigned voffB[2]; int RA[2], CA[2];
#pragma unroll
    for (int i = 0; i < 2; ++i) { int R, C; stage_rc(tid * 16 + i * 8192, R, C); RA[i] = R; CA[i] = C; const int Rb = Epi::PERM ? ((R & ~31) + perm32(R & 31)) : R; voffB[i] = (unsigned)(Rb * Kb + C * 2); }
    const size_t kstep = (size_t)(BK * 2);
    const size_t hstep = (size_t)HALF * Kb;
    const size_t hstepA = Sched::GATHER ? (size_t)0 : hstep;
    const unsigned ldsw = (unsigned)wid * 1024u;
    const int aoff = lds_byte(wr * 64 + fr, fq * 8), boff = lds_byte(wc * 32 + fr, fq * 8);
#define PG8_SA(b, h) (((b) * 2 + (h)) * HTB)
#define PG8_SB(b, h) ((4 + (b) * 2 + (h)) * HTB)
#define PG8_STAGE(bufoff, gbase, voff) do { _Pragma("unroll") for (int _i = 0; _i < 2; ++_i) \
        __builtin_amdgcn_global_load_lds((const unsigned*)((const char*)(gbase) + (voff)[_i]), (LAS unsigned*)(lds + (bufoff) + ldsw + _i * 8192), 16, 0, 0); } while (0)
#define PG8_LDA(dst, b, h) do { _Pragma("unroll") for (int m = 0; m < 4; ++m) _Pragma("unroll") for (int k = 0; k < 2; ++k) dst[m][k] = *(const LAS bf16x8*)(lds + PG8_SA(b, h) + aoff + m * 2048 + k * 1024); } while (0)
#define PG8_LDB(dst, b, h) do { _Pragma("unroll") for (int n = 0; n < 2; ++n) _Pragma("unroll") for (int k = 0; k < 2; ++k) dst[n][k] = *(const LAS bf16x8*)(lds + PG8_SB(b, h) + boff + n * 2048 + k * 1024); } while (0)
#define PG8_F8CAT(x) __builtin_bit_cast(v8i32, __builtin_shufflevector(x[0], x[1], 0, 1, 2, 3, 4, 5, 6, 7, 8, 9, 10, 11, 12, 13, 14, 15))
#define PG8_MMA(ai, bj, At, Bt) do { __builtin_amdgcn_s_setprio(1); _Pragma("unroll") for (int m = 0; m < 4; ++m) _Pragma("unroll") for (int n = 0; n < 2; ++n) { \
        if constexpr (F8) { asm volatile("v_mfma_f32_16x16x128_f8f6f4 %0, %1, %2, %0" : "+v"(acc[ai][bj][m][n]) : "v"(PG8_F8CAT(Bt[n])), "v"(PG8_F8CAT(At[m]))); } \
        else { _Pragma("unroll") for (int k = 0; k < 2; ++k) acc[ai][bj][m][n] = __builtin_amdgcn_mfma_f32_16x16x32_bf16(Bt[n][k], At[m][k], acc[ai][bj][m][n], 0, 0, 0); } } __builtin_amdgcn_s_setprio(0); } while (0)
#define PG8_WAIT_V(n) asm volatile("s_waitcnt vmcnt(" #n ")" ::: "memory")
#define PG8_WAIT_L(n) asm volatile("s_waitcnt lgkmcnt(" #n ")" ::: "memory")
#define PG8_BAR __builtin_amdgcn_s_barrier()
#define PG8_SCHED __builtin_amdgcn_sched_barrier(0)
#define PG8_SETV(v, u) do { _Pragma("unroll") for (int _h = 0; _h < 2; ++_h) _Pragma("unroll") for (int _i = 0; _i < 2; ++_i) \
        v[_h][_i] = Sched::GATHER ? (S.tok(u, _h * HALF + RA[_i]) * (unsigned)Kb + (unsigned)CA[_i] * 2u) : (unsigned)(RA[_i] * Kb + CA[_i] * 2); } while (0)
    Unit cur, nxt; int ui = 0;
    if (!S.next(0, cur)) return;
    f32x4 acc[2][2][4][2];
#pragma unroll
    for (int a = 0; a < 2; ++a)
#pragma unroll
        for (int b = 0; b < 2; ++b)
#pragma unroll
            for (int m = 0; m < 4; ++m)
#pragma unroll
                for (int n = 0; n < 2; ++n) acc[a][b][m][n] = (f32x4){0.f, 0.f, 0.f, 0.f};
    bf16x8 At[4][2], B0[2][2], B1[2][2];
    unsigned cvA[2][2], nvA[2][2];
    PG8_SETV(cvA, cur);
    const char* cA = S.abase(cur); const char* cB = S.bbase(cur);
    PG8_STAGE(PG8_SB(0, 0), cB, voffB); PG8_STAGE(PG8_SB(0, 1), cB + hstep, voffB); PG8_STAGE(PG8_SA(0, 0), cA, cvA[0]); PG8_STAGE(PG8_SA(0, 1), cA + hstepA, cvA[1]);
    if (wr == 1) PG8_BAR;
    PG8_WAIT_V(2); PG8_BAR;
    PG8_STAGE(PG8_SB(1, 0), cB + kstep, voffB); PG8_STAGE(PG8_SA(1, 0), cA + kstep, cvA[0]); PG8_STAGE(PG8_SB(1, 1), cB + hstep + kstep, voffB);
    PG8_WAIT_V(6); PG8_BAR;
#if defined(PROBE_A)
    volatile LAS unsigned* pm_ = (volatile LAS unsigned*)(lds + (LDS_BYTES - 256));
    const bool pw_ = (blockIdx.x == 0 && tid == 0);
#define PTICK(slot) do { if (pw_) { const unsigned now_ = (unsigned)__builtin_amdgcn_s_memrealtime(); pm_[34 + (slot)] += now_ - pm_[31]; pm_[31] = now_; } } while (0)
    if (pw_) pm_[31] = (unsigned)__builtin_amdgcn_s_memrealtime();
#else
#define PTICK(slot) do { } while (0)
#endif
    for (;;) {
        PTICK(22);
        const bool has_next = S.next(ui + 1, nxt);
        const char* nA = has_next ? S.abase(nxt) : cA; const char* nB = has_next ? S.bbase(nxt) : cB;
        if constexpr (Sched::GATHER) {
            if (has_next) { PG8_SETV(nvA, nxt); }
            else {
#pragma unroll
                for (int h = 0; h < 2; ++h)
#pragma unroll
                    for (int i = 0; i < 2; ++i) nvA[h][i] = cvA[h][i];
            }
            asm volatile("" : "+v"(nvA[0][0]), "+v"(nvA[0][1]), "+v"(nvA[1][0]), "+v"(nvA[1][1]));
        }
        PTICK(20);
#pragma unroll 1
        for (int t = 0; t < nt; t += 2) {
            const bool last = (t == nt - 2);
            const char* a1 = cA + (size_t)(t + 1) * kstep;
            const char* a2 = last ? nA : cA + (size_t)(t + 2) * kstep; const char* b2 = last ? nB : cB + (size_t)(t + 2) * kstep;
            const char* a3 = a2 + kstep; const char* b3 = b2 + kstep;
            unsigned v0[2], v1[2];
#pragma unroll
            for (int i = 0; i < 2; ++i) { if constexpr (Sched::GATHER) { v0[i] = last ? nvA[0][i] : cvA[0][i]; v1[i] = last ? nvA[1][i] : cvA[1][i]; } else { v0[i] = cvA[0][i]; v1[i] = cvA[1][i]; } }
            PG8_LDB(B0, 0, 0); PG8_LDB(B1, 0, 1); PG8_SCHED; PG8_LDA(At, 0, 0); PG8_STAGE(PG8_SA(1, 1), a1 + hstepA, cvA[1]);
            PG8_WAIT_V(8); PG8_WAIT_L(0); PG8_BAR; PG8_MMA(0, 0, At, B0); PG8_MMA(0, 1, At, B1); PG8_BAR; PG8_SCHED;
            PG8_LDA(At, 0, 1); PG8_STAGE(PG8_SB(0, 0), b2, voffB); PG8_STAGE(PG8_SB(0, 1), b2 + hstep, voffB); PG8_STAGE(PG8_SA(0, 0), a2, v0);
            PG8_WAIT_V(8); PG8_WAIT_L(0); PG8_BAR; PG8_MMA(1, 0, At, B0); PG8_MMA(1, 1, At, B1); PG8_BAR; PG8_SCHED;
            PG8_LDB(B0, 1, 0); PG8_LDB(B1, 1, 1); PG8_SCHED; PG8_LDA(At, 1, 0); PG8_STAGE(PG8_SA(0, 1), a2 + hstepA, v1);
            PG8_WAIT_V(8); PG8_WAIT_L(0); PG8_BAR; PG8_MMA(0, 0, At, B0); PG8_MMA(0, 1, At, B1); PG8_BAR; PG8_SCHED;
            PG8_LDA(At, 1, 1); PG8_STAGE(PG8_SB(1, 0), b3, voffB); PG8_STAGE(PG8_SB(1, 1), b3 + hstep, voffB); PG8_STAGE(PG8_SA(1, 0), a3, v0);
            PG8_WAIT_V(8); PG8_WAIT_L(0); PG8_BAR; PG8_MMA(1, 0, At, B0); PG8_MMA(1, 1, At, B1); PG8_BAR; PG8_SCHED;
        }
        PTICK(21);
        if constexpr (ALIGN_EPI) { if (wr == 0) PG8_BAR; }
        bool keep = false;
        if constexpr (HasChain<Epi>::value) { E.chain(acc, cur, wr, wc, fr, fq); keep = (cur.e == 0); } else E(acc, cur, wr, wc, fr, fq);
        if (!has_next) break;
        if (!keep) {
#pragma unroll
        for (int a = 0; a < 2; ++a)
#pragma unroll
            for (int b = 0; b < 2; ++b)
#pragma unroll
                for (int m = 0; m < 4; ++m)
#pragma unroll
                    for (int n = 0; n < 2; ++n) acc[a][b][m][n] = (f32x4){0.f, 0.f, 0.f, 0.f};
        }
        cur = nxt; cA = nA; cB = nB; ++ui;
#pragma unroll
        for (int h = 0; h < 2; ++h)
#pragma unroll
            for (int i = 0; i < 2; ++i) { if constexpr (Sched::GATHER) cvA[h][i] = nvA[h][i]; }
        if constexpr (ALIGN_EPI) { if (wr == 1) PG8_BAR; }
    }
    PG8_WAIT_V(0);
    if constexpr (!ALIGN_EPI) { if (wr == 0) PG8_BAR; }
    PG8_BAR;
#undef PG8_SA
#undef PG8_SB
#undef PG8_STAGE
#undef PG8_LDA
#undef PG8_LDB
#undef PG8_MMA
#undef PG8_F8CAT
#undef PG8_WAIT_V
#undef PG8_WAIT_L
#undef PG8_BAR
#undef PG8_SCHED
#undef PG8_SETV
#undef PTICK
}

struct EpiIn {
    static constexpr bool PERM = true;
    unsigned char* ws; float sc; int pn0; const float* qg; const float* kg;
    __device__ __forceinline__ void qk_tile(const f32x4 (&acc)[2][2][4][2], const Unit& u, int pn, int wr, int wc, int fr, int fq) const {
        const bool isq = pn < 10; const int head = 4 * (pn & 1) + wc;
        bf16_t* base = (bf16_t*)(ws + (isq ? WS_AQ : WS_AK)); const float* gp = (isq ? qg : kg);
        f32x4 g[2][2], ks[2][2];
#pragma unroll
        for (int bj = 0; bj < 2; ++bj)
#pragma unroll
            for (int n = 0; n < 2; ++n) { g[bj][n] = *(const f32x4*)(gp + 32 * bj + 8 * fq + 4 * n) * (isq ? QSCALE : 1.0f); ks[bj][n] = (f32x4){0.f, 0.f, 0.f, 0.f}; }
#pragma unroll
        for (int ai = 0; ai < 2; ++ai)
#pragma unroll
            for (int m = 0; m < 4; ++m) { f32x4 v[2][2]; float ss = 0.f;
#pragma unroll
                for (int bj = 0; bj < 2; ++bj)
#pragma unroll
                    for (int n = 0; n < 2; ++n) { v[bj][n] = acc[ai][bj][m][n] * sc; ss += (v[bj][n].x * v[bj][n].x + v[bj][n].y * v[bj][n].y) + (v[bj][n].z * v[bj][n].z + v[bj][n].w * v[bj][n].w); }
                ss = shx_sum<16>(ss); ss = shx_sum<32>(ss);
                const float r = 1.0f / sqrtf(ss * (1.f / 64.f) + EPS);
                bf16_t* rowp = base + (size_t)(u.pm * BM + ai * HALF + wr * 64 + m * 16 + fr) * 512 + 64 * head + 8 * fq;
#pragma unroll
                for (int bj = 0; bj < 2; ++bj) { const f32x4 y0 = v[bj][0] * r * g[bj][0], y1 = v[bj][1] * r * g[bj][1]; ks[bj][0] += y0; ks[bj][1] += y1;
                    u32x4 w; w.x = cvt_pk_bf16(y0[0], y0[1]); w.y = cvt_pk_bf16(y0[2], y0[3]); w.z = cvt_pk_bf16(y1[0], y1[1]); w.w = cvt_pk_bf16(y1[2], y1[3]);
                    *(u32x4*)(rowp + 32 * bj) = w; } }
        if (!isq) {
#pragma unroll
            for (int bj = 0; bj < 2; ++bj)
#pragma unroll
                for (int n = 0; n < 2; ++n)
#pragma unroll
                    for (int j = 0; j < 4; ++j) { float t = ks[bj][n][j]; t += dppf<0xB1>(t); t += dppf<0x4E>(t); t += dppf<0x141>(t); t += dppf<0x140>(t); ks[bj][n][j] = t; }
            if (fr == 0) { float* km = (float*)(ws + WS_KMEAN) + (size_t)wr * 65536 + ((size_t)((u.pm >> 4) * 8 + head) * 16 + (u.pm & 15)) * 64 + 8 * fq;
#pragma unroll
                for (int bj = 0; bj < 2; ++bj) { *(f32x4*)(km + 32 * bj) = ks[bj][0]; *(f32x4*)(km + 32 * bj + 4) = ks[bj][1]; } }
        }
    }
    __device__ __forceinline__ void operator()(const f32x4 (&acc)[2][2][4][2], const Unit& u, int wr, int wc, int fr, int fq) const {
        const int pn = u.pn + pn0; bf16_t* base; int ld, colt; bool sg;
        if (pn >= 8 && pn < 12) { qk_tile(acc, u, pn, wr, wc, fr, fq); return; }
        if (pn < 4) { base = (bf16_t*)(ws + WS_MQK); ld = 1024; colt = 256 * pn; sg = false; }
        else if (pn < 14) { const int q = (pn - 4) >> 1; base = (bf16_t*)(ws + WS_MV + (size_t)q * (32 * MiB)); ld = 512; colt = 256 * ((pn - 4) & 1); sg = (q == 1); }
        else { base = (bf16_t*)(ws + WS_GAB); ld = 2048; colt = 256 * (pn - 14); sg = true; }
        const int row0 = u.pm * BM + wr * 64 + fr, col0 = colt + wc * 32 + 8 * fq;
#pragma unroll
        for (int ai = 0; ai < 2; ++ai)
#pragma unroll
            for (int m = 0; m < 4; ++m) { bf16_t* rowp = base + (size_t)(row0 + ai * HALF + m * 16) * ld + col0;
#pragma unroll
                for (int bj = 0; bj < 2; ++bj) { f32x4 v0 = acc[ai][bj][m][0] * sc, v1 = acc[ai][bj][m][1] * sc;
                    if (sg) {
                        v0 = v0 * (-LOG2E); v1 = v1 * (-LOG2E);
#pragma unroll
                        for (int j = 0; j < 4; ++j) { v0[j] = __builtin_amdgcn_exp2f(v0[j]); v1[j] = __builtin_amdgcn_exp2f(v1[j]); }
                        v0 = v0 + 1.0f; v1 = v1 + 1.0f;
#pragma unroll
                        for (int j = 0; j < 4; ++j) { v0[j] = __builtin_amdgcn_rcpf(v0[j]); v1[j] = __builtin_amdgcn_rcpf(v1[j]); } }
                    u32x4 w; w.x = cvt_pk_bf16(v0[0], v0[1]); w.y = cvt_pk_bf16(v0[2], v0[3]); w.z = cvt_pk_bf16(v1[0], v1[1]); w.w = cvt_pk_bf16(v1[2], v1[3]);
                    *(u32x4*)(rowp + bj * HALF) = w; } }
    }
};
template <int BR> struct EpiBranch {
    static constexpr bool PERM = true;
    bf16_t* Y; const bf16_t* G; unsigned char* Y8;
    __device__ __forceinline__ void operator()(const f32x4 (&acc)[2][2][4][2], const Unit& u, int wr, int wc, int fr, int fq) const {
        const int row0 = u.pm * BM + wr * 64 + fr, col0 = u.pn * BM + wc * 32 + 8 * fq;
#pragma unroll
        for (int ai = 0; ai < 2; ++ai) {
            u32x4 g[4][2], yo[4][2];
#pragma unroll
            for (int m = 0; m < 4; ++m)
#pragma unroll
                for (int bj = 0; bj < 2; ++bj) { const size_t r = (size_t)(row0 + ai * HALF + m * 16); const int c = col0 + bj * HALF;
                    g[m][bj] = *(const u32x4*)(G + r * 2048 + BR * 1024 + c); if (BR == 1) yo[m][bj] = *(const u32x4*)(Y + r * 1024 + c); }
            __builtin_amdgcn_sched_barrier(0);
#pragma unroll
            for (int m = 0; m < 4; ++m)
#pragma unroll
                for (int bj = 0; bj < 2; ++bj) { const size_t r = (size_t)(row0 + ai * HALF + m * 16); const int c = col0 + bj * HALF; const u32x4 gg = g[m][bj];
                    f32x4 v0 = acc[ai][bj][m][0], v1 = acc[ai][bj][m][1];
                    v0[0] *= bf_lo(gg.x); v0[1] *= bf_hi(gg.x); v0[2] *= bf_lo(gg.y); v0[3] *= bf_hi(gg.y); v1[0] *= bf_lo(gg.z); v1[1] *= bf_hi(gg.z); v1[2] *= bf_lo(gg.w); v1[3] *= bf_hi(gg.w);
                    if (BR == 1) { const u32x4 y = yo[m][bj];
                        v0[0] += bf_lo(y.x); v0[1] += bf_hi(y.x); v0[2] += bf_lo(y.y); v0[3] += bf_hi(y.y); v1[0] += bf_lo(y.z); v1[1] += bf_hi(y.z); v1[2] += bf_lo(y.w); v1[3] += bf_hi(y.w); }
                    if (BR == 1 && OUT8 && Y8 != nullptr) { v0 = v0 * 16.0f; v1 = v1 * 16.0f; u32x2 w8; w8.x = cvt_pk4_fp8(v0[0], v0[1], v0[2], v0[3]); w8.y = cvt_pk4_fp8(v1[0], v1[1], v1[2], v1[3]); *(u32x2*)(Y8 + r * 1024 + c) = w8; }
                    else { u32x4 w; w.x = cvt_pk_bf16(v0[0], v0[1]); w.y = cvt_pk_bf16(v0[2], v0[3]); w.z = cvt_pk_bf16(v1[0], v1[1]); w.w = cvt_pk_bf16(v1[2], v1[3]);
                        *(u32x4*)(Y + r * 1024 + c) = w; } }
            __builtin_amdgcn_sched_barrier(0);
        }
    }
};
struct MergeOrder {
    static constexpr bool GATHER = false;
    StaticOrder so; const char* A1; const char* B1;
    __device__ __forceinline__ bool next(int i, Unit& u) const { const bool ok = so.next(i >> 1, u); u.e = i & 1; return ok; }
    __device__ __forceinline__ const char* abase(const Unit& u) const { return (u.e ? A1 : so.A) + (size_t)u.pm * so.tstep; }
    __device__ __forceinline__ const char* bbase(const Unit& u) const { return (u.e ? B1 : so.Bt) + (size_t)u.pn * so.tstep; }
    __device__ __forceinline__ unsigned tok(const Unit&, int) const { return 0u; }
};
struct EpiMerge {
    static constexpr bool PERM = true;
    static constexpr bool CHAIN = true;
    bf16_t* Y; const bf16_t* G; unsigned char* Y8;
    __device__ __forceinline__ void chain(f32x4 (&acc)[2][2][4][2], const Unit& u, int wr, int wc, int fr, int fq) const {
        const int row0 = u.pm * BM + wr * 64 + fr, col0 = u.pn * BM + wc * 32 + 8 * fq;
        if (u.e == 0) {
#pragma unroll
            for (int ai = 0; ai < 2; ++ai) {
                u32x4 ga[4][2], gb[4][2];
#pragma unroll
                for (int m = 0; m < 4; ++m)
#pragma unroll
                    for (int bj = 0; bj < 2; ++bj) { const size_t r = (size_t)(row0 + ai * HALF + m * 16); const int c = col0 + bj * HALF;
                        ga[m][bj] = *(const u32x4*)(G + r * 2048 + c); gb[m][bj] = *(const u32x4*)(G + r * 2048 + 1024 + c); }
                __builtin_amdgcn_sched_barrier(0);
#pragma unroll
                for (int m = 0; m < 4; ++m)
#pragma unroll
                    for (int bj = 0; bj < 2; ++bj) { const u32x4 a = ga[m][bj], b = gb[m][bj];
                        f32x4 q0, q1;
                        q0[0] = bf_lo(a.x) * __builtin_amdgcn_rcpf(bf_lo(b.x)); q0[1] = bf_hi(a.x) * __builtin_amdgcn_rcpf(bf_hi(b.x)); q0[2] = bf_lo(a.y) * __builtin_amdgcn_rcpf(bf_lo(b.y)); q0[3] = bf_hi(a.y) * __builtin_amdgcn_rcpf(bf_hi(b.y));
                        q1[0] = bf_lo(a.z) * __builtin_amdgcn_rcpf(bf_lo(b.z)); q1[1] = bf_hi(a.z) * __builtin_amdgcn_rcpf(bf_hi(b.z)); q1[2] = bf_lo(a.w) * __builtin_amdgcn_rcpf(bf_lo(b.w)); q1[3] = bf_hi(a.w) * __builtin_amdgcn_rcpf(bf_hi(b.w));
                        acc[ai][bj][m][0] = acc[ai][bj][m][0] * q0; acc[ai][bj][m][1] = acc[ai][bj][m][1] * q1; }
                __builtin_amdgcn_sched_barrier(0);
            }
        } else {
            u32x4 gb2[2][4][2];
#pragma unroll
            for (int ai = 0; ai < 2; ++ai)
#pragma unroll
                for (int m = 0; m < 4; ++m)
#pragma unroll
                    for (int bj = 0; bj < 2; ++bj) { const size_t r = (size_t)(row0 + ai * HALF + m * 16); const int c = col0 + bj * HALF; gb2[ai][m][bj] = *(const u32x4*)(G + r * 2048 + 1024 + c); }
            __builtin_amdgcn_sched_barrier(0);
#pragma unroll
            for (int ai = 0; ai < 2; ++ai) {
#pragma unroll
                for (int m = 0; m < 4; ++m)
#pragma unroll
                    for (int bj = 0; bj < 2; ++bj) { const size_t r = (size_t)(row0 + ai * HALF + m * 16); const int c = col0 + bj * HALF; const u32x4 b = gb2[ai][m][bj];
                        f32x4 v0 = acc[ai][bj][m][0], v1 = acc[ai][bj][m][1];
                        v0[0] *= bf_lo(b.x); v0[1] *= bf_hi(b.x); v0[2] *= bf_lo(b.y); v0[3] *= bf_hi(b.y); v1[0] *= bf_lo(b.z); v1[1] *= bf_hi(b.z); v1[2] *= bf_lo(b.w); v1[3] *= bf_hi(b.w);
                        if (OUT8 && Y8 != nullptr) { v0 = v0 * 16.0f; v1 = v1 * 16.0f; u32x2 w8; w8.x = cvt_pk4_fp8(v0[0], v0[1], v0[2], v0[3]); w8.y = cvt_pk4_fp8(v1[0], v1[1], v1[2], v1[3]); *(u32x2*)(Y8 + r * 1024 + c) = w8; }
                        else { u32x4 w; w.x = cvt_pk_bf16(v0[0], v0[1]); w.y = cvt_pk_bf16(v0[2], v0[3]); w.z = cvt_pk_bf16(v1[0], v1[1]); w.w = cvt_pk_bf16(v1[2], v1[3]);
                            *(u32x4*)(Y + r * 1024 + c) = w; } }
                __builtin_amdgcn_sched_barrier(0);
            }
        }
    }
};
struct EpiResid {
    static constexpr bool PERM = true;
    const void* base; bf16_t* out; float sc; bool basebf;
    __device__ __forceinline__ void operator()(const f32x4 (&acc)[2][2][4][2], const Unit& u, int wr, int wc, int fr, int fq) const {
        const int row0 = u.pm * BM + wr * 64 + fr, col0 = u.pn * BM + wc * 32 + 8 * fq;
#pragma unroll
        for (int ai = 0; ai < 2; ++ai) {
            if (basebf) {
                u32x4 b[4][2];
#pragma unroll
                for (int m = 0; m < 4; ++m)
#pragma unroll
                    for (int bj = 0; bj < 2; ++bj) b[m][bj] = *(const u32x4*)((const bf16_t*)base + (size_t)(row0 + ai * HALF + m * 16) * XBP + xb_col(col0 + bj * HALF));
                __builtin_amdgcn_sched_barrier(0);
#pragma unroll
                for (int m = 0; m < 4; ++m)
#pragma unroll
                    for (int bj = 0; bj < 2; ++bj) { const u32x4 y = b[m][bj];
                        const f32x4 v0 = (f32x4){bf_lo(y.x), bf_hi(y.x), bf_lo(y.y), bf_hi(y.y)} + acc[ai][bj][m][0] * sc, v1 = (f32x4){bf_lo(y.z), bf_hi(y.z), bf_lo(y.w), bf_hi(y.w)} + acc[ai][bj][m][1] * sc;
                        u32x4 w; w.x = cvt_pk_bf16(v0[0], v0[1]); w.y = cvt_pk_bf16(v0[2], v0[3]); w.z = cvt_pk_bf16(v1[0], v1[1]); w.w = cvt_pk_bf16(v1[2], v1[3]);
                        *(u32x4*)(out + (size_t)(row0 + ai * HALF + m * 16) * XBP + xb_col(col0 + bj * HALF)) = w; }
            } else {
                f32x4 b[4][2][2];
#pragma unroll
                for (int m = 0; m < 4; ++m)
#pragma unroll
                    for (int bj = 0; bj < 2; ++bj)
#pragma unroll
                        for (int n = 0; n < 2; ++n) b[m][bj][n] = *(const f32x4*)((const float*)base + (size_t)(row0 + ai * HALF + m * 16) * 1024 + col0 + bj * HALF + 4 * n);
                __builtin_amdgcn_sched_barrier(0);
#pragma unroll
                for (int m = 0; m < 4; ++m)
#pragma unroll
                    for (int bj = 0; bj < 2; ++bj) { const f32x4 v0 = b[m][bj][0] + acc[ai][bj][m][0] * sc, v1 = b[m][bj][1] + acc[ai][bj][m][1] * sc;
                        u32x4 w; w.x = cvt_pk_bf16(v0[0], v0[1]); w.y = cvt_pk_bf16(v0[2], v0[3]); w.z = cvt_pk_bf16(v1[0], v1[1]); w.w = cvt_pk_bf16(v1[2], v1[3]);
                        *(u32x4*)(out + (size_t)(row0 + ai * HALF + m * 16) * XBP + xb_col(col0 + bj * HALF)) = w; }
            }
            __builtin_amdgcn_sched_barrier(0);
        }
    }
};
template <bool MOE, bool F8OUT = false> struct EpiSwiGLU {
    static constexpr bool PERM = true;
    void* Ov; int ld; float sc;
    __device__ __forceinline__ void operator()(const f32x4 (&acc)[2][2][4][2], const Unit& u, int wr, int wc, int fr, int fq) const {
        const int row0 = u.pm * BM + wr * 64 + fr, col0 = (MOE ? u.lp : u.pn) * HALF + wc * 32 + 8 * fq;
#pragma unroll
        for (int ai = 0; ai < 2; ++ai)
#pragma unroll
            for (int m = 0; m < 4; ++m) { const size_t off = (size_t)(row0 + ai * HALF + m * 16) * ld + col0;
                f32x4 v0, v1;
                { const float c1 = -sc * LOG2E, c2 = sc * sc;
                  const f32x4 ga = acc[ai][0][m][0], gb = acc[ai][0][m][1];
                  const f32x4 xa = ga * c1, xb = gb * c1; f32x4 ea, eb;
#pragma unroll
                  for (int j = 0; j < 4; ++j) { ea[j] = __builtin_amdgcn_exp2f(xa[j]); eb[j] = __builtin_amdgcn_exp2f(xb[j]); }
                  const float k2 = 1.0f / c2; const f32x4 da = ea * k2 + k2, db = eb * k2 + k2; f32x4 ra, rb;
#pragma unroll
                  for (int j = 0; j < 4; ++j) { ra[j] = __builtin_amdgcn_rcpf(da[j]); rb[j] = __builtin_amdgcn_rcpf(db[j]); }
                  v0 = (ga * acc[ai][1][m][0]) * ra; v1 = (gb * acc[ai][1][m][1]) * rb; }
                if constexpr (F8OUT) { u32x2 w; w.x = cvt_pk4_fp8(v0[0], v0[1], v0[2], v0[3]); w.y = cvt_pk4_fp8(v1[0], v1[1], v1[2], v1[3]); *(u32x2*)((unsigned char*)Ov + off) = w; }
                else { u32x4 w; w.x = cvt_pk_bf16(v0[0], v0[1]); w.y = cvt_pk_bf16(v0[2], v0[3]); w.z = cvt_pk_bf16(v1[0], v1[1]); w.w = cvt_pk_bf16(v1[2], v1[3]); *(u32x4*)((bf16_t*)Ov + off) = w; } }
    }
};
struct EpiMoeStore {
    static constexpr bool PERM = true;
    bf16_t* O; float sc; bf16_t* O2;
    __device__ __forceinline__ void operator()(const f32x4 (&acc)[2][2][4][2], const Unit& u, int wr, int wc, int fr, int fq) const {
        const bool second = (u.e >> 8) != 0;
        const int row0 = (second ? u.lp : u.pm) * BM + wr * 64 + fr, col0 = (u.pn & 3) * BM + wc * 32 + 8 * fq; bf16_t* Ob = second ? O2 : O;
#pragma unroll
        for (int ai = 0; ai < 2; ++ai)
#pragma unroll
            for (int m = 0; m < 4; ++m) { bf16_t* rowp = Ob + (size_t)(row0 + ai * HALF + m * 16) * 1024 + col0;
#pragma unroll
                for (int bj = 0; bj < 2; ++bj) { const f32x4 v0 = acc[ai][bj][m][0] * sc, v1 = acc[ai][bj][m][1] * sc;
                    u32x4 w; w.x = cvt_pk_bf16(v0[0], v0[1]); w.y = cvt_pk_bf16(v0[2], v0[3]); w.z = cvt_pk_bf16(v1[0], v1[1]); w.w = cvt_pk_bf16(v1[2], v1[3]);
                    *(u32x4*)(rowp + bj * HALF) = w; } }
    }
};
struct EpiMoeDown {
    static constexpr bool PERM = false;
    float* X; const int* idx; const float* wgt; const unsigned* cnt;
    __device__ __forceinline__ void operator()(const f32x4 (&acc)[2][2][4][2], const Unit& u, int wr, int wc, int fr, int fq) const {
        const int n = (int)cnt[64 * u.e]; const int col0 = (u.pn & 3) * BM + wc * 32 + 4 * fq;
        int tk[2][4]; float w[2][4];
#pragma unroll
        for (int ai = 0; ai < 2; ++ai)
#pragma unroll
            for (int m = 0; m < 4; ++m) { const int j = u.lp * 256 + ai * HALF + wr * 64 + m * 16 + fr; const bool ok = j < n; const int jj = ok ? j : 0;
                tk[ai][m] = ok ? idx[u.e * 65536 + jj] : -1; w[ai][m] = wgt[u.e * 65536 + jj] * (1.0f / 128.0f); }
        __builtin_amdgcn_sched_barrier(0);
#pragma unroll
        for (int ai = 0; ai < 2; ++ai) {
            f32x4 b[4][2][2];
#pragma unroll
            for (int m = 0; m < 4; ++m) { const float* p = X + (size_t)(tk[ai][m] < 0 ? 0 : tk[ai][m]) * 1024 + col0;
#pragma unroll
                for (int bj = 0; bj < 2; ++bj)
#pragma unroll
                    for (int nn = 0; nn < 2; ++nn) b[m][bj][nn] = *(const f32x4*)(p + bj * HALF + nn * 16); }
            __builtin_amdgcn_sched_barrier(0);
#pragma unroll
            for (int m = 0; m < 4; ++m) { if (tk[ai][m] >= 0) { float* p = X + (size_t)tk[ai][m] * 1024 + col0;
#pragma unroll
                for (int bj = 0; bj < 2; ++bj)
#pragma unroll
                    for (int nn = 0; nn < 2; ++nn) *(f32x4*)(p + bj * HALF + nn * 16) = b[m][bj][nn] + w[ai][m] * acc[ai][bj][m][nn]; } }
            __builtin_amdgcn_sched_barrier(0);
        }
    }
};
template <bool UP> struct MoeOrder {
    static constexpr bool GATHER = false;
    const char* A; const char* Bt; size_t tstep; const int* idx; const unsigned* cnt; int NT, G, c, g0, g1; LAS int* psl; int fake = 0; int mode = 0, khalf = 0;
    __device__ __forceinline__ void init(const void* A_, const void* Bt_, int Kb, const int* idx_, const unsigned* cnt_, int NT_, int G_, int c_, int g0_, int g1_, int tid, LAS unsigned char* ldsb) {
        A = (const char*)A_; Bt = (const char*)Bt_; tstep = (size_t)BM * Kb; idx = idx_; cnt = cnt_; NT = NT_; G = G_; c = c_; g0 = g0_; g1 = g1_; psl = (LAS int*)(ldsb + LDS_BYTES - 512);
        if (tid < 64) { const int mine = ((int)cnt[64 * (tid & 15)] + 255) >> 8; int acc_ = 0;
#pragma unroll
            for (int g = 0; g < 16; ++g) { if (tid == g) psl[g] = acc_; acc_ += __builtin_amdgcn_readlane(mine, g); }
            if (tid == 16) psl[16] = acc_; }
        __syncthreads();
        if (tid < 64) { Unit u; u.pm = 0; u.pn = 0; u.e = 0; u.lp = 0; const bool ok = compute(tid, u); LAS int* t = (LAS int*)((LAS unsigned char*)psl - (LDS_BYTES - 512) + LDS_UNITS) + 4 * tid; t[0] = ok ? u.pm : -1; t[1] = u.pn; t[2] = u.e; t[3] = u.lp; }
        __syncthreads();
    }
    __device__ __forceinline__ bool next(int i, Unit& u) const {
        if (i >= 64) return false;
        const LAS int* t = (const LAS int*)((LAS unsigned char*)psl - (LDS_BYTES - 512) + LDS_UNITS) + 4 * i; const int pm = __builtin_amdgcn_readfirstlane(t[0]);
        if (pm < 0) return false;
        u.pm = pm; u.pn = __builtin_amdgcn_readfirstlane(t[1]); u.e = __builtin_amdgcn_readfirstlane(t[2]); u.lp = __builtin_amdgcn_readfirstlane(t[3]); return true;
    }
    __device__ __forceinline__ bool compute(int i, Unit& u) const {
        int g = -1, lp = 0, pl = 0; int ps[17];
#pragma unroll
        for (int k = 0; k < 17; ++k) ps[k] = __builtin_amdgcn_readfirstlane(psl[k]);
        if (UP && (G % 8 == 0)) {
            const int x = c & 7, n = i * (G >> 3) + (c >> 3); int acc_ = 0;
#pragma unroll
            for (int k = 0; k < 16; ++k) { const int p0_ = (x + k) & 7, tc = (p0_ <= ((NT - 1) & 7)) ? ((NT - 1) >> 3) + 1 : ((NT - 1) >> 3); const int np_ = ps[k + 1] - ps[k], ne = np_ * tc;
                if (k >= g0 && k < g1) { if (g < 0 && n < acc_ + ne) { g = k; const int r = n - acc_; lp = r / tc; pl = p0_ + 8 * (r - lp * tc); } acc_ += ne; } }
            if (g < 0) return false;
        } else if (!UP && (G % 8 == 0)) {
            const int x = c & 7, np_ = ps[g1] - ps[g0]; const int pa = (x * np_) >> 3, pb = ((x + 1) * np_) >> 3;
            int n = i * (G >> 3) + (c >> 3), half = 0; const int nfull = 4 * (G >> 3);
            if (mode == 1) { if (n >= nfull) return false; }
            if (mode == 2) { half = n & 1; n = nfull + (n >> 1); }
            if (n >= (pb - pa) * NT) return false;
            const int p = ps[g0] + pa + n / NT; pl = n % NT;
#pragma unroll
            for (int k = 0; k < 16; ++k) if (p >= ps[k] && p < ps[k + 1]) { g = k; lp = p - ps[k]; }
            if (mode == 2) { int pbase2 = 0;
#pragma unroll
                for (int k = 0; k < 16; ++k) if (k == g) pbase2 = ps[k];
                u.pm = pbase2 + lp; u.pn = (g & 7) * NT + pl; u.e = g | (half << 8); u.lp = x * 4 + (n / NT - nfull / NT); return true; }
        } else {
            const int L = i * G + c, p = ps[g0] + L / NT; if (L >= (ps[g1] - ps[g0]) * NT) return false;
            pl = L % NT;
#pragma unroll
            for (int k = 0; k < 16; ++k) if (p >= ps[k] && p < ps[k + 1]) { g = k; lp = p - ps[k]; }
        }
        int pbase = 0;
#pragma unroll
        for (int k = 0; k < 16; ++k) if (k == g) pbase = ps[k];
        u.pm = pbase + lp; u.pn = (g & 7) * NT + pl; u.e = UP ? (g | (lp << 8)) : g; u.lp = UP ? pl : lp;
        return true;
    }
    __device__ __forceinline__ const char* abase(const Unit& u) const { return A + (size_t)u.pm * tstep + ((!UP && (u.e >> 8)) ? khalf : 0); }
    __device__ __forceinline__ const char* bbase(const Unit& u) const { return Bt + (size_t)(fake ? 0 : u.pn) * tstep + ((!UP && (u.e >> 8)) ? khalf : 0); }
    __device__ __forceinline__ unsigned tok(const Unit& u, int r) const { const int g = fake ? 0 : (u.e & 255), lp = fake ? 0 : (u.e >> 8); const int n = (int)cnt[64 * g]; int j = lp * 256 + r; j = j < n ? j : n - 1; return (unsigned)idx[g * 65536 + j]; }
};
}

#define XB_TMO      128
#define XB_XCNT(j)  (256  + 64 * (j))
#define XB_XSUB(j)  (1280 + 64 * (j))
#define XB_XGEN(j)  (2304 + 64 * (j))
#define XB_TOP      3328
#define XB_TOPGEN   3392
#define XCD_BAR_WORDS 3456
#define XB_SPIN_CAP (1u << 18)

__device__ __forceinline__ unsigned xb_ld(unsigned* p)              { return __hip_atomic_load(p, __ATOMIC_RELAXED, __HIP_MEMORY_SCOPE_AGENT); }
__device__ __forceinline__ unsigned xb_add(unsigned* p, unsigned v) { return __hip_atomic_fetch_add(p, v, __ATOMIC_RELAXED, __HIP_MEMORY_SCOPE_AGENT); }
__device__ __forceinline__ unsigned xb_xcc_id() { return (unsigned)__builtin_amdgcn_s_getreg((3 << 11) | 20) & 0xFu; }
#define XB_SPIN(cond, bar) do { unsigned _sp = 0; while (cond) { __builtin_amdgcn_s_sleep(1); \
    if ((++_sp & 255u) == 0u) { if (xb_ld(&(bar)[XB_TMO])) break; if (_sp > XB_SPIN_CAP) { atomicAdd(&(bar)[XB_TMO], 1u); break; } } } } while (0)

struct XcdBarrier { unsigned* bar; unsigned x; volatile LAS unsigned* st; };
__device__ __forceinline__ XcdBarrier xcd_barrier_post(unsigned* bar, volatile LAS unsigned* st, int tid) {
    XcdBarrier b; b.bar = bar; b.x = xb_xcc_id(); b.st = st;
    if (tid == 0) (void)xb_add(&bar[XB_XCNT(b.x)], 1u);
    return b;
}
__device__ __forceinline__ void xcd_barrier_complete(unsigned* bar, unsigned x, unsigned& nloc, unsigned& nx) {
    const unsigned G = gridDim.x * gridDim.y * gridDim.z;
    unsigned sum, cnt, mine, sp = 0u;
    for (;;) {
        sum = 0u; cnt = 0u; mine = 0u;
#pragma unroll
        for (unsigned j = 0; j < 16; ++j) { const unsigned c = xb_ld(&bar[XB_XCNT(j)]); sum += c; cnt += (c > 0u) ? 1u : 0u; mine = (j == x) ? c : mine; }
        if (sum == G) break;
        __builtin_amdgcn_s_sleep(1);
        if ((++sp & 255u) == 0u) { if (xb_ld(&bar[XB_TMO])) break; if (sp > XB_SPIN_CAP) { atomicAdd(&bar[XB_TMO], 1u); break; } }
    }
    nloc = mine > 0u ? mine : 1u; nx = cnt > 0u ? cnt : 1u;
}
__device__ __forceinline__ void xcd_barrier(const XcdBarrier& b, int tid) {
    asm volatile("s_waitcnt vmcnt(0)" ::: "memory");
    __syncthreads();
    if (tid == 0) {
        unsigned* bar = b.bar; asm volatile("" : "+s"(bar));
        __builtin_amdgcn_s_waitcnt(0);
        unsigned nloc = b.st[0], nx = b.st[1];
        if (nloc == 0u) { xcd_barrier_complete(bar, b.x, nloc, nx); b.st[0] = nloc; b.st[1] = nx; }
        const unsigned old = xb_add(&bar[XB_XSUB(b.x)], 1u);
        const unsigned gen = old / nloc;
        if (old + 1u == (gen + 1u) * nloc) {
            __builtin_amdgcn_fence(__ATOMIC_RELEASE, "agent");
            asm volatile("s_waitcnt vmcnt(0)" ::: "memory");
            const unsigned og = xb_add(&bar[XB_TOP], 1u);
            const unsigned tg = og / nx;
            if (og + 1u == (tg + 1u) * nx) xb_add(&bar[XB_TOPGEN], 1u);
            else XB_SPIN(xb_ld(&bar[XB_TOPGEN]) == tg, bar);
            __builtin_amdgcn_fence(__ATOMIC_ACQUIRE, "agent");
            xb_add(&bar[XB_XGEN(b.x)], 1u);
            asm volatile("s_waitcnt vmcnt(0)" ::: "memory");
        } else {
            XB_SPIN(xb_ld(&bar[XB_XGEN(b.x)]) == gen, bar);
            __builtin_amdgcn_fence(__ATOMIC_ACQUIRE, "agent");
            asm volatile("s_waitcnt vmcnt(0)" ::: "memory");
        }
    }
    __syncthreads();
}

struct Args { const float* in[22]; float* out; unsigned char* ws; };
typedef __attribute__((address_space(4))) const unsigned char* karg_t;
__device__ __forceinline__ karg_t kargs() { karg_t p = (karg_t)__builtin_amdgcn_kernarg_segment_ptr(); asm volatile("" : "+s"(p)); return p; }
#define AIN(i) (((const float* const __attribute__((address_space(4)))*)kargs())[i])
#define AOUT() (((float* const __attribute__((address_space(4)))*)kargs())[22])
#define AWS() (((unsigned char* const __attribute__((address_space(4)))*)kargs())[23])
struct Frame {
    LAS unsigned char* lds; unsigned char* ws;
    int tid, lane, wave, vcu, G;
};


template <int O> __device__ __forceinline__ float shx(float v) {
    if constexpr (O < 32) return __int_as_float(__builtin_amdgcn_ds_swizzle(__float_as_int(v), 0x1f | (O << 10)));
    else { auto rr = __builtin_amdgcn_permlane32_swap(__float_as_uint(v), __float_as_uint(v), false, false); const float lo = __uint_as_float(rr[0]), hi = __uint_as_float(rr[1]); return (lo + hi) - v; }
}
template <int O> __device__ __forceinline__ float shx_sum(float v) {
    if constexpr (O < 32) return v + shx<O>(v);
    else { auto rr = __builtin_amdgcn_permlane32_swap(__float_as_uint(v), __float_as_uint(v), false, false); return __uint_as_float(rr[0]) + __uint_as_float(rr[1]); }
}
template <int O> __device__ __forceinline__ float shx_max(float v) {
    if constexpr (O < 32) return fmaxf(v, shx<O>(v));
    else { auto rr = __builtin_amdgcn_permlane32_swap(__float_as_uint(v), __float_as_uint(v), false, false); return fmaxf(__uint_as_float(rr[0]), __uint_as_float(rr[1])); }
}
__device__ __forceinline__ float bperm(int src_lane, float v) { return __int_as_float(__builtin_amdgcn_ds_bpermute(src_lane << 2, __float_as_int(v))); }
__device__ __forceinline__ Frame unit_frame(const Frame& F) { Frame f = F; LAS unsigned char* L = F.lds; asm volatile("" : "+s"(L)); int l = F.lane; asm volatile("" : "+v"(l)); f.lds = L; f.lane = l; f.tid = f.wave * 64 + l; return f; }
__device__ __forceinline__ float wave_sum(float v) { v = shx_sum<1>(v); v = shx_sum<2>(v); v = shx_sum<4>(v); v = shx_sum<8>(v); v = shx_sum<16>(v); v = shx_sum<32>(v); return v; }
__device__ __forceinline__ float wave_max(float v) { v = shx_max<1>(v); v = shx_max<2>(v); v = shx_max<4>(v); v = shx_max<8>(v); v = shx_max<16>(v); v = shx_max<32>(v); return v; }

struct TrDesc { const float* src; int ldw; unsigned char* dst; int Kd; };
__device__ __forceinline__ void tr_load(float (&v)[32], const TrDesc& d, int lane) {
#pragma unroll
    for (int i = 0; i < 32; ++i) v[i] = __builtin_nontemporal_load(d.src + (size_t)(2 * i + (lane >> 5)) * d.ldw + (lane & 31));
}
template <bool F8> __device__ __forceinline__ void tr_store(const float (&v)[32], const TrDesc& d, LAS float* scr, int lane, float sc) {
#pragma unroll
    for (int i = 0; i < 32; ++i) scr[(2 * i + (lane >> 5)) * 33 + (lane & 31)] = F8 ? v[i] * sc : v[i];
    LDS_WAIT(); asm volatile("" ::: "memory");
    if constexpr (F8) { const int c = lane & 3;
#pragma unroll
        for (int j = 0; j < 2; ++j) { const int n = (lane >> 2) + 16 * j; const LAS float* s = scr + (16 * c) * 33 + n;
            u32x4 o; o.x = cvt_pk4_fp8(s[0 * 33], s[1 * 33], s[2 * 33], s[3 * 33]); o.y = cvt_pk4_fp8(s[4 * 33], s[5 * 33], s[6 * 33], s[7 * 33]);
            o.z = cvt_pk4_fp8(s[8 * 33], s[9 * 33], s[10 * 33], s[11 * 33]); o.w = cvt_pk4_fp8(s[12 * 33], s[13 * 33], s[14 * 33], s[15 * 33]);
            *(GAS u32x4*)(d.dst + (size_t)n * d.Kd + 16 * c) = o; } }
    else { const int c = lane & 7;
#pragma unroll
        for (int j = 0; j < 4; ++j) { const int n = (lane >> 3) + 8 * j; const LAS float* s = scr + (8 * c) * 33 + n;
            u32x4 o; o.x = cvt_pk_bf16(s[0 * 33], s[1 * 33]); o.y = cvt_pk_bf16(s[2 * 33], s[3 * 33]); o.z = cvt_pk_bf16(s[4 * 33], s[5 * 33]); o.w = cvt_pk_bf16(s[6 * 33], s[7 * 33]);
            *(GAS u32x4*)(d.dst + ((size_t)n * d.Kd + 8 * c) * 2) = o; } }
    LDS_WAIT(); asm volatile("" ::: "memory");
}
__device__ __forceinline__ TrDesc tr_desc(const float* W, int N, int ldw, void* WT, int Kd, int esz, int mode, int bj, int item, int cb = 0) {
    const int nblk = N / 32, kb = item / nblk, nb = item % nblk; const int c0 = cb + 32 * nb;
    int n0 = c0, dr = c0;
    if (mode == 1) { n0 = c0 + (c0 >= 2048 ? 8 : 0);
        if (c0 >= 2048 && c0 < 3072) { const int cl = (c0 - 2048) & 255; dr = (c0 & ~255) + 128 * ((cl >> 5) & 1) + 32 * (cl >> 6); } }
    if (mode == 2) { dr = 256 * (c0 >> 7) + 128 * bj + (c0 & 127); }
    TrDesc d; d.src = W + (size_t)(64 * kb) * ldw + n0; d.ldw = ldw; d.dst = (unsigned char*)WT + ((size_t)dr * Kd + 64 * kb) * esz; d.Kd = Kd; return d;
}
constexpr int P0_IN_BF = (IN8 == 2) ? 2048 : NIN, P0_IN_F8 = (IN8 == 2) ? NIN - 2048 : NIN;
constexpr int P0_I_IN = 16 * (P0_IN_BF / 32), P0_I_IN8 = 16 * (P0_IN_F8 / 32), P0_I_BR = 8 * 32, P0_I_OUT = 16 * 32, P0_I_GU = 16 * (DFF / 32), P0_I_D = (DFF / 64) * 32;
constexpr int P0_GU_MAIN = DUP8 ? 0 : P0_I_GU, P0_D_MAIN = DDN8 ? 0 : P0_I_D;
constexpr int P0_NITEMS = 2 * P0_I_IN + 4 * P0_I_BR + 2 * P0_I_OUT + 2 * P0_GU_MAIN + P0_D_MAIN;
__device__ __forceinline__ TrDesc p0_desc(Frame& F, int it) {
    int r = it;
    if (r < 2 * P0_I_IN) { const int l = r / P0_I_IN; return tr_desc(AIN(3) + (size_t)l * DM * INW, P0_IN_BF, INW, (bf16_t*)(F.ws + WS_WIN) + (size_t)l * NIN * DM, DM, 2, 1, 0, r % P0_I_IN); } r -= 2 * P0_I_IN;
    if (r < 2 * P0_I_BR) { const int l = r / P0_I_BR; return tr_desc(AIN(11) + (size_t)l * 512 * DM, DM, DM, (bf16_t*)(F.ws + WS_WA) + (size_t)l * DM * 512, 512, 2, 0, 0, r % P0_I_BR); } r -= 2 * P0_I_BR;
    if (r < 2 * P0_I_BR) { const int l = r / P0_I_BR; return tr_desc(AIN(12) + (size_t)l * 512 * DM, DM, DM, (bf16_t*)(F.ws + WS_WB) + (size_t)l * DM * 512, 512, 2, 0, 0, r % P0_I_BR); } r -= 2 * P0_I_BR;
    if (r < 2 * P0_I_OUT) { const int l = r / P0_I_OUT; return tr_desc(AIN(13) + (size_t)l * DM * DM, DM, DM, (bf16_t*)(F.ws + WS_WOUT) + (size_t)l * DM * DM, DM, 2, 0, 0, r % P0_I_OUT); } r -= 2 * P0_I_OUT;
    if (r < P0_GU_MAIN) return tr_desc(AIN(15), DFF, DFF, F.ws + WS_WGU, DM, 2, 2, 0, r); r -= P0_GU_MAIN;
    if (r < P0_GU_MAIN) return tr_desc(AIN(16), DFF, DFF, F.ws + WS_WGU, DM, 2, 2, 1, r); r -= P0_GU_MAIN;
    return tr_desc(AIN(17), DM, DM, F.ws + WS_WD, DFF, 2, 0, 0, r);
}
constexpr int PE_I_GU = 16 * (EFF / 32), PE_I_D = (EFF / 64) * 32, PE_I_E = 2 * PE_I_GU + PE_I_D;
__device__ __forceinline__ TrDesc pe_desc(Frame& F, int it, float& sc) {
    const int e = it / PE_I_E; int r = it % PE_I_E;
    if (r < 2 * PE_I_GU) { const int bj = r >= PE_I_GU; r -= bj * PE_I_GU; sc = 64.0f; return tr_desc((bj ? AIN(20) : AIN(19)) + (size_t)e * DM * EFF, EFF, EFF, F.ws + WS_WGUE + (size_t)e * 2 * EFF * DM, DM, 1, 2, bj, r); }
    r -= 2 * PE_I_GU; sc = 128.0f;
    return tr_desc(AIN(21) + (size_t)e * EFF * DM, DM, DM, F.ws + WS_WDE + (size_t)e * DM * EFF, EFF, 1, 0, 0, r);
}
__device__ __forceinline__ void p0_convert(Frame& F) {
    LAS float* scr = (LAS float*)(F.lds + F.wave * 8704);
    const int gw = F.vcu * 8 + F.wave, NGW = F.G * 8;
    float va[32], vb[32]; TrDesc da, db; int it = gw;
    if (it < P0_NITEMS) { da = p0_desc(F, it); tr_load(va, da, F.lane); }
    while (it < P0_NITEMS) {
        int itn = it + NGW; if (itn < P0_NITEMS) { db = p0_desc(F, itn); tr_load(vb, db, F.lane); }
        tr_store<false>(va, da, scr, F.lane, 1.0f); it = itn; if (it >= P0_NITEMS) break;
        itn = it + NGW; if (itn < P0_NITEMS) { da = p0_desc(F, itn); tr_load(va, da, F.lane); }
        tr_store<false>(vb, db, scr, F.lane, 1.0f); it = itn;
    }
#if DUP8
    for (int i8 = gw; i8 < 2 * P0_I_GU; i8 += NGW) { const int bj = i8 >= P0_I_GU; const TrDesc d8 = tr_desc(bj ? AIN(16) : AIN(15), DFF, DFF, F.ws + WS_WGU, DM, 1, 2, bj, i8 - bj * P0_I_GU);
        tr_load(va, d8, F.lane); tr_store<true>(va, d8, scr, F.lane, 64.0f); }
#endif
#if DDN8
    for (int i8 = gw; i8 < P0_I_D; i8 += NGW) { const TrDesc d8 = tr_desc(AIN(17), DM, DM, F.ws + WS_WD, DFF, 1, 0, 0, i8);
        tr_load(va, d8, F.lane); tr_store<true>(va, d8, scr, F.lane, 128.0f); }
#endif
#if OUT8
    for (int i8 = gw; i8 < 2 * P0_I_OUT; i8 += NGW) { const int l = i8 / P0_I_OUT; const TrDesc d8 = tr_desc(AIN(13) + (size_t)l * DM * DM, DM, DM, F.ws + WS_WOUT8 + (size_t)l * DM * DM, DM, 1, 0, 0, i8 % P0_I_OUT);
        tr_load(va, d8, F.lane); tr_store<true>(va, d8, scr, F.lane, 64.0f); }
#endif
#if IN8
    for (int i8 = gw; i8 < 2 * P0_I_IN8; i8 += NGW) { const int l = i8 / P0_I_IN8; const TrDesc d8 = tr_desc(AIN(3) + (size_t)l * DM * INW, P0_IN_F8, INW, F.ws + 541 * MiB + (size_t)l * NIN * DM, DM, 1, 1, 0, i8 % P0_I_IN8, NIN - P0_IN_F8);
        tr_load(va, d8, F.lane); tr_store<true>(va, d8, scr, F.lane, 64.0f); }
#endif
}
__device__ __forceinline__ void p_convert_experts(Frame& F) {
    LAS float* scr = (LAS float*)(F.lds + F.wave * 8704);
    const int gw = F.vcu * 8 + F.wave, NGW = F.G * 8; constexpr int NI = 8 * PE_I_E;
    float va[32], vb[32]; TrDesc da, db; float sa = 1.f, sb = 1.f; int it = gw;
    if (it < NI) { da = pe_desc(F, it, sa); tr_load(va, da, F.lane); }
    while (it < NI) {
        int itn = it + NGW; if (itn < NI) { db = pe_desc(F, itn, sb); tr_load(vb, db, F.lane); }
        tr_store<true>(va, da, scr, F.lane, sa); it = itn; if (it >= NI) break;
        itn = it + NGW; if (itn < NI) { da = pe_desc(F, itn, sa); tr_load(va, da, F.lane); }
        tr_store<true>(vb, db, scr, F.lane, sb); it = itn;
    }
}

__device__ __forceinline__ float wave_sum_fast(float v) {
    v += dppf<0xB1>(v); v += dppf<0x4E>(v); v += dppf<0x141>(v); v += dppf<0x140>(v); v = shx_sum<16>(v); v = shx_sum<32>(v); return v; }
__device__ __forceinline__ float reduce8(const float (&d)[8], int lane) {
    const bool b0 = lane & 1, b1 = lane & 2, b2 = lane & 4;
    float e[4];
#pragma unroll
    for (int i = 0; i < 4; ++i) { const float snd = b0 ? d[i] : d[4 + i], kp = b0 ? d[4 + i] : d[i]; e[i] = kp + dppf<0xB1>(snd); }
    float f[2];
#pragma unroll
    for (int i = 0; i < 2; ++i) { const float snd = b1 ? e[i] : e[2 + i], kp = b1 ? e[2 + i] : e[i]; f[i] = kp + dppf<0x4E>(snd); }
    const float snd = b2 ? f[0] : f[1], kp = b2 ? f[1] : f[0];
    float g = kp + shx<4>(snd);
    g = shx_sum<8>(g); g = shx_sum<16>(g); g = shx_sum<32>(g);
    return g;
}
template <int MODE>
__device__ __forceinline__ void norm_store_row(Frame& F, f32x4 (&v)[4], const f32x4 (&gv)[4], float ss, int m, bool on) {
    const float r = 1.0f / sqrtf(ss * (1.f / DM) + EPS);
#pragma unroll
    for (int j = 0; j < 4; ++j) v[j] = v[j] * r * gv[j];
    if (!on) return;
    if (MODE == 2 || MODE == 3 || (MODE == 0 && IN8)) { u32x2* o4 = (u32x2*)(F.ws + (MODE == 0 ? WS_XN8IN : WS_XN8) + (size_t)m * DM) + F.lane;
#pragma unroll
        for (int j = 0; j < 2; ++j) { u32x2 w; w.x = cvt_pk4_fp8(v[2 * j].x, v[2 * j].y, v[2 * j].z, v[2 * j].w); w.y = cvt_pk4_fp8(v[2 * j + 1].x, v[2 * j + 1].y, v[2 * j + 1].z, v[2 * j + 1].w); o4[64 * j] = w; } }
    if (!(MODE == 2 || MODE == 3 || (MODE == 0 && IN8 == 1))) { u32x4* o8 = (u32x4*)((bf16_t*)(F.ws + WS_XN) + (size_t)m * DM) + F.lane;
#pragma unroll
        for (int j = 0; j < 2; ++j) { u32x4 w; w.x = cvt_pk_bf16(v[2 * j].x, v[2 * j].y); w.y = cvt_pk_bf16(v[2 * j].z, v[2 * j].w); w.z = cvt_pk_bf16(v[2 * j + 1].x, v[2 * j + 1].y); w.w = cvt_pk_bf16(v[2 * j + 1].z, v[2 * j + 1].w); o8[64 * j] = w; } }
}
struct Top2 { int e1, e2; float w1, w2; };
__device__ __forceinline__ Top2 route_top2(float g) {
    float lg[8];
#pragma unroll
    for (int c = 0; c < 8; ++c) lg[c] = __int_as_float(__builtin_amdgcn_readlane(__float_as_int(g), ((c >> 2) & 1) | (c & 2) | ((c & 1) << 2)));
    Top2 t; t.e1 = 0; float v1 = lg[0];
#pragma unroll
    for (int c = 1; c < 8; ++c) if (lg[c] > v1) { v1 = lg[c]; t.e1 = c; }
    t.e2 = -1; float v2 = -INFINITY;
#pragma unroll
    for (int c = 0; c < 8; ++c) if (c != t.e1 && lg[c] > v2) { v2 = lg[c]; t.e2 = c; }
    const float ex = __expf(v2 - v1); t.w1 = 1.0f / (1.0f + ex); t.w2 = ex * t.w1; return t;
}
constexpr int RT_CNT = 32768, RT_BASE = RT_CNT + 64, RT_LIST = RT_CNT + 256, RT_CAP = 2048;
struct RouteAcc { int slot; };
__device__ __forceinline__ void route_park(Frame& F, int slot, int m, int ge, float w) {
    LAS unsigned* lc = (LAS unsigned*)(F.lds + RT_CNT);
    const unsigned lpos = __hip_atomic_fetch_add(lc + (ge & 255), 1u, __ATOMIC_RELAXED, __HIP_MEMORY_SCOPE_WORKGROUP);
    LAS int* e = (LAS int*)(F.lds + RT_LIST) + 4 * slot; e[0] = m; e[1] = ge; e[2] = __float_as_int(w); e[3] = (int)lpos;
}
__device__ __forceinline__ void route_commit(Frame& F, int nslot) {
    __syncthreads();
    LAS unsigned* lc = (LAS unsigned*)(F.lds + RT_CNT); LAS unsigned* lb = (LAS unsigned*)(F.lds + RT_BASE);
    if (F.tid < 16) { const unsigned n = lc[F.tid]; lb[F.tid] = n ? __hip_atomic_fetch_add(((unsigned*)F.ws + CW_MOE + 64 * F.tid), n, __ATOMIC_RELAXED, __HIP_MEMORY_SCOPE_AGENT) : 0u; }
    __syncthreads();
    for (int i = F.tid; i < nslot; i += 512) { const LAS int* e = (const LAS int*)(F.lds + RT_LIST) + 4 * i; const int ge = e[1];
        if (ge >= 0) { const int m = e[0], g = ge & 255, rk = ge >> 8; const unsigned pos = lb[g] + (unsigned)e[3];
            ((int*)(F.ws + WS_MIDX))[(size_t)g * 65536 + pos] = m; ((float*)(F.ws + WS_MWGT))[(size_t)g * 65536 + pos] = __int_as_float(e[2]);
            ((unsigned*)(F.ws + WS_RINFO))[(size_t)m * 2 + rk] = (unsigned)g | (pos << 4); } }
}
template <int MODE>
__device__ __forceinline__ void norm_rows2(Frame& F, f32x4 (&va)[4], f32x4 (&vb)[4], const f32x4 (&gv)[4], float sa, float sb, int ma, int mb, bool has2, const LAS float* w8, const float* bi, const float* bf, RouteAcc& R, int it) {
    norm_store_row<MODE>(F, va, gv, sa, ma, true); norm_store_row<MODE>(F, vb, gv, sb, mb, has2);
    if (MODE != 1 && MODE != 3) {
        f32x2 da[4], db[4];
#pragma unroll
        for (int c = 0; c < 4; ++c) { da[c] = f32x2{0.f, 0.f}; db[c] = f32x2{0.f, 0.f}; }
#pragma unroll
        for (int j = 0; j < 4; ++j)
#pragma unroll
            for (int q = 0; q < 4; ++q) { const LAS f32x4* wp = (const LAS f32x4*)w8 + ((j * 4 + q) * 2) * 64 + F.lane; const f32x4 wa = wp[0], wb = wp[64];
                const f32x2 w01 = {wa.x, wa.y}, w23 = {wa.z, wa.w}, w45 = {wb.x, wb.y}, w67 = {wb.z, wb.w};
                const f32x2 ya = {va[j][q], va[j][q]}, yb = {vb[j][q], vb[j][q]};
                da[0] += ya * w01; da[1] += ya * w23; da[2] += ya * w45; da[3] += ya * w67;
                db[0] += yb * w01; db[1] += yb * w23; db[2] += yb * w45; db[3] += yb * w67; }
        const float d0[8] = {da[0].x, da[0].y, da[1].x, da[1].y, da[2].x, da[2].y, da[3].x, da[3].y};
        const float d1[8] = {db[0].x, db[0].y, db[1].x, db[1].y, db[2].x, db[2].y, db[3].x, db[3].y};
        const float ga = reduce8(d0, F.lane), gb = reduce8(d1, F.lane);
        const int myc = 4 * (F.lane & 1) + (F.lane & 2) + ((F.lane >> 2) & 1);
        if (MODE == 0) {
            if (F.lane < 16 && (has2 || F.lane < 8)) { const float g = F.lane < 8 ? ga : gb; float o;
                if (myc < 4) o = g + bi[myc];
                else { const float fp = g + bf[myc - 4]; o = fminf(fp, 0.f) - __logf(1.0f + __expf(-fabsf(fp))); }
                ((float*)(F.ws + WS_GATES))[(size_t)(F.lane < 8 ? ma : mb) * 8 + myc] = o; }
        } else {
            const Top2 ta = route_top2(ga), tb = route_top2(gb);
            if (F.lane < 4 && (has2 || F.lane < 2)) { const bool rb = F.lane >= 2; const int rk = F.lane & 1;
                const int e = rb ? (rk ? tb.e2 : tb.e1) : (rk ? ta.e2 : ta.e1); const float w = rb ? (rk ? tb.w2 : tb.w1) : (rk ? ta.w2 : ta.w1);
                if (R.slot + 4 <= RT_CAP) route_park(F, R.slot + F.lane, rb ? mb : ma, e | (rk << 8), w);
                else { const int m = rb ? mb : ma;
                    const unsigned pos = __hip_atomic_fetch_add(((unsigned*)F.ws + CW_MOE + 64 * e), 1u, __ATOMIC_RELAXED, __HIP_MEMORY_SCOPE_AGENT);
                    ((int*)(F.ws + WS_MIDX))[(size_t)e * 65536 + pos] = m; ((float*)(F.ws + WS_MWGT))[(size_t)e * 65536 + pos] = w;
                    ((unsigned*)(F.ws + WS_RINFO))[(size_t)m * 2 + rk] = (unsigned)e | (pos << 4); } }
            R.slot += 4;
        }
    }
}
template <int MODE>
__device__ __forceinline__ void norm_pass(Frame& F, const void* Xv, bool xbf, const float* gain, const float* W8, int ldw8, const float* bi, const float* bf) {
    LAS float* w8 = (LAS float*)F.lds;
    if (MODE != 1 && MODE != 3) {
#pragma unroll 4
        for (int k = 0; k < 16; ++k) { const int i = F.tid + 512 * k, kk = i >> 3, c = i & 7;
            w8[((((2 * (kk >> 9) + ((kk >> 2) & 1)) * 4 + (kk & 3)) * 2 + (c >> 2)) * 64 + ((kk & 511) >> 3)) * 4 + (c & 3)] = W8[(size_t)kk * ldw8 + c]; }
        __syncthreads();
    }
    const int gw = F.vcu * 8 + F.wave, NGW = F.G * 8;
    f32x4 gv[4];
#pragma unroll
    for (int j = 0; j < 4; ++j) gv[j] = *(const f32x4*)(gain + 512 * (j >> 1) + 8 * F.lane + 4 * (j & 1));
    RouteAcc R; R.slot = 0; int it = 0;
    if (MODE == 2) {
        const int iters = (MTOK - gw + 2 * NGW - 1) / (2 * NGW), spw = 4 * ((MTOK + 2 * NGW - 1) / (2 * NGW)); (void)iters;
        R.slot = F.wave * spw;
        if (F.tid < 16) ((LAS unsigned*)(F.lds + RT_CNT))[F.tid] = 0u;
        for (int i = F.tid; i < 8 * spw && i < RT_CAP; i += 512) ((LAS int*)(F.lds + RT_LIST))[4 * i + 1] = -1;
        __syncthreads();
    }
    for (int m = gw; m < MTOK; m += 2 * NGW, ++it) {
        const int m2 = m + NGW; const bool has2 = m2 < MTOK; const int mb = has2 ? m2 : m;
        f32x4 va[4], vb[4]; float sa = 0.f, sb = 0.f;
        if (xbf) { const bf16_t* xa = (const bf16_t*)Xv + (size_t)m * XBP + xb_col(8 * F.lane); const bf16_t* xb = (const bf16_t*)Xv + (size_t)mb * XBP + xb_col(8 * F.lane);
            u32x4 ra[2], rb[2];
#pragma unroll
            for (int j = 0; j < 2; ++j) { ra[j] = *(const u32x4*)(xa + 1024 * j); rb[j] = *(const u32x4*)(xb + 1024 * j); }
#pragma unroll
            for (int j = 0; j < 2; ++j) {
                va[2 * j] = (f32x4){bf_lo(ra[j].x), bf_hi(ra[j].x), bf_lo(ra[j].y), bf_hi(ra[j].y)}; va[2 * j + 1] = (f32x4){bf_lo(ra[j].z), bf_hi(ra[j].z), bf_lo(ra[j].w), bf_hi(ra[j].w)};
                vb[2 * j] = (f32x4){bf_lo(rb[j].x), bf_hi(rb[j].x), bf_lo(rb[j].y), bf_hi(rb[j].y)}; vb[2 * j + 1] = (f32x4){bf_lo(rb[j].z), bf_hi(rb[j].z), bf_lo(rb[j].w), bf_hi(rb[j].w)}; }
        } else { const f32x4* xa = (const f32x4*)((const float*)Xv + (size_t)m * DM) + 2 * F.lane; const f32x4* xb = (const f32x4*)((const float*)Xv + (size_t)mb * DM) + 2 * F.lane;
#pragma unroll
            for (int j = 0; j < 4; ++j) { va[j] = xa[128 * (j >> 1) + (j & 1)]; vb[j] = xb[128 * (j >> 1) + (j & 1)]; } }
#pragma unroll
        for (int j = 0; j < 4; ++j) { sa += (va[j].x * va[j].x + va[j].y * va[j].y) + (va[j].z * va[j].z + va[j].w * va[j].w); sb += (vb[j].x * vb[j].x + vb[j].y * vb[j].y) + (vb[j].z * vb[j].z + vb[j].w * vb[j].w); }
        sa = wave_sum_fast(sa); sb = wave_sum_fast(sb);
        norm_rows2<MODE>(F, va, vb, gv, sa, sb, m, mb, has2, w8, bi, bf, R, it);
    }
    if (MODE == 2) { const int spw = 4 * ((MTOK + 2 * NGW - 1) / (2 * NGW)); route_commit(F, 8 * spw < RT_CAP ? 8 * spw : RT_CAP); }
    __syncthreads();
}

__device__ __forceinline__ void moe_place(Frame& F) {
    const unsigned* cnt = (const unsigned*)F.ws + CW_MOE;
    const int mine = ((int)cnt[64 * (F.lane & 15)] + 255) >> 8; int pre = 0, acc_ = 0;
#pragma unroll
    for (int g = 0; g < 16; ++g) { if ((F.lane & 15) == g) pre = acc_; acc_ += __builtin_amdgcn_readlane(mine, g); }
    const int gw = F.vcu * 8 + F.wave, NGW = F.G * 8;
    unsigned ninfo[4];
#pragma unroll
    for (int i = 0; i < 4; ++i) { const int pr = gw + i * NGW; ninfo[i] = (pr < 2 * MTOK) ? ((const unsigned*)(F.ws + WS_RINFO))[pr] : 0u; }
    for (int pr0 = gw; pr0 < 2 * MTOK; pr0 += 4 * NGW) {
        unsigned info[4]; u32x4 v[4];
#pragma unroll
        for (int i = 0; i < 4; ++i) info[i] = ninfo[i];
#pragma unroll
        for (int i = 0; i < 4; ++i) { const int pr = pr0 + (4 + i) * NGW; ninfo[i] = (pr < 2 * MTOK) ? ((const unsigned*)(F.ws + WS_RINFO))[pr] : 0u; }
#pragma unroll
        for (int i = 0; i < 4; ++i) { const int pr = pr0 + i * NGW; v[i] = *((const u32x4*)(F.ws + WS_XN8 + (size_t)((pr < 2 * MTOK ? pr : gw) >> 1) * DM) + F.lane); }
#pragma unroll
        for (int i = 0; i < 4; ++i) { const int pr = pr0 + i * NGW; const int g = info[i] & 15, pos = (int)(info[i] >> 4);
            const int base = __builtin_amdgcn_readlane(pre, __builtin_amdgcn_readfirstlane(g));
            if (pr < 2 * MTOK) *((u32x4*)(F.ws + WS_XN8S + ((size_t)base * 256 + pos) * DM) + F.lane) = v[i]; }
    }
}

__device__ __forceinline__ void moe_combine(Frame& F, float* X) {
    const unsigned* cnt = (const unsigned*)F.ws + CW_MOE;
    const int mine = ((int)cnt[64 * (F.lane & 15)] + 255) >> 8; int pre = 0, acc_ = 0;
#pragma unroll
    for (int g = 0; g < 16; ++g) { if ((F.lane & 15) == g) pre = acc_; acc_ += __builtin_amdgcn_readlane(mine, g); }
    const int gw = F.vcu * 8 + F.wave, NGW = F.G * 8;
    const unsigned* RI = (const unsigned*)(F.ws + WS_RINFO); const float* WG = (const float*)(F.ws + WS_MWGT); const bf16_t* YP = (const bf16_t*)(F.ws + WS_YP); const bf16_t* YP2 = (const bf16_t*)(F.ws + WS_YP2);
    const bool split = (F.G % 8 == 0); const int ptot = __builtin_amdgcn_readfirstlane(acc_), gq = F.G >> 3;
    unsigned na[2] = {0u, 0u}, nb[2] = {0u, 0u};
    if (gw < MTOK) { const int t1 = (gw + NGW < MTOK) ? gw + NGW : gw; na[0] = RI[2 * gw]; nb[0] = RI[2 * gw + 1]; na[1] = RI[2 * t1]; nb[1] = RI[2 * t1 + 1]; }
    for (int tb = gw; tb < MTOK; tb += 2 * NGW) {
        int tt[2]; tt[0] = tb; tt[1] = (tb + NGW < MTOK) ? tb + NGW : tb;
        unsigned ia[2], ib[2];
#pragma unroll
        for (int k = 0; k < 2; ++k) { ia[k] = na[k]; ib[k] = nb[k]; }
        { const int tn = tb + 2 * NGW; if (tn < MTOK) { const int t1 = (tn + NGW < MTOK) ? tn + NGW : tn; na[0] = RI[2 * tn]; nb[0] = RI[2 * tn + 1]; na[1] = RI[2 * t1]; nb[1] = RI[2 * t1 + 1]; } }
        float w0[2], w1[2]; const u32x2* y0[2]; const u32x2* y1[2]; const u32x2* xc[2]; const u32x2* z0[2]; const u32x2* z1[2]; int rr0[2], rr1[2];
#pragma unroll
        for (int k = 0; k < 2; ++k) { const int t = tt[k];
            const int g0 = __builtin_amdgcn_readfirstlane((int)(ia[k] & 15)), p0 = __builtin_amdgcn_readfirstlane((int)(ia[k] >> 4)), g1 = __builtin_amdgcn_readfirstlane((int)(ib[k] & 15)), p1 = __builtin_amdgcn_readfirstlane((int)(ib[k] >> 4));
            w0[k] = WG[g0 * 65536 + p0]; w1[k] = WG[g1 * 65536 + p1];
            const size_t r0 = (size_t)__builtin_amdgcn_readlane(pre, g0) * 256 + p0, r1 = (size_t)__builtin_amdgcn_readlane(pre, g1) * 256 + p1;
            y0[k] = (const u32x2*)(YP + r0 * DM) + F.lane; y1[k] = (const u32x2*)(YP + r1 * DM) + F.lane;
            rr0[k] = (int)r0; rr1[k] = (int)r1;
            xc[k] = (const u32x2*)((const bf16_t*)X + (size_t)t * XBP + xb_col(4 * F.lane)); }
        u32x2 xv[2][4], a[2][4], b[2][4];
#pragma unroll
        for (int k = 0; k < 2; ++k)
#pragma unroll
            for (int j = 0; j < 4; ++j) { xv[k][j] = xc[k][128 * j]; a[k][j] = y0[k][64 * j]; b[k][j] = y1[k][64 * j]; }
#pragma unroll
        for (int k = 0; k < 2; ++k) {
            z0[k] = nullptr; z1[k] = nullptr;
            if (split) { const int q0 = rr0[k] >> 8, q1 = rr1[k] >> 8, x0 = (8 * q0 + 7) / ptot, x1 = (8 * q1 + 7) / ptot, o0 = q0 - ((x0 * ptot) >> 3) - gq, o1 = q1 - ((x1 * ptot) >> 3) - gq;
                if (o0 >= 0) z0[k] = (const u32x2*)(YP2 + ((size_t)(x0 * 4 + o0) * 256 + (rr0[k] & 255)) * DM) + F.lane;
                if (o1 >= 0) z1[k] = (const u32x2*)(YP2 + ((size_t)(x1 * 4 + o1) * 256 + (rr1[k] & 255)) * DM) + F.lane; } }
#pragma unroll
        for (int k = 0; k < 2; ++k) {
            if (z0[k] != nullptr) {
#pragma unroll
                for (int j = 0; j < 4; ++j) { const u32x2 z = z0[k][64 * j]; a[k][j].x = cvt_pk_bf16(bf_lo(a[k][j].x) + bf_lo(z.x), bf_hi(a[k][j].x) + bf_hi(z.x)); a[k][j].y = cvt_pk_bf16(bf_lo(a[k][j].y) + bf_lo(z.y), bf_hi(a[k][j].y) + bf_hi(z.y)); } }
            if (z1[k] != nullptr) {
#pragma unroll
                for (int j = 0; j < 4; ++j) { const u32x2 z = z1[k][64 * j]; b[k][j].x = cvt_pk_bf16(bf_lo(b[k][j].x) + bf_lo(z.x), bf_hi(b[k][j].x) + bf_hi(z.x)); b[k][j].y = cvt_pk_bf16(bf_lo(b[k][j].y) + bf_lo(z.y), bf_hi(b[k][j].y) + bf_hi(z.y)); } } }
#pragma unroll
        for (int k = 0; k < 2; ++k) { if (k == 1 && tt[1] == tt[0]) break;
            f32x4* xr = (f32x4*)(X + (size_t)tt[k] * DM) + F.lane;
#pragma unroll
            for (int j = 0; j < 4; ++j) { f32x4 o = {bf_lo(xv[k][j].x), bf_hi(xv[k][j].x), bf_lo(xv[k][j].y), bf_hi(xv[k][j].y)};
                o.x += w0[k] * bf_lo(a[k][j].x) + w1[k] * bf_lo(b[k][j].x); o.y += w0[k] * bf_hi(a[k][j].x) + w1[k] * bf_hi(b[k][j].x); o.z += w0[k] * bf_lo(a[k][j].y) + w1[k] * bf_lo(b[k][j].y); o.w += w0[k] * bf_hi(a[k][j].y) + w1[k] * bf_hi(b[k][j].y);
                xr[64 * j] = o; } }
    }
}

__device__ __forceinline__ void moba_prep_item(const Frame& F0, int it, const float* qg, const float* kg) {
    Frame F = unit_frame(F0);
    const int h = it & 7, blk = (it >> 3) & 15, b = it >> 7;
    const size_t r0 = (size_t)b * SEQ + blk * ABLK;
    const int row = F.tid >> 1, half = F.tid & 1;
    LAS float* part = (LAS float*)F.lds;
    bf16_t* qp = (bf16_t*)(F.ws + WS_AQ) + (r0 + row) * 512 + h * 64 + half * 32;
    bf16_t* kp = (bf16_t*)(F.ws + WS_AK) + (r0 + row) * 512 + h * 64 + half * 32;
    float gq[32], gk[32];
#pragma unroll
    for (int i = 0; i < 32; ++i) { gq[i] = qg[half * 32 + i] * QSCALE; gk[i] = kg[half * 32 + i]; }
    {
        u32x4 w[4]; float x[32]; float ss = 0.f;
#pragma unroll
        for (int i = 0; i < 4; ++i) w[i] = ((const u32x4*)qp)[i];
#pragma unroll
        for (int i = 0; i < 4; ++i) { x[8 * i + 0] = bf_lo(w[i].x); x[8 * i + 1] = bf_hi(w[i].x); x[8 * i + 2] = bf_lo(w[i].y); x[8 * i + 3] = bf_hi(w[i].y); x[8 * i + 4] = bf_lo(w[i].z); x[8 * i + 5] = bf_hi(w[i].z); x[8 * i + 6] = bf_lo(w[i].w); x[8 * i + 7] = bf_hi(w[i].w); }
#pragma unroll
        for (int i = 0; i < 32; ++i) ss += x[i] * x[i];
        ss = shx_sum<1>(ss);
        const float r = 1.0f / sqrtf(ss * (1.f / 64.f) + EPS);
#pragma unroll
        for (int i = 0; i < 4; ++i) { u32x4 o; o.x = cvt_pk_bf16(x[8 * i] * r * gq[8 * i], x[8 * i + 1] * r * gq[8 * i + 1]); o.y = cvt_pk_bf16(x[8 * i + 2] * r * gq[8 * i + 2], x[8 * i + 3] * r * gq[8 * i + 3]);
            o.z = cvt_pk_bf16(x[8 * i + 4] * r * gq[8 * i + 4], x[8 * i + 5] * r * gq[8 * i + 5]); o.w = cvt_pk_bf16(x[8 * i + 6] * r * gq[8 * i + 6], x[8 * i + 7] * r * gq[8 * i + 7]); ((u32x4*)qp)[i] = o; }
    }
    {
        u32x4 w[4]; float x[32]; float ss = 0.f;
#pragma unroll
        for (int i = 0; i < 4; ++i) w[i] = ((const u32x4*)kp)[i];
#pragma unroll
        for (int i = 0; i < 4; ++i) { x[8 * i + 0] = bf_lo(w[i].x); x[8 * i + 1] = bf_hi(w[i].x); x[8 * i + 2] = bf_lo(w[i].y); x[8 * i + 3] = bf_hi(w[i].y); x[8 * i + 4] = bf_lo(w[i].z); x[8 * i + 5] = bf_hi(w[i].z); x[8 * i + 6] = bf_lo(w[i].w); x[8 * i + 7] = bf_hi(w[i].w); }
#pragma unroll
        for (int i = 0; i < 32; ++i) ss += x[i] * x[i];
        ss = shx_sum<1>(ss);
        const float r = 1.0f / sqrtf(ss * (1.f / 64.f) + EPS);
#pragma unroll
        for (int i = 0; i < 32; ++i) x[i] = x[i] * r * gk[i];
#pragma unroll
        for (int i = 0; i < 4; ++i) { u32x4 o; o.x = cvt_pk_bf16(x[8 * i], x[8 * i + 1]); o.y = cvt_pk_bf16(x[8 * i + 2], x[8 * i + 3]); o.z = cvt_pk_bf16(x[8 * i + 4], x[8 * i + 5]); o.w = cvt_pk_bf16(x[8 * i + 6], x[8 * i + 7]); ((u32x4*)kp)[i] = o; }
#pragma unroll
        for (int i = 0; i < 32; ++i) { float s = x[i]; s = shx_sum<2>(s); s = shx_sum<4>(s); s = shx_sum<8>(s); s = shx_sum<16>(s); s = shx_sum<32>(s); x[i] = s; }
        if (F.lane < 2) {
#pragma unroll
            for (int i = 0; i < 32; ++i) part[F.wave * 64 + half * 32 + i] = x[i]; }
    }
    __syncthreads();
    if (F.tid < 64) { float s = 0.f;
#pragma unroll
        for (int w = 0; w < 8; ++w) s += part[w * 64 + F.tid];
        ((float*)(F.ws + WS_KMEAN))[((size_t)(b * 8 + h) * 16 + blk) * 64 + F.tid] = s * (1.f / 256.f); }
    __syncthreads();
}

constexpr int ML_TILE = 128 * 272;
constexpr int ML_Q = 0, ML_K = ML_TILE, ML_VT = 2 * ML_TILE, ML_CT = 3 * ML_TILE, ML_TAB = 4 * ML_TILE;
constexpr int MT_BB = 0, MT_U = 1, MT_M = 2, MT_WST = 3, MT_LIM = 4, MT_N = 5, MT_QN = 6, MT_INV = 7, MT_WS = 8, MT_SC = 9;
static_assert(ML_TAB + 10 * 512 <= MISC_OFF, "mLSTM LDS map");

struct MlGates { float i0, i1, f0, f1; };
__device__ __forceinline__ void ml_gates(const Frame& F, MlGates& g, size_t r0, int h) {
    const float* G = (const float*)(F.ws + WS_GATES); const int l = F.lane;
    g.i0 = G[(r0 + 2 * l) * 8 + h]; g.i1 = G[(r0 + 2 * l + 1) * 8 + h]; g.f0 = G[(r0 + 2 * l) * 8 + 4 + h]; g.f1 = G[(r0 + 2 * l + 1) * 8 + 4 + h];
}
__device__ __forceinline__ void ml_scalars(Frame& F, const MlGates& g, LAS float* tab, float& umax_out, float& blast_out) {
    const int l = F.lane;
    const float i0 = g.i0, i1 = g.i1, f0 = g.f0, f1 = g.f1;
    float ps = f0 + f1, sc = ps;
#pragma unroll
    for (int o = 1; o < 64; o <<= 1) { const float t = bperm(l >= o ? l - o : l, sc); if (l >= o) sc += t; }
    const float ex = sc - ps;
    const float b0 = ex + f0, b1 = ex + ps;
    const float u0 = i0 - b0, u1 = i1 - b1;
    float pm = fmaxf(u0, u1), sm = pm;
#pragma unroll
    for (int o = 1; o < 64; o <<= 1) { const float t = bperm(l >= o ? l - o : l, sm); if (l >= o) sm = fmaxf(sm, t); }
    const float pe = bperm(l >= 1 ? l - 1 : l, sm);
    const float p0 = (l == 0) ? u0 : fmaxf(pe, u0), p1 = fmaxf(p0, u1);
    tab[MT_BB * 128 + 2 * l] = b0; tab[MT_BB * 128 + 2 * l + 1] = b1;
    tab[MT_U * 128 + 2 * l] = u0; tab[MT_U * 128 + 2 * l + 1] = u1;
    tab[MT_M * 128 + 2 * l] = p0; tab[MT_M * 128 + 2 * l + 1] = p1;
    umax_out = __int_as_float(__builtin_amdgcn_readlane(__float_as_int(sm), 63)); blast_out = __int_as_float(__builtin_amdgcn_readlane(__float_as_int(sc), 63));
}
constexpr int ML_CW = ML_TAB + 10 * 512;
constexpr int ML_NG = ML_CW + 5120;
static_assert(ML_NG + 2048 <= LDS_UNITS, "mLSTM LDS map");
struct MlRaw7 { u32x4 x[7]; };
struct MlRaw4 { u32x4 x[4]; };
__device__ __forceinline__ void ml_load_conv(const Frame& F, MlRaw7& R, size_t r0, int tpos0, int col0) {
    const bf16_t* src = (const bf16_t*)(F.ws + WS_MQK); const int cg = F.tid & 15, rg = F.tid >> 4;
#pragma unroll
    for (int j = 0; j < 7; ++j) { const int rr = 4 * rg - 3 + j;
        R.x[j] = (tpos0 + rr >= 0) ? *(const u32x4*)(src + (size_t)((long)r0 + rr) * 1024 + col0 + cg * 8) : (u32x4){0u, 0u, 0u, 0u}; }
}
__device__ __forceinline__ void ml_load_rows(const Frame& F, MlRaw4& R, const bf16_t* src, size_t r0, int pitch, int col0) {
    const int cg = F.tid & 15, rg = F.tid >> 4;
#pragma unroll
    for (int rr = 0; rr < 4; ++rr) R.x[rr] = *(const u32x4*)(src + (r0 + 4 * rg + rr) * pitch + col0 + cg * 8);
}
__device__ __forceinline__ void ml_store_conv(const Frame& F, const MlRaw7& R, LAS unsigned char* tile, const LAS float* cwt, float scale) {
    const int cg = F.tid & 15, rg = F.tid >> 4;
    float w[5][8];
#pragma unroll
    for (int j = 0; j < 5; ++j) { const f32x4 a = *(const LAS f32x4*)(cwt + j * 128 + cg * 8), b = *(const LAS f32x4*)(cwt + j * 128 + cg * 8 + 4);
        w[j][0] = a.x; w[j][1] = a.y; w[j][2] = a.z; w[j][3] = a.w; w[j][4] = b.x; w[j][5] = b.y; w[j][6] = b.z; w[j][7] = b.w; }
    float x[7][8];
#pragma unroll
    for (int j = 0; j < 7; ++j) { const u32x4 v = R.x[j];
        x[j][0] = bf_lo(v.x); x[j][1] = bf_hi(v.x); x[j][2] = bf_lo(v.y); x[j][3] = bf_hi(v.y); x[j][4] = bf_lo(v.z); x[j][5] = bf_hi(v.z); x[j][6] = bf_lo(v.w); x[j][7] = bf_hi(v.w); }
#pragma unroll
    for (int rr = 0; rr < 4; ++rr) { float y[8];
#pragma unroll
        for (int i = 0; i < 8; i += 2) { f32x2 a;
            a.x = w[4][i] + w[0][i] * x[rr][i] + w[1][i] * x[rr + 1][i] + w[2][i] * x[rr + 2][i] + w[3][i] * x[rr + 3][i];
            a.y = w[4][i + 1] + w[0][i + 1] * x[rr][i + 1] + w[1][i + 1] * x[rr + 1][i + 1] + w[2][i + 1] * x[rr + 2][i + 1] + w[3][i + 1] * x[rr + 3][i + 1];
            f32x2 e = a * (-LOG2E); e.x = __builtin_amdgcn_exp2f(e.x); e.y = __builtin_amdgcn_exp2f(e.y); e = e + 1.0f; e.x = __builtin_amdgcn_rcpf(e.x); e.y = __builtin_amdgcn_rcpf(e.y);
            const f32x2 o2 = (a * scale) * e; y[i] = o2.x; y[i + 1] = o2.y; }
        u32x4 o; o.x = cvt_pk_bf16(y[0], y[1]); o.y = cvt_pk_bf16(y[2], y[3]); o.z = cvt_pk_bf16(y[4], y[5]); o.w = cvt_pk_bf16(y[6], y[7]);
        *(LAS u32x4*)(tile + (4 * rg + rr) * 272 + cg * 16) = o; }
}
__device__ __forceinline__ void ml_store_rows(const Frame& F, const MlRaw4& R, LAS unsigned char* tile, const LAS float* rs) {
    const int cg = F.tid & 15, rg = F.tid >> 4;
#pragma unroll
    for (int rr = 0; rr < 4; ++rr) { const int row = 4 * rg + rr; u32x4 v = R.x[rr];
        if (rs) { const float sc = rs[row];
            v.x = cvt_pk_bf16(bf_lo(v.x) * sc, bf_hi(v.x) * sc); v.y = cvt_pk_bf16(bf_lo(v.y) * sc, bf_hi(v.y) * sc); v.z = cvt_pk_bf16(bf_lo(v.z) * sc, bf_hi(v.z) * sc); v.w = cvt_pk_bf16(bf_lo(v.w) * sc, bf_hi(v.w) * sc); }
        *(LAS u32x4*)(tile + row * 272 + cg * 16) = v; }
}
struct MlCw { float v[3]; };
__device__ __forceinline__ void ml_cw_load(const Frame& F, MlCw& c, const float* cw, const float* cb, int h) {
#pragma unroll
    for (int k = 0; k < 3; ++k) { const int i = F.tid + 512 * k; const int t = i / 640, r = i - t * 640, j = r >> 7, d = r & 127; const int ch = t * 512 + h * 128 + d;
        c.v[k] = (i < 1280) ? ((j < 4) ? cw[j * 1024 + ch] : cb[ch]) : 0.f; }
}
__device__ __forceinline__ void ml_cw_store(const Frame& F, const MlCw& c, LAS float* cwt) {
#pragma unroll
    for (int k = 0; k < 3; ++k) { const int i = F.tid + 512 * k; if (i < 1280) cwt[i] = c.v[k]; }
}
#define SYNC_SB() do { __syncthreads(); __builtin_amdgcn_sched_barrier(0); } while (0)
#define MFMA32(a, b, c) __builtin_amdgcn_mfma_f32_32x32x16_bf16(a, b, c, 0, 0, 0)
typedef short v4i16_ml __attribute__((ext_vector_type(4)));
__device__ __forceinline__ bf16x8 ml_frag_nat(const LAS unsigned char* T, int i0, int k0, int lane) { return *(const LAS bf16x8*)(T + (i0 + (lane & 31)) * 272 + (k0 + 8 * (lane >> 5)) * 2); }
__device__ __forceinline__ bf16x8 ml_frag_tr(const LAS unsigned char* T, int i0, int k0, int lane) {
    const LAS unsigned char* a = T + (k0 + 8 * (lane >> 5) + ((lane & 15) >> 2)) * 272 + (i0 + 16 * ((lane >> 4) & 1) + 4 * (lane & 3)) * 2;
    const s16x4 lo = __builtin_bit_cast(s16x4, __builtin_amdgcn_ds_read_tr16_b64_v4i16((LAS v4i16_ml*)a)), hi = __builtin_bit_cast(s16x4, __builtin_amdgcn_ds_read_tr16_b64_v4i16((LAS v4i16_ml*)(a + 4 * 272)));
    return (bf16x8){lo[0], lo[1], lo[2], lo[3], hi[0], hi[1], hi[2], hi[3]};
}
template <bool TRA, bool TRB>
__device__ __forceinline__ void ml_mma(const LAS unsigned char* TA, const LAS unsigned char* TB, int rb, int cb, int lane, f32x16& c0, f32x16& c1) {
#pragma unroll 2
    for (int k = 0; k < 8; ++k) {
        const bf16x8 a = TRA ? ml_frag_tr(TA, rb, 16 * k, lane) : ml_frag_nat(TA, rb, 16 * k, lane);
        const bf16x8 b0 = TRB ? ml_frag_tr(TB, cb, 16 * k, lane) : ml_frag_nat(TB, cb, 16 * k, lane);
        const bf16x8 b1 = TRB ? ml_frag_tr(TB, cb + 32, 16 * k, lane) : ml_frag_nat(TB, cb + 32, 16 * k, lane);
        c0 = MFMA32(a, b0, c0); c1 = MFMA32(a, b1, c1);
    }
}

__device__ __forceinline__ float ml_dot32(const LAS unsigned char* row, const LAS float* tabv) {
    float s = 0.f;
#pragma unroll 1
    for (int q = 0; q < 4; ++q) { const u32x4 w = *(const LAS u32x4*)(row + q * 16);
        if (tabv) { const f32x4 a = *(const LAS f32x4*)(tabv + q * 8), b = *(const LAS f32x4*)(tabv + q * 8 + 4);
            s += bf_lo(w.x) * a.x + bf_hi(w.x) * a.y + bf_lo(w.y) * a.z + bf_hi(w.y) * a.w + bf_lo(w.z) * b.x + bf_hi(w.z) * b.y + bf_lo(w.w) * b.z + bf_hi(w.w) * b.w; }
        else s += (bf_lo(w.x) + bf_hi(w.x)) + (bf_lo(w.y) + bf_hi(w.y)) + (bf_lo(w.z) + bf_hi(w.z)) + (bf_lo(w.w) + bf_hi(w.w)); }
    return s;
}
struct MlPre1 { MlRaw7 kx; MlRaw4 vx; MlCw cw; MlGates g; };
template <int PART> __device__ __forceinline__ void ml1_issue(const Frame& F, MlPre1& P, int unit, const float* cw, const float* cb) {
    const int c = unit & 31, h = (unit >> 5) & 3, b = unit >> 7; const size_t r0 = (size_t)b * SEQ + c * MCH;
    if (PART <= 0) {
        ml_cw_load(F, P.cw, cw, cb, h); ml_gates(F, P.g, r0, h);
        __builtin_amdgcn_sched_barrier(0);
        ml_load_conv(F, P.kx, r0, c * MCH, 512 + h * 128); }
    if (PART < 0 || PART == 1) ml_load_rows(F, P.vx, (const bf16_t*)(F.ws + WS_MV), r0, 512, h * 128);
}
__device__ __forceinline__ void mlstm_local_phase(const Frame& F0, int G, const float* cw, const float* cb) {
    MlPre1 P; int unit = F0.vcu;
    if (unit < 1024) ml1_issue<-1>(F0, P, unit, cw, cb);
#pragma unroll 1
    for (; unit < 1024; unit += G) {
    Frame F = unit_frame(F0);
    LAS float* tab = (LAS float*)(F.lds + ML_TAB); LAS float* cwt = (LAS float*)(F.lds + ML_CW);
    ml_cw_store(F, P.cw, cwt);
    if (F.wave == 0) { float umax, blast; ml_scalars(F, P.g, tab, umax, blast);
        tab[MT_WS * 128 + 2 * F.lane] = __expf(tab[MT_U * 128 + 2 * F.lane] - umax); tab[MT_WS * 128 + 2 * F.lane + 1] = __expf(tab[MT_U * 128 + 2 * F.lane + 1] - umax);
        if (F.lane == 0) { float* sc = (float*)(F.ws + WS_MSC); sc[unit] = umax; sc[1024 + unit] = blast; } }
    SYNC_SB();
    ml_store_conv(F, P.kx, F.lds + ML_K, cwt + 640, 0.08838834764831845f);
    ml_store_rows(F, P.vx, F.lds + ML_VT, tab + MT_WS * 128);
    SYNC_SB();
    if (unit + G < 1024) ml1_issue<0>(F, P, unit + G, cw, cb);
    __builtin_amdgcn_sched_barrier(0);
    {
        f32x16 c0 = {}, c1 = {}; const int rb = 32 * (F.wave & 3), cbk = 64 * (F.wave >> 2);
        ml_mma<true, true>(F.lds + ML_VT, F.lds + ML_K, rb, cbk, F.lane, c0, c1);
        bf16_t* U = (bf16_t*)(F.ws + WS_XN) + (size_t)unit * 16384; const int r32 = F.lane & 31, hi = F.lane >> 5; const bool odd = F.lane & 1;
#pragma unroll
        for (int r = 0; r < 16; r += 2) { const int e = rb + crow(odd ? r + 1 : r, hi);
            { const float xa = dppf<0xB1>(c0[r]), xb = dppf<0xB1>(c0[r + 1]); const unsigned w = cvt_pk_bf16(odd ? xb : c0[r], odd ? c0[r + 1] : xa); *(unsigned*)(U + e * 128 + cbk + (r32 & ~1)) = w; }
            { const float xa = dppf<0xB1>(c1[r]), xb = dppf<0xB1>(c1[r + 1]); const unsigned w = cvt_pk_bf16(odd ? xb : c1[r], odd ? c1[r + 1] : xa); *(unsigned*)(U + e * 128 + cbk + 32 + (r32 & ~1)) = w; } }
    }
    if (unit + G < 1024) ml1_issue<1>(F, P, unit + G, cw, cb);
    __builtin_amdgcn_sched_barrier(0);
    {
        const int dg = F.tid & 63, part = F.tid >> 6; float s0 = 0.f, s1 = 0.f;
#pragma unroll 4
        for (int i = 0; i < 16; ++i) { const int sr = part * 16 + i; const unsigned w = *(const LAS unsigned*)(F.lds + ML_K + sr * 272 + dg * 4); const float ws = tab[MT_WS * 128 + sr]; s0 += bf_lo(w) * ws; s1 += bf_hi(w) * ws; }
        LAS float* pp = (LAS float*)(F.lds + ML_Q);
        pp[part * 128 + 2 * dg] = s0; pp[part * 128 + 2 * dg + 1] = s1;
        SYNC_SB();
        if (F.tid < 128) { float s = 0.f;
#pragma unroll
            for (int p = 0; p < 8; ++p) s += pp[p * 128 + F.tid];
            ((float*)(F.ws + WS_UN))[(size_t)unit * 128 + F.tid] = s; }
    }
    SYNC_SB();
    }
}
__device__ __forceinline__ void mlstm_scan(const Frame& F0, int bh, int slice) {
    Frame F = unit_frame(F0);
    const float* sc = (const float*)(F.ws + WS_MSC);
    const bf16_t* U = (const bf16_t*)(F.ws + WS_XN); bf16_t* C = (bf16_t*)(F.ws + WS_CST);
    const int eoff = slice * 2048 + F.tid * 4;
    f32x4 cst = {0.f, 0.f, 0.f, 0.f}; float nst = 0.f; float m = 0.f;
    const bool don = (slice == 0) && (F.tid < 128);
    static_assert(NCH % 16 == 0, "scan batches");
#define SCAN_LOAD(u, un, umx, bl, c0) do { _Pragma("unroll") for (int i = 0; i < 8; ++i) { const int unit = bh * 32 + (c0) + i; \
        u[i] = *(const u32x2*)(U + (size_t)unit * 16384 + eoff); umx[i] = sc[unit]; bl[i] = sc[1024 + unit]; \
        un[i] = don ? ((const float*)(F.ws + WS_UN))[(size_t)unit * 128 + F.tid] : 0.f; } } while (0)
#define SCAN_STEP(u, un, umx, bl, c0) do { _Pragma("unroll") for (int i = 0; i < 8; ++i) { const int unit = bh * 32 + (c0) + i; \
        *(u32x2*)(C + (size_t)unit * 16384 + eoff) = (u32x2){cvt_pk_bf16(cst.x, cst.y), cvt_pk_bf16(cst.z, cst.w)}; \
        if (don) ((float*)(F.ws + WS_NST))[(size_t)unit * 128 + F.tid] = nst; \
        if (slice == 0 && F.tid == 0) ((float*)(F.ws + WS_MSC))[2048 + unit] = m; \
        const float umax = umx[i], blast = bl[i]; \
        const float Mx = fmaxf(m, umax); const float dc = __expf(m - Mx), du = __expf(umax - Mx); \
        cst = cst * dc + (f32x4){bf_lo(u[i].x), bf_hi(u[i].x), bf_lo(u[i].y), bf_hi(u[i].y)} * du; nst = nst * dc + un[i] * du; m = blast + Mx; } } while (0)
    u32x2 ua[8], ub[8]; float una[8], unb[8], uma[8], umb[8], bla[8], blb[8];
    SCAN_LOAD(ua, una, uma, bla, 0);
#pragma unroll 1
    for (int c0 = 0; c0 < NCH; c0 += 16) {
        SCAN_LOAD(ub, unb, umb, blb, c0 + 8);
        SCAN_STEP(ua, una, uma, bla, c0);
        if (c0 + 16 < NCH) SCAN_LOAD(ua, una, uma, bla, c0 + 16);
        SCAN_STEP(ub, unb, umb, blb, c0 + 8);
    }
#undef SCAN_LOAD
#undef SCAN_STEP
}
#if defined(PROBE_A)
#define MLTICK(k) do { if (blockIdx.x == 0 && F.tid == 0) { const unsigned now_ = (unsigned)__builtin_amdgcn_s_memrealtime(); unsigned* g_ = (unsigned*)F.ws + 12400; g_[(k)] += now_ - g_[31]; g_[31] = now_; } } while (0)
#else
#define MLTICK(k) do { } while (0)
#endif
struct MlPre3 { MlRaw7 qx, kx; MlRaw4 vx, cx; MlCw cw; MlGates g; float nst, m; };
template <int PART> __device__ __forceinline__ void ml3_issue(const Frame& F, MlPre3& P, int unit, const float* cw, const float* cb) {
    const int c = unit & 31, h = (unit >> 5) & 3, b = unit >> 7; const size_t r0 = (size_t)b * SEQ + c * MCH;
    if (PART <= 0) {
        ml_cw_load(F, P.cw, cw, cb, h); ml_gates(F, P.g, r0, h);
        P.m = ((const float*)(F.ws + WS_MSC))[2048 + unit];
        P.nst = ((const float*)(F.ws + WS_NST))[(size_t)unit * 128 + (F.tid & 127)];
        __builtin_amdgcn_sched_barrier(0);
        ml_load_conv(F, P.qx, r0, c * MCH, h * 128); }
    if (PART < 0 || PART == 1) ml_load_conv(F, P.kx, r0, c * MCH, 512 + h * 128);
    if (PART < 0 || PART == 2) {
        ml_load_rows(F, P.vx, (const bf16_t*)(F.ws + WS_MV), r0, 512, h * 128);
        ml_load_rows(F, P.cx, (const bf16_t*)(F.ws + WS_CST) + (size_t)unit * 16384, 0, 128, 0); }
}
__device__ __forceinline__ void mlstm_out_phase(const Frame& F0, int G, const float* cw, const float* cb, const float* ng) {
    MlPre3 P; int unit = F0.vcu;
    ((LAS float*)(F0.lds + ML_NG))[F0.tid] = ng[F0.tid];
    if (unit < 1024) ml3_issue<-1>(F0, P, unit, cw, cb);
#pragma unroll 1
    for (; unit < 1024; unit += G) {
    Frame F = unit_frame(F0);
#if defined(PROBE_A)
    if (blockIdx.x == 0 && F.tid == 0) ((unsigned*)F.ws + 12400)[31] = (unsigned)__builtin_amdgcn_s_memrealtime();
#endif
    const int c = unit & 31, h = (unit >> 5) & 3, b = unit >> 7;
    const size_t r0 = (size_t)b * SEQ + c * MCH;
    LAS float* tab = (LAS float*)(F.lds + ML_TAB); LAS float* cwt = (LAS float*)(F.lds + ML_CW);
    u32x4 mo[4];
    { const u32x4* op = (const u32x4*)((const bf16_t*)(F.ws + WS_MO) + (r0 + (F.tid >> 2)) * 512 + h * 128 + (F.tid & 3) * 32);
#pragma unroll
      for (int i = 0; i < 4; ++i) mo[i] = op[i]; }
    ml_cw_store(F, P.cw, cwt);
    const float m = P.m;
    if (F.wave == 0) { float umax, blast; ml_scalars(F, P.g, tab, umax, blast);
#pragma unroll
        for (int q = 0; q < 2; ++q) { const int t = 2 * F.lane + q; const float Mt = fmaxf(m, tab[MT_M * 128 + t]);
            tab[MT_M * 128 + t] = Mt; tab[MT_WST * 128 + t] = __expf(m - Mt); tab[MT_LIM * 128 + t] = __expf(-tab[MT_BB * 128 + t] - Mt); } }
    if (F.tid >= 128 && F.tid < 256) tab[MT_N * 128 + F.tid - 128] = P.nst;
    SYNC_SB(); MLTICK(0);
    ml_store_conv(F, P.qx, F.lds + ML_Q, cwt, 1.0f);
    __builtin_amdgcn_sched_barrier(0);
    ml_store_conv(F, P.kx, F.lds + ML_K, cwt + 640, 0.08838834764831845f);
    __builtin_amdgcn_sched_barrier(0);
    ml_store_rows(F, P.vx, F.lds + ML_VT, nullptr);
    ml_store_rows(F, P.cx, F.lds + ML_CT, nullptr);
    SYNC_SB(); MLTICK(1);
    if (unit + G < 1024) ml3_issue<0>(F, P, unit + G, cw, cb);
    __builtin_amdgcn_sched_barrier(0);
    const int rb = 32 * (F.wave & 3), cbk = 64 * (F.wave >> 2), r32 = F.lane & 31, hi = F.lane >> 5;
    f32x16 s0 = {}, s1 = {};
    ml_mma<false, false>(F.lds + ML_Q, F.lds + ML_K, rb, cbk, F.lane, s0, s1);
    {
        const float u0 = tab[MT_U * 128 + cbk + r32], u1 = tab[MT_U * 128 + cbk + 32 + r32];
#pragma unroll
        for (int r = 0; r < 16; ++r) { const int t = rb + crow(r, hi); const float Mt = tab[MT_M * 128 + t];
            s0[r] = (cbk + r32 <= t) ? s0[r] * __expf(u0 - Mt) : 0.f; s1[r] = (cbk + 32 + r32 <= t) ? s1[r] * __expf(u1 - Mt) : 0.f; }
    }
    {
        const int t = F.tid >> 2, part = F.tid & 3; float s = ml_dot32(F.lds + ML_Q + t * 272 + part * 64, tab + MT_N * 128 + part * 32);
        s = shx_sum<1>(s); s = shx_sum<2>(s);
        if (part == 0) tab[MT_QN * 128 + t] = s;
    }
    SYNC_SB(); MLTICK(2);
    if (unit + G < 1024) ml3_issue<1>(F, P, unit + G, cw, cb);
    __builtin_amdgcn_sched_barrier(0);
#pragma unroll
    for (int r = 0; r < 16; r += 2) {
        const unsigned pa = cvt_pk_bf16(s0[r], s0[r + 1]), pb = cvt_pk_bf16(s1[r], s1[r + 1]);
        const int t0 = rb + crow(r, hi), t1 = rb + crow(r + 1, hi);
        *(LAS bf16_t*)(F.lds + ML_K + t0 * 272 + (cbk + r32) * 2) = (bf16_t)(pa & 0xffffu); *(LAS bf16_t*)(F.lds + ML_K + t1 * 272 + (cbk + r32) * 2) = (bf16_t)(pa >> 16);
        *(LAS bf16_t*)(F.lds + ML_K + t0 * 272 + (cbk + 32 + r32) * 2) = (bf16_t)(pb & 0xffffu); *(LAS bf16_t*)(F.lds + ML_K + t1 * 272 + (cbk + 32 + r32) * 2) = (bf16_t)(pb >> 16);
    }
    SYNC_SB(); MLTICK(3);
    if (unit + G < 1024) ml3_issue<2>(F, P, unit + G, cw, cb);
    __builtin_amdgcn_sched_barrier(0);
    f32x16 p0 = {}, p1 = {}, q0 = {}, q1 = {};
    ml_mma<false, true>(F.lds + ML_K, F.lds + ML_VT, rb, cbk, F.lane, p0, p1);
    __builtin_amdgcn_sched_barrier(0);
    ml_mma<false, false>(F.lds + ML_Q, F.lds + ML_CT, rb, cbk, F.lane, q0, q1);
    {
        const int t = F.tid >> 2, part = F.tid & 3; float s = ml_dot32(F.lds + ML_K + t * 272 + part * 64, nullptr);
        s = shx_sum<1>(s); s = shx_sum<2>(s);
        if (part == 0) { const float den = s + tab[MT_WST * 128 + t] * tab[MT_QN * 128 + t]; tab[MT_INV * 128 + t] = 1.0f / fmaxf(fabsf(den), tab[MT_LIM * 128 + t]); }
    }
    SYNC_SB(); MLTICK(4);
    LAS float* H = (LAS float*)(F.lds + ML_Q);
#pragma unroll
    for (int r = 0; r < 16; ++r) { const int t = rb + crow(r, hi); const float w = tab[MT_WST * 128 + t], iv = tab[MT_INV * 128 + t];
        H[t * 132 + cbk + r32] = (p0[r] + w * q0[r]) * iv; H[t * 132 + cbk + 32 + r32] = (p1[r] + w * q1[r]) * iv; }
    SYNC_SB(); MLTICK(5);
    {
        const int t = F.tid >> 2, part = F.tid & 3;
        bf16_t* op = (bf16_t*)(F.ws + WS_MO) + (r0 + t) * 512 + h * 128 + part * 32;
        float x[32]; float ss = 0.f;
#pragma unroll
        for (int i = 0; i < 4; ++i) { const u32x4 g = mo[i]; const LAS float* hp = H + t * 132 + part * 32 + 8 * i;
            x[8 * i] = hp[0] * bf_lo(g.x); x[8 * i + 1] = hp[1] * bf_hi(g.x); x[8 * i + 2] = hp[2] * bf_lo(g.y); x[8 * i + 3] = hp[3] * bf_hi(g.y);
            x[8 * i + 4] = hp[4] * bf_lo(g.z); x[8 * i + 5] = hp[5] * bf_hi(g.z); x[8 * i + 6] = hp[6] * bf_lo(g.w); x[8 * i + 7] = hp[7] * bf_hi(g.w); }
#pragma unroll
        for (int i = 0; i < 32; ++i) ss += x[i] * x[i];
        ss = shx_sum<1>(ss); ss = shx_sum<2>(ss);
        const float r = 1.0f / sqrtf(ss * (1.f / 128.f) + EPS);
        const LAS float* gp = (const LAS float*)(F.lds + ML_NG) + h * 128 + part * 32;
#pragma unroll
        for (int i = 0; i < 4; ++i) { u32x4 o; o.x = cvt_pk_bf16(x[8 * i] * r * gp[8 * i], x[8 * i + 1] * r * gp[8 * i + 1]); o.y = cvt_pk_bf16(x[8 * i + 2] * r * gp[8 * i + 2], x[8 * i + 3] * r * gp[8 * i + 3]);
            o.z = cvt_pk_bf16(x[8 * i + 4] * r * gp[8 * i + 4], x[8 * i + 5] * r * gp[8 * i + 5]); o.w = cvt_pk_bf16(x[8 * i + 6] * r * gp[8 * i + 6], x[8 * i + 7] * r * gp[8 * i + 7]); ((u32x4*)op)[i] = o; }
    }
    SYNC_SB(); MLTICK(6);
    }
}

namespace attn {
constexpr int DMP = 512;
constexpr int NW = 8, QBLK = 32, QB = 256, KVBLK = 64;
#define SBAR() __builtin_amdgcn_sched_barrier(0)
constexpr int NSLOT = 3, SLOTB = 8192;
constexpr int LDS_K = 0, LDS_V = NSLOT * SLOTB, LDS_WS = 2 * NSLOT * SLOTB, LDS_OST = LDS_WS + NW * 64 * 4, LDS_END = LDS_OST + NW * 4096;
constexpr int TB_N = 1536, TB_COPY = TB_N * 4, LDS_TB = LDS_END;
constexpr int LDS_KM = LDS_TB + 4 * TB_COPY;
constexpr int LDS_ZERO = LDS_KM + 4096;
constexpr int LDS_ATT_END = LDS_ZERO + 512;
static_assert(LDS_ATT_END <= MISC_OFF, "attention LDS map");
typedef LAS const char* lds_cptr;
typedef short v4i16_t __attribute__((ext_vector_type(4)));
__device__ __forceinline__ void glds16(const void* gsrc, unsigned lds_dst) { unsigned keep;
  asm volatile("s_mov_b32 %0, m0\n\ts_mov_b32 m0, %2\n\ts_nop 0\n\tglobal_load_lds_dwordx4 %1, off\n\ts_mov_b32 m0, %0" : "=&s"(keep) : "v"(gsrc), "s"(lds_dst) : "memory"); }
__device__ __forceinline__ float max3f(float a, float b, float c) { float r; asm("v_max3_f32 %0, %1, %2, %3" : "=v"(r) : "v"(a), "v"(b), "v"(c)); return r; }
__device__ __forceinline__ float max2f(float a, float b) { float r; asm("v_max_f32_e32 %0, %1, %2" : "=v"(r) : "v"(a), "v"(b)); return r; }
__device__ __forceinline__ float fadd_s(float a, float b) { float r; asm("v_add_f32_e32 %0, %1, %2" : "=v"(r) : "v"(a), "v"(b)); return r; }
__device__ __forceinline__ float fsub_s(float a, float b) { float r; asm("v_sub_f32_e32 %0, %1, %2" : "=v"(r) : "v"(a), "v"(b)); return r; }
typedef __bf16 bf16x2_t __attribute__((ext_vector_type(2)));
__device__ __forceinline__ unsigned cvtpk_s(float lo, float hi) { f32x2 v = {lo, hi}; bf16x2_t b = __builtin_convertvector(v, bf16x2_t); return __builtin_bit_cast(unsigned, b); }
#define WAIT_BAR(N) asm volatile("s_waitcnt vmcnt(" #N ") lgkmcnt(0)\n\ts_barrier" ::: "memory")
__device__ __forceinline__ void kload8(bf16x8* kf, lds_cptr kp) {
  kf[0] = *(const LAS bf16x8*)(kp);        kf[1] = *(const LAS bf16x8*)(kp + 512);
  kf[2] = *(const LAS bf16x8*)(kp + 2048); kf[3] = *(const LAS bf16x8*)(kp + 2560);
  kf[4] = *(const LAS bf16x8*)(kp + 4096); kf[5] = *(const LAS bf16x8*)(kp + 4608);
  kf[6] = *(const LAS bf16x8*)(kp + 6144); kf[7] = *(const LAS bf16x8*)(kp + 6656);
}
__device__ __forceinline__ void kload2(bf16x8* kf, lds_cptr kp, int j) { kf[2 * j] = *(const LAS bf16x8*)(kp + j * 2048); kf[2 * j + 1] = *(const LAS bf16x8*)(kp + j * 2048 + 512); }
__device__ __forceinline__ s16x4 vtr(lds_cptr p) { return __builtin_bit_cast(s16x4, __builtin_amdgcn_ds_read_tr16_b64_v4i16((LAS v4i16_t*)p)); }
__device__ __forceinline__ float rowmax(const f32x16& p0, const f32x16& p1) {
  float a = max3f(p0[0], p0[1], p1[0]), b = max3f(p0[2], p0[3], p1[1]); a = max3f(a, p1[2], p1[3]);
#pragma unroll
  for (int r = 4; r < 16; r += 4) { a = max3f(a, p0[r], p0[r + 1]); b = max3f(b, p0[r + 2], p0[r + 3]); a = max3f(a, p1[r], p1[r + 1]); b = max3f(b, p1[r + 2], p1[r + 3]); }
  const float m = max2f(a, b);
  auto rr = __builtin_amdgcn_permlane32_swap(__float_as_uint(m), __float_as_uint(m), false, false);
  return max2f(__uint_as_float(rr[0]), __uint_as_float(rr[1]));
}
__device__ __forceinline__ void pv(f32x16* o, int vb, bf16x8 pa0, bf16x8 pa1, bf16x8 pa2, bf16x8 pa3) {
#pragma unroll
  for (int d0 = 0; d0 < 2; ++d0) { s16x4 lo[4], hi[4];
#pragma unroll
    for (int ks = 0; ks < 4; ++ks) {
      asm volatile("ds_read_b64_tr_b16 %0,%1 offset:%c2" : "=&v"(lo[ks]) : "v"(vb), "i"(d0 * 4096 + ks * 1024) : "memory");
      asm volatile("ds_read_b64_tr_b16 %0,%1 offset:%c2" : "=&v"(hi[ks]) : "v"(vb), "i"(d0 * 4096 + ks * 1024 + 512) : "memory"); }
    asm volatile("s_waitcnt lgkmcnt(0)" ::: "memory"); SBAR();
#define PK(k) (bf16x8){lo[k][0], lo[k][1], lo[k][2], lo[k][3], hi[k][0], hi[k][1], hi[k][2], hi[k][3]}
    o[d0] = MFMA32(pa0, PK(0), o[d0]); o[d0] = MFMA32(pa1, PK(1), o[d0]); o[d0] = MFMA32(pa2, PK(2), o[d0]); o[d0] = MFMA32(pa3, PK(3), o[d0]);
#undef PK
  }
}
template <int THRL> __device__ __forceinline__ void attn_unit(int b, int h, int qb, const bf16_t* Q, const bf16_t* __restrict__ K, const bf16_t* __restrict__ V, bf16_t* O, LAS unsigned char* shm, int wid, int lane, float b31) {
  const int r32 = lane & 31, hi = lane >> 5;
  const long rowbase = (long)b * SEQ; const int q0 = qb * QB;
  const bf16_t* Qw = Q + (rowbase + q0 + wid * QBLK) * DMP + h * ADH;
  const bf16_t* Kh = K + rowbase * DMP + h * ADH; const bf16_t* Vh = V + rowbase * DMP + h * ADH;
  const unsigned lds0 = (unsigned)(uintptr_t)shm;
  LAS float* wsf = (LAS float*)(shm + LDS_WS) + wid * 64;
  const bf16_t* ksrc = Kh + (long)lane * DMP + wid * 8;
  const bf16_t* vsrc = Vh + (long)(16 * (wid & 3) + (lane >> 2)) * DMP + (wid >> 2) * 32 + (lane & 3) * 8;
  const unsigned kdst = lds0 + LDS_K + wid * 1024, vdst = lds0 + LDS_V + wid * 1024;
#define PT(t) (4 * (qb - ((t) >> 2)) + ((t) & 3))
#define DMA_K(t, slot) glds16(ksrc + (long)PT(t) * KVBLK * DMP, (unsigned)__builtin_amdgcn_readfirstlane(kdst + (slot)))
#define DMA_V(t, slot) glds16(vsrc + (long)PT(t) * KVBLK * DMP, (unsigned)__builtin_amdgcn_readfirstlane(vdst + (slot)))
  const int vb0 = (int)(lds0 + LDS_V) + ((lane >> 4) & 1) * 32 + (lane & 3) * 8 + (4 * hi + ((lane & 15) >> 2)) * 64;
  const lds_cptr shm3 = (lds_cptr)shm; const lds_cptr Kbase = shm3 + LDS_K; bf16x8 kf[8];
  const lds_cptr kp0 = shm3 + LDS_K + hi * 1024 + r32 * 16; const lds_cptr vp0 = shm3 + LDS_V + ((lane >> 4) & 1) * 32 + (lane & 3) * 8 + (4 * hi + ((lane & 15) >> 2)) * 64;
  const int NT = 4 * (qb + 1);
  DMA_K(0, 0); DMA_V(0, 0); DMA_K(1, SLOTB);
  bf16x8 qr[4];
#pragma unroll
  for (int d0 = 0; d0 < 4; ++d0) qr[d0] = *reinterpret_cast<const bf16x8*>(&Qw[(long)r32 * DMP + d0 * 16 + hi * 8]);
  DMA_K(2, 2 * SLOTB);
  const int ta = (3 - (r32 & 3)) & 3;
  const lds_cptr tb0 = shm3 + LDS_TB + ta * TB_COPY + 4 * (1279 - 32 * wid - r32 - ta) + 16 * hi;
#define TBP(t) (tb0 - 1024 * ((t) >> 2) + 256 * ((t) & 3))
  const lds_cptr zb_ = shm3 + LDS_ZERO + 16 * hi;
#define BLD(X, sw, p, off) X.sw = *(const LAS f32x4*)((p) + (off))
  f32x16 pA0, pA1, pB0, pB1;
  { const lds_cptr p = TBP(0); BLD(pA0, s0123, p, 0); BLD(pA0, s4567, p, 32); BLD(pA0, s89ab, p, 64); BLD(pA0, scdef, p, 96); BLD(pA1, s0123, p, 128); BLD(pA1, s4567, p, 160); BLD(pA1, s89ab, p, 192); BLD(pA1, scdef, p, 224); }
  unsigned selmask = 0u;
  { float v1 = -INFINITY, v2 = -INFINITY, v3 = -INFINITY; int i1 = -1, i2 = -1, i3 = -1;
    const LAS float* KM = (const LAS float*)(shm + LDS_KM);
#pragma unroll 1
    for (int j = 0; j < qb; ++j) { float s = 0.f;
#pragma unroll
      for (int d0 = 0; d0 < 4; ++d0) { const f32x4 ka = *(const LAS f32x4*)(KM + j * 64 + d0 * 16 + hi * 8), kb = *(const LAS f32x4*)(KM + j * 64 + d0 * 16 + hi * 8 + 4);
        s += bf2f((bf16_t)qr[d0][0]) * ka.x + bf2f((bf16_t)qr[d0][1]) * ka.y + bf2f((bf16_t)qr[d0][2]) * ka.z + bf2f((bf16_t)qr[d0][3]) * ka.w
           + bf2f((bf16_t)qr[d0][4]) * kb.x + bf2f((bf16_t)qr[d0][5]) * kb.y + bf2f((bf16_t)qr[d0][6]) * kb.z + bf2f((bf16_t)qr[d0][7]) * kb.w; }
      s = shx_sum<32>(s);
      if (s > v1) { v3 = v2; i3 = i2; v2 = v1; i2 = i1; v1 = s; i1 = j; } else if (s > v2) { v3 = v2; i3 = i2; v2 = s; i2 = j; } else if (s > v3) { v3 = s; i3 = j; } }
    if (i1 >= 0) selmask |= 1u << i1; if (i2 >= 0) selmask |= 1u << i2; if (i3 >= 0) selmask |= 1u << i3; }
  float mhat = 0.f, l_reg = 0.f; f32x16 o[2]; o[0] = f32x16{}; o[1] = f32x16{};
  float selneg = 0.f, msel = 0.f;
  const bf16x8 kone = (hi == 0) ? (bf16x8){0x3f80, 0x3f80, 0, 0, 0, 0, 0, 0} : (bf16x8){0, 0, 0, 0, 0, 0, 0, 0};
  bf16x8 qx = (bf16x8){0, 0, 0, 0, 0, 0, 0, 0};
#define SETQX() do { const unsigned hb_ = cvtpk_s(msel, 0.f) & 0xffffu; const float hf_ = __uint_as_float(hb_ << 16); const float lf_ = (msel == -INFINITY) ? 0.f : (msel - hf_); \
    const unsigned w_ = (hi == 0) ? (hb_ | (cvtpk_s(lf_, 0.f) << 16)) : 0u; qx = __builtin_bit_cast(bf16x8, (u32x4){w_, 0u, 0u, 0u}); } while (0)
#define BLOCKSEL(t, MODE) do { if ((t) >= 4) selneg = ((selmask >> (qb - ((t) >> 2))) & 1u) ? 0.f : -INFINITY; \
    msel = (MODE) ? (selneg - mhat) : (selneg + (b31 - mhat)); SETQX(); } while (0)
  bool resc = false;
#define RESC() do { if (resc) { asm volatile("s_waitcnt lgkmcnt(0)" ::: "memory"); \
      _Pragma("unroll") for (int d_ = 0; d_ < 2; ++d_) _Pragma("unroll") for (int r = 0; r < 16; ++r) o[d_][r] *= wsf[crow(r, hi)]; } } while (0)
  int sl_prev = 0, sl_cur = 0, sl_next = SLOTB;
#define ROT() do { sl_prev = sl_cur; sl_cur = sl_next; sl_next = (sl_next == (NSLOT - 1) * SLOTB) ? 0 : sl_next + SLOTB; } while (0)
  WAIT_BAR(3);
  { const lds_cptr kb = Kbase + hi * 1024 + r32 * 16;
#pragma unroll
    for (int d0 = 0; d0 < 4; ++d0) { const bf16x8 b0 = *(const LAS bf16x8*)(kb + d0 * 2048), b1 = *(const LAS bf16x8*)(kb + d0 * 2048 + 512); pA0 = MFMA32(b0, qr[d0], pA0); pA1 = MFMA32(b1, qr[d0], pA1); } }
  asm volatile("s_nop 15\n\ts_nop 7" : "+v"(pA0), "+v"(pA1));
  { const float rm = rowmax(pA0, pA1); mhat = fadd_s(mhat, rm);
#pragma unroll
    for (int r = 0; r < 16; ++r) { pA0[r] = fsub_s(pA0[r], rm); pA1[r] = fsub_s(pA1[r], rm); }
    msel = selneg - mhat; SETQX();
#pragma unroll
    for (int r = 0; r < 16; ++r) pA0[r] = __builtin_amdgcn_exp2f(pA0[r]);
#pragma unroll
    for (int r = 0; r < 16; ++r) pA1[r] = __builtin_amdgcn_exp2f(pA1[r]); }
  { const lds_cptr p = TBP(1); BLD(pB0, s0123, p, 0); BLD(pB0, s4567, p, 32); BLD(pB0, s89ab, p, 64); BLD(pB0, scdef, p, 96); BLD(pB1, s0123, p, 128); BLD(pB1, s4567, p, 160); BLD(pB1, s89ab, p, 192); BLD(pB1, scdef, p, 224); }
  WAIT_BAR(0);
  DMA_K(3, 0); DMA_V(1, SLOTB);
  ROT();
  kload8(kf, kp0 + sl_cur);
  WAIT_BAR(2);
  s16x4 vlo[8], vhi[8]; u32x4 pw0, pw1, pw2, pw3;
#define PKW(P, B) cvtpk_s(P[B], P[B + 1])
#define PAF(k) __builtin_bit_cast(bf16x8, pw##k)
#define VFR(i) (bf16x8){vlo[i][0], vlo[i][1], vlo[i][2], vlo[i][3], vhi[i][0], vhi[i][1], vhi[i][2], vhi[i][3]}
#define PIN(x) asm volatile("" : "+v"(x))
#define MX3(a, b, c) __builtin_fmaxf(__builtin_fmaxf((a), (b)), (c))
#define GAPA(MF, A0, A1, A2, A3, W0, W1, PW) do { MF; sacc += A0; sacc += A1; sacc += A2; sacc += A3; PIN(sacc); W0; W1; PIN(PW); SBAR(); } while (0)
#define EX(v) __builtin_amdgcn_exp2f(v)
#define GAPB(MF, X, B, BR) do { MF; X[B] = EX(X[B]); X[B + 1] = EX(X[B + 1]); X[B + 2] = EX(X[B + 2]); X[B + 3] = EX(X[B + 3]); PIN(X); BR; SBAR(); } while (0)
#define VRD(i) do { vlo[i] = vtr(vp_ + (((i) >> 2) * 4096 + ((i) & 3) * 1024)); vhi[i] = vtr(vp_ + (((i) >> 2) * 4096 + ((i) & 3) * 1024 + 512)); } while (0)
#define KRD(G, j) do { if (G) { kload2(kf, kp0 + sl_next, j); SBAR(); } } while (0)
#define NB(X, sw, off) BLD(X, sw, tbn_, off)
#define STEP(C0, C1, P0, P1, t, GK, GV, GL, BS) do { SBAR(); \
    const bool tab_ = ((t) < 20); \
    if (BS) { if ((((t)) & 3) == 0) BLOCKSEL(t, tab_); } \
    C0 = MFMA32(kone, qx, C0); C1 = MFMA32(kone, qx, C1); \
    const lds_cptr vp_ = vp0 + sl_prev; const lds_cptr tbn_ = ((t) + 1 < 20) ? TBP((t) + 1) : zb_; \
    VRD(0); SBAR(); float sacc = (P0[0] + P0[1]); \
    GAPA(C0 = MFMA32(kf[0], qr[0], C0), P0[2], P0[3], P0[4], P0[5],     pw0[0] = PKW(P0, 0), pw0[1] = PKW(P0, 2), pw0); \
    VRD(4); SBAR(); GAPA(C1 = MFMA32(kf[1], qr[0], C1), P0[6], P0[7], P0[8], P0[9],     pw0[2] = PKW(P0, 4), pw0[3] = PKW(P0, 6), pw0); \
    VRD(1); SBAR(); GAPA(C0 = MFMA32(kf[2], qr[1], C0),   P0[10], P0[11], P0[12], P0[13], pw1[0] = PKW(P0, 8), pw1[1] = PKW(P0, 10), pw1); \
    VRD(5); SBAR(); GAPA(C1 = MFMA32(kf[3], qr[1], C1),   P0[14], P0[15], P1[0], P1[1],   pw1[2] = PKW(P0, 12), pw1[3] = PKW(P0, 14), pw1); \
    VRD(2); SBAR(); GAPA(C0 = MFMA32(kf[4], qr[2], C0),   P1[2], P1[3], P1[4], P1[5],     pw2[0] = PKW(P1, 0), pw2[1] = PKW(P1, 2), pw2); \
    VRD(6); SBAR(); GAPA(C1 = MFMA32(kf[5], qr[2], C1),   P1[6], P1[7], P1[8], P1[9],     pw2[2] = PKW(P1, 4), pw2[3] = PKW(P1, 6), pw2); \
    VRD(3); SBAR(); GAPA(C0 = MFMA32(kf[6], qr[3], C0),   P1[10], P1[11], P1[12], P1[13], pw3[0] = PKW(P1, 8), pw3[1] = PKW(P1, 10), pw3); \
    VRD(7); SBAR(); GAPA(C1 = MFMA32(kf[7], qr[3], C1),   P1[14], P1[15], 0.f, 0.f,       pw3[2] = PKW(P1, 12), pw3[3] = PKW(P1, 14), pw3); \
    l_reg += sacc; \
    if (GK) { DMA_K((t) + 3, sl_cur); } if (GV) { DMA_V((t) + 1, sl_next); } \
    { float a = MX3(C0[0], C0[1], C1[0]), b = MX3(C0[2], C0[3], C1[1]); a = MX3(a, C1[2], C1[3]); \
      _Pragma("unroll") for (int r = 4; r < 16; r += 4) { a = MX3(a, C0[r], C0[r + 1]); b = MX3(b, C0[r + 2], C0[r + 3]); a = MX3(a, C1[r], C1[r + 1]); b = MX3(b, C1[r + 2], C1[r + 3]); } \
      float rm = __builtin_fmaxf(a, b); { auto rr = __builtin_amdgcn_permlane32_swap(__float_as_uint(rm), __float_as_uint(rm), false, false); rm = __builtin_fmaxf(__uint_as_float(rr[0]), __uint_as_float(rr[1])); } \
      resc = false; \
      if (__builtin_expect(__any(rm > (float)THRL), 0)) { const float dl = __builtin_fmaxf(rm, 0.f); mhat += dl; \
        _Pragma("unroll") for (int r = 0; r < 16; ++r) { C0[r] -= dl; C1[r] -= dl; } \
        msel -= dl; SETQX(); \
        const float f = __builtin_amdgcn_exp2f(-dl); l_reg *= f; if (hi == 0) wsf[r32] = f; resc = true; } } \
    SBAR(); \
    GAPB(o[0] = MFMA32(PAF(0), VFR(0), o[0]), C0, 0, NB(P0, s0123, 0)); \
    GAPB(o[1] = MFMA32(PAF(0), VFR(4), o[1]), C0, 4, NB(P0, s4567, 32)); \
    KRD(GL, 0); GAPB(o[0] = MFMA32(PAF(1), VFR(1), o[0]), C0, 8, NB(P0, s89ab, 64)); \
    KRD(GL, 1); GAPB(o[1] = MFMA32(PAF(1), VFR(5), o[1]), C0, 12, NB(P0, scdef, 96)); \
    KRD(GL, 2); GAPB(o[0] = MFMA32(PAF(2), VFR(2), o[0]), C1, 0, NB(P1, s0123, 128)); \
    KRD(GL, 3); GAPB(o[1] = MFMA32(PAF(2), VFR(6), o[1]), C1, 4, NB(P1, s4567, 160)); \
    GAPB(o[0] = MFMA32(PAF(3), VFR(3), o[0]), C1, 8, NB(P1, s89ab, 192)); \
    GAPB(o[1] = MFMA32(PAF(3), VFR(7), o[1]), C1, 12, NB(P1, scdef, 224)); \
    } while (0)
#define ENDW(tt) do { if ((tt) + 3 < NT) { WAIT_BAR(2); } else if ((tt) + 2 < NT) { WAIT_BAR(1); } else { WAIT_BAR(0); } } while (0)
  int t = 1;
  for (; t + 5 < NT; t += 2) {
    STEP(pB0, pB1, pA0, pA1, t, true, true, true, 0);     WAIT_BAR(2); RESC(); ROT();
    STEP(pA0, pA1, pB0, pB1, t + 1, true, true, true, 1); WAIT_BAR(2); RESC(); ROT(); }
  for (; t + 1 < NT; t += 2) {
    STEP(pB0, pB1, pA0, pA1, t, (t + 3 < NT), (t + 1 < NT), (t + 1 < NT), 0);     ENDW(t);     RESC(); ROT();
    STEP(pA0, pA1, pB0, pB1, t + 1, (t + 4 < NT), (t + 2 < NT), (t + 2 < NT), 1); ENDW(t + 1); RESC(); ROT(); }
  STEP(pB0, pB1, pA0, pA1, NT - 1, false, false, false, 0); RESC();
  { float sacc = pB0[0] + pB0[1];
#pragma unroll
    for (int r = 2; r < 16; ++r) sacc += pB0[r];
#pragma unroll
    for (int r = 0; r < 16; ++r) sacc += pB1[r];
    l_reg += sacc;
    pw0 = (u32x4){PKW(pB0, 0), PKW(pB0, 2), PKW(pB0, 4), PKW(pB0, 6)}; pw1 = (u32x4){PKW(pB0, 8), PKW(pB0, 10), PKW(pB0, 12), PKW(pB0, 14)}; pw2 = (u32x4){PKW(pB1, 0), PKW(pB1, 2), PKW(pB1, 4), PKW(pB1, 6)}; pw3 = (u32x4){PKW(pB1, 8), PKW(pB1, 10), PKW(pB1, 12), PKW(pB1, 14)};
    SBAR(); pv(o, vb0 + sl_cur, PAF(0), PAF(1), PAF(2), PAF(3)); }
  { auto rr = __builtin_amdgcn_permlane32_swap(__float_as_uint(l_reg), __float_as_uint(l_reg), false, false); l_reg = __uint_as_float(rr[0]) + __uint_as_float(rr[1]); }
  if (hi == 0) wsf[32 + r32] = l_reg; asm volatile("s_waitcnt lgkmcnt(0)" ::: "memory");
  float rli[16];
#pragma unroll
  for (int r = 0; r < 16; ++r) rli[r] = __builtin_amdgcn_rcpf(wsf[32 + crow(r, hi)]);
  bf16_t* Ow = O + (rowbase + q0 + wid * QBLK) * DMP + h * ADH;
  { LAS bf16_t* stg = (LAS bf16_t*)(shm + LDS_OST) + wid * 2048;
#pragma unroll
    for (int r = 0; r < 16; ++r) { const int orow = crow(r, hi);
#pragma unroll
      for (int d0 = 0; d0 < 2; ++d0) stg[orow * 64 + d0 * 32 + r32] = (bf16_t)(cvtpk_s(o[d0][r] * rli[r], 0.f) & 0xffffu); }
    asm volatile("s_waitcnt lgkmcnt(0)" ::: "memory");
#pragma unroll
    for (int i = 0; i < 4; ++i) { const int row = i * 8 + (lane >> 3), ch = lane & 7; const u32x4 v = *(const LAS u32x4*)(stg + row * 64 + ch * 8); *(u32x4*)(Ow + (long)row * DMP + ch * 8) = v; } }
  asm volatile("s_waitcnt lgkmcnt(0)\n\ts_barrier" ::: "memory");
#undef PT
#undef DMA_K
#undef DMA_V
#undef TBP
#undef BLD
#undef BLOCKSEL
#undef SETQX
#undef RESC
#undef ROT
#undef PKW
#undef PAF
#undef VFR
#undef PIN
#undef MX3
#undef GAPA
#undef EX
#undef GAPB
#undef VRD
#undef KRD
#undef NB
#undef STEP
#undef ENDW
}
#undef SBAR
#undef WAIT_BAR
}

__device__ __forceinline__ void moba_tables(const Frame& F, int bh, const float* rel_bias) {
    const int h = bh & 7;
    LAS float* TB = (LAS float*)(F.lds + attn::LDS_TB); LAS float* KM = (LAS float*)(F.lds + attn::LDS_KM);
    for (int i = F.tid; i < 4 * attn::TB_N; i += 512) { const int a = i / attn::TB_N, k = i - a * attn::TB_N; const int d = 1279 - (k + a); float v;
        if (d < 0) v = -INFINITY;
        else { int bk; if (d < 16) bk = d; else bk = 16 + (d >= 21) + (d >= 27) + (d >= 35) + (d >= 46) + (d >= 59) + (d >= 77) + (d >= 99) + (d >= 128) + (d >= 166) + (d >= 216) + (d >= 280) + (d >= 363) + (d >= 470) + (d >= 609) + (d >= 790);
            v = rel_bias[bk * 8 + h] * LOG2E; }
        TB[i] = v; }
    for (int i = F.tid; i < 1024; i += 512) { const float* km = (const float*)(F.ws + WS_KMEAN) + (size_t)bh * 1024 + i; KM[i] = (km[0] + km[65536]) * (1.f / 256.f); }
    if (F.tid < 128) ((LAS float*)(F.lds + attn::LDS_ZERO))[F.tid] = 0.f;
    __syncthreads();
}

__global__ void __launch_bounds__(512, 2) hybrid_fwd(Args args) {
    extern __shared__ __attribute__((aligned(16))) unsigned char lds[];
    Frame F;
    F.lds = (LAS unsigned char*)lds; F.ws = AWS();
    F.wave = __builtin_amdgcn_readfirstlane((int)threadIdx.x >> 6); F.lane = fresh_lane(); F.tid = F.wave * 64 + F.lane;
    F.G = gridDim.x; { const int bx = blockIdx.x; F.vcu = (F.G % 8 == 0) ? (bx % 8) * (F.G / 8) + bx / 8 : bx; }
    volatile LAS unsigned* MISC = (volatile LAS unsigned*)(F.lds + MISC_OFF);
    if (F.tid < 64) MISC[F.tid] = 0u;
    __syncthreads();
    XcdBarrier bar = xcd_barrier_post(((unsigned*)F.ws + CW_BAR), MISC + 8, F.tid);
#define RELOAD() do { int l_ = fresh_lane(); int w_ = F.wave; asm volatile("" : "+s"(w_)); F.wave = w_; F.lane = l_; F.tid = w_ * 64 + l_; \
        int g_ = gridDim.x, b_ = blockIdx.x; asm volatile("" : "+s"(g_), "+s"(b_)); F.G = g_; F.vcu = (g_ % 8 == 0) ? (b_ % 8) * (g_ / 8) + b_ / 8 : b_; F.ws = AWS(); ws = F.ws; G = g_; bx = b_; } while (0)
#if defined(PROBE_A)
#define STAMP(slot) do { if (blockIdx.x == 0 && F.tid == 0) { const unsigned long long now_ = __builtin_amdgcn_s_memrealtime(); const unsigned long long prev_ = ((unsigned long long)MISC[33] << 32) | MISC[32]; \
        MISC[34 + (slot)] += (unsigned)(now_ - prev_); MISC[32] = (unsigned)now_; MISC[33] = (unsigned)(now_ >> 32); } } while (0)
#else
#define STAMP(slot) do { } while (0)
#endif
#if defined(PROBE_A)
#define WGT0() const unsigned long long wgt0_ = __builtin_amdgcn_s_memrealtime()
#define WGT1(ph) do { if (F.tid == 0) { const unsigned d_ = (unsigned)(__builtin_amdgcn_s_memrealtime() - wgt0_); unsigned* g_ = (unsigned*)F.ws + 12000; \
        atomicMax(g_ + 4 * (ph) + 3, d_); atomicMin(g_ + 200 + (ph), d_ ^ 0u); atomicMax(g_ + 300 + 16 * (ph) + (int)xb_xcc_id(), d_); } } while (0)
#define SNAP(ph) do { if (blockIdx.x == 0 && F.tid == 0) { unsigned* g_ = (unsigned*)F.ws + 12000 + 4 * (ph); g_[0] += MISC[54]; g_[1] += MISC[55]; g_[2] += MISC[56]; MISC[54] = 0u; MISC[55] = 0u; MISC[56] = 0u; } } while (0)
#else
#define SNAP(ph) do { } while (0)
#define WGT0() do { } while (0)
#define WGT1(ph) do { } while (0)
#endif
#define GRID_BARS(slot) do { xcd_barrier(bar, F.tid); STAMP(slot); RELOAD(); } while (0)
#define GRID_BAR() GRID_BARS(15)
    unsigned char* ws = F.ws;
    int G = F.G, bx = (int)blockIdx.x;

#if defined(PROBE_A) && defined(MB_KIND)
    if (blockIdx.x == 0) {
        typedef int v8i_ __attribute__((ext_vector_type(8)));
        v8i_ a_ = {0x38383838, 0x38383838, 0x38383838, 0x38383838, 0x38383838, 0x38383838, 0x38383838, 0x38383838}, b_ = a_; asm volatile("" : "+v"(a_), "+v"(b_));
        bf16x8 ha_ = {0x3f80, 0x3f80, 0x3f80, 0x3f80, 0x3f80, 0x3f80, 0x3f80, 0x3f80}, hb_ = ha_; asm volatile("" : "+v"(ha_), "+v"(hb_));
        f32x4 c_[8]; f32x16 d_[4];
#pragma unroll
        for (int i = 0; i < 8; ++i) c_[i] = (f32x4){0.f, 0.f, 0.f, 0.f};
#pragma unroll
        for (int i = 0; i < 4; ++i) d_[i] = f32x16{};
        __syncthreads();
        const unsigned long long t0_ = __builtin_amdgcn_s_memrealtime();
        if (F.wave < MB_WAVES) {
#pragma unroll 1
            for (int it = 0; it < 2000; ++it) {
#if MB_KIND == 0
#pragma unroll
                for (int i = 0; i < 8; ++i) asm volatile("v_mfma_f32_16x16x128_f8f6f4 %0, %1, %2, %0" : "+v"(c_[i]) : "v"(a_), "v"(b_));
#elif MB_KIND == 1
#pragma unroll
                for (int i = 0; i < 8; ++i) asm volatile("v_mfma_f32_16x16x32_bf16 %0, %1, %2, %0" : "+v"(c_[i]) : "v"(ha_), "v"(hb_));
#elif MB_KIND == 2
#pragma unroll
                for (int i = 0; i < 4; ++i) asm volatile("v_mfma_f32_32x32x64_f8f6f4 %0, %1, %2, %0" : "+v"(d_[i]) : "v"(a_), "v"(b_));
#pragma unroll
                for (int i = 0; i < 4; ++i) asm volatile("v_mfma_f32_32x32x64_f8f6f4 %0, %1, %2, %0" : "+v"(d_[i]) : "v"(a_), "v"(b_));
#endif
            }
        }
#pragma unroll
        for (int i = 0; i < 8; ++i) asm volatile("" :: "v"(c_[i]));
#pragma unroll
        for (int i = 0; i < 4; ++i) asm volatile("" :: "v"(d_[i]));
        const unsigned long long t1_ = __builtin_amdgcn_s_memrealtime();
        if (F.tid == 0) MISC[34 + 26] = (unsigned)(t1_ - t0_);
        __syncthreads();
    }
#endif
#if defined(PROBE_A)
    if (blockIdx.x == 0 && F.tid == 0) { const unsigned long long now_ = __builtin_amdgcn_s_memrealtime(); MISC[32] = (unsigned)now_; MISC[33] = (unsigned)(now_ >> 32); }
#endif
    p0_convert(F);
    __syncthreads();
    STAMP(17);

#pragma unroll 1
    for (int layer = 0; layer < 2; ++layer) {
        RELOAD();
        bf16_t* X = (bf16_t*)AOUT(); const void* xin = (layer == 0) ? (const void*)AIN(0) : (const void*)X; const bool xbf = layer != 0;
        norm_pass<0>(F, xin, xbf, AIN(2) + layer * DM, AIN(3) + (size_t)layer * DM * INW + 2048, INW, AIN(6) + layer * 4, AIN(7) + layer * 4);
        GRID_BARS(0);
#if IN8 == 1
        { pg8::StaticOrder S; S.init(ws + WS_XN8IN, ws + 541 * MiB + (size_t)layer * NIN * DM, MTOK, NIN, DM, G, bx, F.tid, F.lds);
          pg8::EpiIn E{ws, 1.0f / 64.0f, 0, AIN(9) + layer * 64, AIN(10) + layer * 64}; pg8::gemm_phase<pg8::EpiIn, pg8::StaticOrder, true, true, 121>(F.lds, DM, S, E, F.wave); }
#elif IN8 == 2
        { pg8::StaticOrder S; S.init(ws + WS_XN, ws + WS_WIN + (size_t)layer * NIN * DM * 2, MTOK, 2048, 2 * DM, G, bx, F.tid, F.lds);
          pg8::EpiIn E{ws, 1.0f, 0, AIN(9) + layer * 64, AIN(10) + layer * 64}; pg8::gemm_phase<pg8::EpiIn, pg8::StaticOrder, true>(F.lds, 2 * DM, S, E, F.wave); }
        { pg8::StaticOrder S; S.wgm = 2; S.init(ws + WS_XN8IN, ws + 541 * MiB + (size_t)layer * NIN * DM + (size_t)2048 * DM, MTOK, NIN - 2048, DM, G, bx, F.tid, F.lds);
          pg8::EpiIn E{ws, 1.0f / 64.0f, 8, AIN(9) + layer * 64, AIN(10) + layer * 64}; pg8::gemm_phase<pg8::EpiIn, pg8::StaticOrder, true, true, 121>(F.lds, DM, S, E, F.wave); }
#else
        { pg8::StaticOrder S; S.init(ws + WS_XN, ws + WS_WIN + (size_t)layer * NIN * DM * 2, MTOK, NIN, 2 * DM, G, bx, F.tid, F.lds);
          pg8::EpiIn E{ws, 1.0f, 0, AIN(9) + layer * 64, AIN(10) + layer * 64}; pg8::gemm_phase<pg8::EpiIn, pg8::StaticOrder, true>(F.lds, 2 * DM, S, E, F.wave); }
#endif
        SNAP(0);
        GRID_BARS(1);
#if !defined(NO_MIX)
        mlstm_local_phase(F, G, AIN(4) + layer * 4096, AIN(5) + layer * 1024);
        GRID_BARS(2);
        for (int it = F.vcu; it < 256; it += G) mlstm_scan(F, it >> 3, it & 7);
        GRID_BARS(3);
#pragma unroll 1
        for (int ph = 0; ph < 2; ++ph) {
            RELOAD();
            if (((ph ^ F.vcu) & 1) == 0) {
                mlstm_out_phase(F, G, AIN(4) + layer * 4096, AIN(5) + layer * 1024, AIN(8) + layer * 512);
            } else {
                for (int v = F.vcu; v < 256; v += G) { const int bh = v >> 2, s = v & 3;
                    moba_tables(F, bh, AIN(1));
                    const float b31 = AIN(1)[31 * 8 + (bh & 7)] * LOG2E;
#pragma unroll 1
                    for (int i = 0; i < 4; ++i) { const int qb = (i == 0) ? s : (i == 1) ? 7 - s : (i == 2) ? 8 + s : 15 - s;
                        Frame f = unit_frame(F);
                        attn::attn_unit<8>(bh >> 3, bh & 7, qb, (const bf16_t*)(f.ws + WS_AQ), (const bf16_t*)(f.ws + WS_AK), (const bf16_t*)(f.ws + WS_AV), (bf16_t*)(f.ws + WS_AQ), f.lds, f.wave, f.lane, b31); }
                    __syncthreads(); }
            }
            __syncthreads();
        }
        GRID_BARS(4);
#endif
        { pg8::MergeOrder S; S.so.init(ws + WS_MO, ws + WS_WA + (size_t)layer * DM * 512 * 2, MTOK, DM, 1024, G, bx, F.tid, F.lds); S.A1 = (const char*)(ws + WS_AQ); S.B1 = (const char*)(ws + WS_WB + (size_t)layer * DM * 512 * 2);
          pg8::EpiMerge E{(bf16_t*)(ws + WS_Y), (const bf16_t*)(ws + WS_GAB), (OUT8 == 1 || (OUT8 == 2 && layer == 1)) ? ws + WS_Y8 : nullptr}; pg8::gemm_phase<pg8::EpiMerge, pg8::MergeOrder, AEPI_LD>(F.lds, 1024, S, E, F.wave); }
        GRID_BARS(5);
#if OUT8
        if (OUT8 == 2 && layer == 0) { pg8::StaticOrder S; S.init(ws + WS_Y, ws + WS_WOUT + (size_t)layer * DM * DM * 2, MTOK, DM, 2 * DM, G, bx, F.tid, F.lds);
          pg8::EpiResid E{xin, X, 1.0f, xbf}; pg8::gemm_phase<pg8::EpiResid, pg8::StaticOrder, true>(F.lds, 2 * DM, S, E, F.wave); }
        else
        { WGT0(); pg8::StaticOrder S; S.init(ws + WS_Y8, ws + WS_WOUT8 + (size_t)layer * DM * DM, MTOK, DM, DM, G, bx, F.tid, F.lds);
          pg8::EpiResid E{xin, X, 1.0f / 1024.0f, xbf}; pg8::gemm_phase<pg8::EpiResid, pg8::StaticOrder, true, true, 121>(F.lds, DM, S, E, F.wave); WGT1(3); }
#else
        { WGT0(); pg8::StaticOrder S; S.init(ws + WS_Y, ws + WS_WOUT + (size_t)layer * DM * DM * 2, MTOK, DM, 2 * DM, G, bx, F.tid, F.lds);
          pg8::EpiResid E{xin, X, 1.0f, xbf}; pg8::gemm_phase<pg8::EpiResid, pg8::StaticOrder, AEPI_LD>(F.lds, 2 * DM, S, E, F.wave); WGT1(3); }
#endif
        SNAP(3);
        GRID_BARS(6);
        if (layer == 0) {
            norm_pass<(DUP8 ? 3 : 1)>(F, X, true, AIN(14), nullptr, 0, nullptr, nullptr);
            GRID_BARS(7);
#if DUP8
            { pg8::StaticOrder S; S.wgm = 2; S.init(ws + WS_XN8, ws + WS_WGU, MTOK, 2 * DFF, DM, G, bx, F.tid, F.lds);
              pg8::EpiSwiGLU<false, (DDN8 != 0)> E{(void*)(ws + WS_ACT), DFF, 1.0f / 64.0f}; pg8::gemm_phase<pg8::EpiSwiGLU<false, (DDN8 != 0)>, pg8::StaticOrder, true, true, 121>(F.lds, DM, S, E, F.wave); }
#else
            { pg8::StaticOrder S; S.init(ws + WS_XN, ws + WS_WGU, MTOK, 2 * DFF, 2 * DM, G, bx, F.tid, F.lds);
              pg8::EpiSwiGLU<false, (DDN8 != 0)> E{(void*)(ws + WS_ACT), DFF, 1.0f}; pg8::gemm_phase<pg8::EpiSwiGLU<false, (DDN8 != 0)>, pg8::StaticOrder, true>(F.lds, 2 * DM, S, E, F.wave); }
#endif
            GRID_BARS(8);
#if DDN8
            { pg8::StaticOrder S; S.init(ws + WS_ACT, ws + WS_WD, MTOK, DM, DFF, G, bx, F.tid, F.lds);
              pg8::EpiResid E{X, X, 1.0f / 128.0f, true}; pg8::gemm_phase<pg8::EpiResid, pg8::StaticOrder, true, true, 120>(F.lds, DFF, S, E, F.wave); }
#else
            { pg8::StaticOrder S; S.init(ws + WS_ACT, ws + WS_WD, MTOK, DM, 2 * DFF, G, bx, F.tid, F.lds);
              pg8::EpiResid E{X, X, 1.0f, true}; pg8::gemm_phase<pg8::EpiResid, pg8::StaticOrder, AEPI_LD>(F.lds, 2 * DFF, S, E, F.wave); }
#endif
            GRID_BARS(9);
        } else {
#if !defined(NO_MOE)
            norm_pass<2>(F, X, true, AIN(14) + DM, AIN(18), 8, nullptr, nullptr);
            STAMP(18);
            p_convert_experts(F);
            GRID_BARS(10);
            moe_place(F);
            GRID_BARS(15);
            {
                const int* idx = (const int*)(ws + WS_MIDX); const float* wgt = (const float*)(ws + WS_MWGT); const unsigned* cnt = (const unsigned*)(ws + WS_CTL) + CW_MOE;
#if defined(PROBE_A)
                if (blockIdx.x == 0 && F.tid == 0) { MISC[54] = 0u; MISC[55] = 0u; MISC[56] = 0u; }
#endif
                { pg8::MoeOrder<true> S; S.init(ws + WS_XN8S, ws + WS_WGUE, DM, idx, cnt, EFF / 128, G, bx, 0, 16, F.tid, F.lds);
                  pg8::EpiSwiGLU<true, true> E{(void*)(ws + WS_EACT), EFF, 1.0f / 64.0f}; pg8::gemm_phase<pg8::EpiSwiGLU<true, true>, pg8::MoeOrder<true>, true, true, 121>(F.lds, DM, S, E, F.wave); }
#if defined(PROBE_A)
                if (blockIdx.x == 0 && F.tid == 0) { MISC[57] = MISC[54]; MISC[58] = MISC[55]; MISC[59] = MISC[56]; }
#endif
                GRID_BARS(11);
#if defined(PROBE_A) && defined(FAKE_UP)
                if (blockIdx.x == 0 && F.tid == 0) { MISC[54] = 0u; MISC[55] = 0u; MISC[56] = 0u; }
                { pg8::MoeOrder<true> S; S.init(ws + WS_XN8, ws + WS_WGUE, DM, idx, cnt, EFF / 128, G, bx, 0, 16, F.tid, F.lds); S.fake = 1;
                  pg8::EpiSwiGLU<true, true> E{(void*)(ws + 244 * MiB), EFF, 1.0f / 64.0f}; pg8::gemm_phase<pg8::EpiSwiGLU<true, true>, pg8::MoeOrder<true>, true, true, 121>(F.lds, DM, S, E, F.wave); }
                if (blockIdx.x == 0 && F.tid == 0) { MISC[61] = MISC[54]; MISC[62] = MISC[55]; MISC[63] = MISC[56]; }
                GRID_BARS(15);
                idx = (const int*)(ws + WS_MIDX); wgt = (const float*)(ws + WS_MWGT); cnt = (const unsigned*)(ws + WS_CTL) + CW_MOE;
#endif
                idx = (const int*)(ws + WS_MIDX); wgt = (const float*)(ws + WS_MWGT); cnt = (const unsigned*)(ws + WS_CTL) + CW_MOE;
#pragma unroll 1
                for (int md = 1; md <= 2; ++md) { RELOAD(); idx = (const int*)(ws + WS_MIDX); cnt = (const unsigned*)(ws + WS_CTL) + CW_MOE;
                  const bool split = (G % 8 == 0);
                  if (!split && md == 2) break;
                  pg8::MoeOrder<false> S; S.mode = split ? md : 0; S.khalf = EFF / 2; S.init(ws + WS_EACT, ws + WS_WDE, EFF, idx, cnt, 4, G, bx, 0, 16, F.tid, F.lds);
                  pg8::EpiMoeStore E{(bf16_t*)(ws + WS_YP), 1.0f / 128.0f, (bf16_t*)(ws + WS_YP2)}; pg8::gemm_phase<pg8::EpiMoeStore, pg8::MoeOrder<false>, true, true, 120>(F.lds, EFF, S, E, F.wave, (split && md == 2) ? EFF / 256 : 0); }
                SNAP(7);
                GRID_BARS(12);
                moe_combine(F, AOUT());
            }
#endif
        }
    }
#if defined(EXTRA_BARS)
#pragma unroll 1
    for (int eb_ = 0; eb_ < EXTRA_BARS; ++eb_) { GRID_BAR(); }
#endif
#if defined(PROBE_A)
    STAMP(14);
    if (blockIdx.x == 0 && F.tid == 0) { unsigned a_ = MISC[34 + PROBE_A] / 1000u, b_ = (PROBE_B >= 500 ? (((unsigned*)F.ws + 12400)[((PROBE_B - 500) >> 4) & 15] + ((((PROBE_B - 500) & 15) == 15) ? 0u : ((unsigned*)F.ws + 12400)[(PROBE_B - 500) & 15])) : PROBE_B >= 100 ? ((unsigned*)F.ws + 12000)[PROBE_B - 100] : MISC[34 + (PROBE_B < 100 ? PROBE_B : 0)]) / 1000u; a_ = a_ > 127u ? 127u : a_; b_ = b_ > 127u ? 127u : b_;
        const unsigned long long t0_ = __builtin_amdgcn_s_memrealtime(), dl_ = (unsigned long long)(a_ + 128u * b_) * 1000ull;
        while (__builtin_amdgcn_s_memrealtime() - t0_ < dl_) __builtin_amdgcn_s_sleep(32); }
#endif
}

extern "C" void kernel_launch(void* const* d_in, const int* in_sizes, int n_in, void* d_out, int out_size, void* d_ws, size_t ws_size, hipStream_t stream) {
    static int grid = 0;
    if (grid == 0) {
        if (n_in != 22 || out_size != MTOK * DM || ws_size < WS_END) { fprintf(stderr, "kernel_launch: unexpected shapes (n_in %d, out %d, ws %zu)\n", n_in, out_size, ws_size); grid = -1; return; }
        int dev = 0, cus = 0, per_cu = 0;
        if (hipGetDevice(&dev) != hipSuccess || hipDeviceGetAttribute(&cus, hipDeviceAttributeMultiprocessorCount, dev) != hipSuccess) { grid = -1; return; }
        if (hipFuncSetAttribute((const void*)hybrid_fwd, hipFuncAttributeMaxDynamicSharedMemorySize, LDS_BYTES) != hipSuccess) { fprintf(stderr, "kernel_launch: hipFuncSetAttribute failed\n"); grid = -1; return; }
        if (hipOccupancyMaxActiveBlocksPerMultiprocessor(&per_cu, (const void*)hybrid_fwd, 512, LDS_BYTES) != hipSuccess || per_cu < 1) fprintf(stderr, "kernel_launch: occupancy query reports %d\n", per_cu);
        (void)hipGetLastError();
        grid = cus;
    }
    if (grid < 0) return;
    if (hipMemsetAsync((char*)d_ws + WS_CTL, 0, CTL_ZERO_BYTES, stream) != hipSuccess) return;
    Args a{};
    for (int i = 0; i < 22; ++i) a.in[i] = (const float*)d_in[i];
    a.out = (float*)d_out; a.ws = (unsigned char*)d_ws;
    hipLaunchKernelGGL(hybrid_fwd, dim3(grid), dim3(512), LDS_BYTES, stream, a);
}
```
